# Optimizing an MI355X kernel written in HIP

```python
import numpy as np
import jax
import jax.numpy as jnp
from jax import lax

D_MODEL = 1024
BATCH = 8
SEQ = 2048
DEPTH = 1

HEAD_DIM = 64
NSA_HEADS = 8
NSA_KV_HEADS = 2
NSA_GROUP = NSA_HEADS // NSA_KV_HEADS
SWA_HEADS = 8
SWA_KV_HEADS = 2
SWA_GROUP = SWA_HEADS // SWA_KV_HEADS
NSA_WIDTH = NSA_HEADS * HEAD_DIM
SWA_WIDTH = SWA_HEADS * HEAD_DIM
NSA_KV_WIDTH = NSA_KV_HEADS * HEAD_DIM
SWA_KV_WIDTH = SWA_KV_HEADS * HEAD_DIM
CMP_LEN = 32
CMP_STRIDE = 16
CMP_HIDDEN = 256
SLC_LEN = 64
SLC_TOPK = 8
NSA_WINDOW = 256
SLC_QUERY_CHUNK = 64
SWA_WINDOW = 128
BAND_BLOCK = 128
N_GROUPS = 4
EXPERTS_PER_GROUP = 8
N_EXPERTS = N_GROUPS * EXPERTS_PER_GROUP
EXPERT_TOPK = 2
EXPERT_FF = 256
MOE_BLOCK = 128
IN_SIZES = (NSA_WIDTH, NSA_KV_WIDTH, NSA_KV_WIDTH, NSA_KV_WIDTH, NSA_KV_WIDTH, NSA_KV_WIDTH, NSA_KV_WIDTH,
            3 * NSA_HEADS, SWA_WIDTH, SWA_KV_WIDTH, SWA_KV_WIDTH, 2 * D_MODEL)
IN_WIDTH = sum(IN_SIZES)
RMS_EPS = 1e-6
NEG_INF = -1e30
FORCE_SCORE = 1e9

kernel_name = "hybrid_nsa_swa_sinks_hier_moe"


def rms_norm(x, g):
    x32 = x.astype(jnp.float32)
    y = x32 * lax.rsqrt(jnp.mean(x32 * x32, axis=-1, keepdims=True) + RMS_EPS)
    return (y * g.astype(jnp.float32)).astype(x.dtype)


def masked_softmax(s, mask):
    s = jnp.where(mask, s, NEG_INF)
    m = jnp.max(s, axis=-1, keepdims=True)
    e = jnp.where(mask, jnp.exp(s - m), 0.0)
    z = jnp.sum(e, axis=-1, keepdims=True)
    return e / jnp.where(z > 0, z, 1.0)


def alibi_slopes():
    n = NSA_HEADS + SWA_HEADS
    s = 2.0 ** (-8.0 * np.arange(1, n + 1) / n)
    return jnp.asarray(s[:SWA_HEADS], jnp.float32), jnp.asarray(s[SWA_HEADS:], jnp.float32)


def compress_blocks(kv, pos, w1, w2):
    B, S, H, d = kv.shape
    r = CMP_LEN // CMP_STRIDE
    nc = S // CMP_STRIDE - r + 1
    kc = kv.reshape(B, S // CMP_STRIDE, CMP_STRIDE, H, d)
    blocks = jnp.concatenate([kc[:, i:i + nc] for i in range(r)], axis=2)
    blocks = blocks + pos[None, None, :, None, :]
    flat = jnp.transpose(blocks, (0, 1, 3, 2, 4)).reshape(B, nc, H, CMP_LEN * d)
    return jax.nn.silu(flat @ w1) @ w2


def compressed_branch(q, kc, vc, slopes):
    B, S, Hkv, G, d = q.shape
    nc = kc.shape[1]
    s = jnp.einsum('bshgd,bchd->bhgsc', q, kc, preferred_element_type=jnp.float32) * (d ** -0.5)
    end = jnp.arange(nc) * CMP_STRIDE + CMP_LEN - 1
    dist = jnp.arange(S)[:, None] - end[None, :]
    s = s - slopes.reshape(Hkv, G, 1, 1) * dist.astype(jnp.float32)
    p = masked_softmax(s, dist >= 0)
    o = jnp.einsum('bhgsc,bchd->bshgd', p.astype(vc.dtype), vc)
    return o, p


def select_blocks(p_cmp, S):
    nc = p_cmp.shape[-1]
    ns = S // SLC_LEN
    c0 = np.arange(nc) * CMP_STRIDE
    s0 = np.arange(ns) * SLC_LEN
    ov = np.clip(np.minimum(c0[:, None] + CMP_LEN, s0[None, :] + SLC_LEN)
                 - np.maximum(c0[:, None], s0[None, :]), 0, None) / CMP_LEN
    imp = jnp.einsum('bhsc,cj->bhsj', jnp.sum(p_cmp, axis=2), jnp.asarray(ov, jnp.float32))
    t = jnp.arange(S)[:, None]
    j = jnp.arange(ns)[None, :]
    cur = t // SLC_LEN
    valid = j * SLC_LEN <= t
    forced = (j == 0) | (j == cur) | (j == cur - 1)
    score = jnp.where(forced, FORCE_SCORE, jnp.where(valid, imp, NEG_INF))
    vals, idx = lax.top_k(score, min(SLC_TOPK, ns))
    return idx, vals > 0.5 * NEG_INF


def selected_branch(q, k, v, idx, valid, slopes):
    B, S, Hkv, G, d = q.shape
    ns = S // SLC_LEN
    n = idx.shape[-1]
    QC = SLC_QUERY_CHUNK
    nq = S // QC
    kb = jnp.transpose(k.reshape(B, ns, SLC_LEN, Hkv, d), (0, 3, 1, 2, 4))
    vb = jnp.transpose(v.reshape(B, ns, SLC_LEN, Hkv, d), (0, 3, 1, 2, 4))
    qc = jnp.swapaxes(q.reshape(B, nq, QC, Hkv, G, d), 0, 1)
    ic = jnp.transpose(idx.reshape(B, Hkv, nq, QC, n), (2, 0, 1, 3, 4))
    vc = jnp.transpose(valid.reshape(B, Hkv, nq, QC, n), (2, 0, 1, 3, 4))
    tc = jnp.arange(S).reshape(nq, QC)
    bi = jnp.arange(B)[:, None, None, None]
    hi = jnp.arange(Hkv)[None, :, None, None]
    sl = slopes.reshape(1, Hkv, G, 1, 1, 1)
    scale = d ** -0.5

    def chunk(args):
        qq, ii, vv, tt = args
        kg = kb[bi, hi, ii]
        vg = vb[bi, hi, ii]
        s = jnp.einsum('bqhgd,bhqnld->bhgqnl', qq, kg, preferred_element_type=jnp.float32) * scale
        kpos = ii[..., None] * SLC_LEN + jnp.arange(SLC_LEN)
        dist = tt[None, None, :, None, None] - kpos
        mask = (vv[..., None] & (dist >= 0))[:, :, None]
        s = s - sl * dist[:, :, None].astype(jnp.float32)
        p = masked_softmax(s.reshape(B, Hkv, G, QC, n * SLC_LEN), mask.reshape(B, Hkv, 1, QC, n * SLC_LEN))
        return jnp.einsum('bhgqk,bhqkd->bqhgd', p.astype(vg.dtype), vg.reshape(B, Hkv, QC, n * SLC_LEN, d))

    out = lax.map(chunk, (qc, ic, vc, tc))
    return jnp.swapaxes(out, 0, 1).reshape(B, S, Hkv, G, d)


def banded_attention(q, k, v, slopes, window, sinks):
    B, S, Hkv, G, d = q.shape
    nb = S // BAND_BLOCK
    nprev = -(-(window - 1) // BAND_BLOCK)
    pad = nprev * BAND_BLOCK
    kw = (nprev + 1) * BAND_BLOCK

    def band(a):
        ap = jnp.pad(a, ((0, 0), (pad, 0), (0, 0), (0, 0))).reshape(B, nb + nprev, BAND_BLOCK, Hkv, d)
        return jnp.concatenate([ap[:, j:j + nb] for j in range(nprev + 1)], axis=2)

    kb, vb = band(k), band(v)
    qb = q.reshape(B, nb, BAND_BLOCK, Hkv, G, d)
    s = jnp.einsum('bnqhgd,bnkhd->bnhgqk', qb, kb, preferred_element_type=jnp.float32) * (d ** -0.5)
    blk = jnp.arange(nb)[:, None] * BAND_BLOCK
    tpos = blk + jnp.arange(BAND_BLOCK)
    kpos = blk - pad + jnp.arange(kw)
    dist = tpos[:, :, None] - kpos[:, None, :]
    mask = ((dist >= 0) & (dist < window) & (kpos[:, None, :] >= 0))[None, :, None, None]
    s = s - slopes.reshape(1, 1, Hkv, G, 1, 1) * dist.astype(jnp.float32)[None, :, None, None]
    s = jnp.where(mask, s, NEG_INF)
    m = jnp.max(s, axis=-1, keepdims=True)
    if sinks is not None:
        sk = sinks.astype(jnp.float32).reshape(1, 1, Hkv, G, 1, 1)
        m = jnp.maximum(m, sk)
    e = jnp.where(mask, jnp.exp(s - m), 0.0)
    z = jnp.sum(e, axis=-1, keepdims=True)
    if sinks is not None:
        z = z + jnp.exp(sk - m)
    p = e / z
    o = jnp.einsum('bnhgqk,bnkhd->bnqhgd', p.astype(v.dtype), vb)
    return o.reshape(B, S, Hkv, G, d)


def hier_moe(h, w_group, b_group, w_expert, b_expert, w_gate_e, w_up_e, w_down_e):
    B, S, D = h.shape
    N = B * S
    hf = h.reshape(N, D)
    g_logits = (hf @ w_group).astype(jnp.float32) + b_group.astype(jnp.float32)
    g_prob = jax.nn.softmax(g_logits, axis=-1)
    grp = jnp.argmax(g_logits, axis=-1)
    p_grp = jnp.take_along_axis(g_prob, grp[:, None], axis=-1)[:, 0]
    e_logits = ((hf @ w_expert).astype(jnp.float32) + b_expert.astype(jnp.float32)).reshape(N, N_GROUPS, EXPERTS_PER_GROUP)
    e_in = jnp.take_along_axis(e_logits, grp[:, None, None], axis=1)[:, 0]
    top_v, top_i = lax.top_k(e_in, EXPERT_TOPK)
    weight = p_grp[:, None] * jax.nn.softmax(top_v, axis=-1)
    eid = (grp[:, None] * EXPERTS_PER_GROUP + top_i).reshape(-1)
    w_f = weight.reshape(-1)
    NK = N * EXPERT_TOPK
    tok = jnp.arange(NK) // EXPERT_TOPK
    order = jnp.argsort(eid)
    e_sorted = eid[order]
    counts = jnp.bincount(eid, length=N_EXPERTS)
    padded = (counts + MOE_BLOCK - 1) // MOE_BLOCK * MOE_BLOCK
    pad_end = jnp.cumsum(padded)
    pad_start = pad_end - padded
    cnt_start = jnp.cumsum(counts) - counts
    dest = pad_start[e_sorted] + jnp.arange(NK) - cnt_start[e_sorted]
    n_blocks = -(-(NK + N_EXPERTS * (MOE_BLOCK - 1)) // MOE_BLOCK)
    buf = jnp.zeros((n_blocks * MOE_BLOCK, D), h.dtype).at[dest].set(hf[tok[order]])
    block_e = jnp.minimum(jnp.searchsorted(pad_end, jnp.arange(n_blocks) * MOE_BLOCK, side='right'), N_EXPERTS - 1)

    def expert_block(args):
        xb, e = args
        return (jax.nn.silu(xb @ w_gate_e[e]) * (xb @ w_up_e[e])) @ w_down_e[e]

    yb = lax.map(expert_block, (buf.reshape(n_blocks, MOE_BLOCK, D), block_e)).reshape(-1, D)
    y_slot = yb[dest] * w_f[order][:, None].astype(yb.dtype)
    y = jnp.zeros((N, D), h.dtype).at[tok[order]].add(y_slot)
    return y.reshape(B, S, D)


def setup_inputs(seed: int = 0) -> dict:
    key = jax.random.key(seed)
    ks = jax.random.split(key, 24)
    f32 = jnp.float32
    L = DEPTH
    d = HEAD_DIM

    def nrm(k, shape, scale):
        return jax.random.normal(k, shape, f32) * scale

    return {
        "x": nrm(ks[0], (BATCH, SEQ, D_MODEL), 1.0),
        "norm_mix_g": 1.0 + nrm(ks[1], (L, D_MODEL), 0.02),
        "w_in": nrm(ks[2], (L, D_MODEL, IN_WIDTH), D_MODEL ** -0.5),
        "cmp_pos_k": nrm(ks[3], (L, CMP_LEN, d), 0.1),
        "cmp_w1_k": nrm(ks[4], (L, CMP_LEN * d, CMP_HIDDEN), (CMP_LEN * d) ** -0.5),
        "cmp_w2_k": nrm(ks[5], (L, CMP_HIDDEN, d), CMP_HIDDEN ** -0.5),
        "cmp_pos_v": nrm(ks[6], (L, CMP_LEN, d), 0.1),
        "cmp_w1_v": nrm(ks[7], (L, CMP_LEN * d, CMP_HIDDEN), (CMP_LEN * d) ** -0.5),
        "cmp_w2_v": nrm(ks[8], (L, CMP_HIDDEN, d), CMP_HIDDEN ** -0.5),
        "sinks": nrm(ks[9], (L, SWA_HEADS), 0.5),
        "w_a": nrm(ks[10], (L, NSA_WIDTH, D_MODEL), NSA_WIDTH ** -0.5),
        "w_b": nrm(ks[11], (L, SWA_WIDTH, D_MODEL), SWA_WIDTH ** -0.5),
        "w_o": nrm(ks[12], (L, D_MODEL, D_MODEL), D_MODEL ** -0.5),
        "norm_ffn_g": 1.0 + nrm(ks[13], (L, D_MODEL), 0.02),
        "w_group": nrm(ks[14], (L, D_MODEL, N_GROUPS), D_MODEL ** -0.5),
        "b_group": nrm(ks[15], (L, N_GROUPS), 0.01),
        "w_expert": nrm(ks[16], (L, D_MODEL, N_EXPERTS), D_MODEL ** -0.5),
        "b_expert": nrm(ks[17], (L, N_EXPERTS), 0.01),
        "w_gate_e": nrm(ks[18], (L, N_EXPERTS, D_MODEL, EXPERT_FF), D_MODEL ** -0.5),
        "w_up_e": nrm(ks[19], (L, N_EXPERTS, D_MODEL, EXPERT_FF), D_MODEL ** -0.5),
        "w_down_e": nrm(ks[20], (L, N_EXPERTS, EXPERT_FF, D_MODEL), EXPERT_FF ** -0.5),
        "norm_final_g": 1.0 + nrm(ks[21], (D_MODEL,), 0.02),
    }


def reference(x, norm_mix_g, w_in, cmp_pos_k, cmp_w1_k, cmp_w2_k, cmp_pos_v, cmp_w1_v, cmp_w2_v,
              sinks, w_a, w_b, w_o, norm_ffn_g, w_group, b_group, w_expert, b_expert,
              w_gate_e, w_up_e, w_down_e, norm_final_g):
    B, S, _ = x.shape
    slopes_swa, slopes_nsa = alibi_slopes()
    split_points = [int(c) for c in np.cumsum(IN_SIZES)[:-1]]
    for l in range(DEPTH):
        h = rms_norm(x, norm_mix_g[l])
        proj = h @ w_in[l]
        (q_a, k_cmp, v_cmp, k_slc, v_slc, k_win, v_win, g_nsa,
         q_b, k_b, v_b, g_merge) = jnp.split(proj, split_points, axis=-1)
        q_a = q_a.reshape(B, S, NSA_KV_HEADS, NSA_GROUP, HEAD_DIM)
        kv_a = [t.reshape(B, S, NSA_KV_HEADS, HEAD_DIM) for t in (k_cmp, v_cmp, k_slc, v_slc, k_win, v_win)]
        kc = compress_blocks(kv_a[0], cmp_pos_k[l], cmp_w1_k[l], cmp_w2_k[l])
        vc = compress_blocks(kv_a[1], cmp_pos_v[l], cmp_w1_v[l], cmp_w2_v[l])
        o_cmp, p_cmp = compressed_branch(q_a, kc, vc, slopes_nsa)
        idx, valid = select_blocks(p_cmp, S)
        o_slc = selected_branch(q_a, kv_a[2], kv_a[3], idx, valid, slopes_nsa)
        o_win = banded_attention(q_a, kv_a[4], kv_a[5], slopes_nsa, NSA_WINDOW, None)
        g = jax.nn.sigmoid(g_nsa).reshape(B, S, NSA_KV_HEADS, NSA_GROUP, 3)
        o_a = (g[..., 0:1] * o_cmp + g[..., 1:2] * o_slc + g[..., 2:3] * o_win).reshape(B, S, NSA_WIDTH)
        q_b = q_b.reshape(B, S, SWA_KV_HEADS, SWA_GROUP, HEAD_DIM)
        k_b = k_b.reshape(B, S, SWA_KV_HEADS, HEAD_DIM)
        v_b = v_b.reshape(B, S, SWA_KV_HEADS, HEAD_DIM)
        o_b = banded_attention(q_b, k_b, v_b, slopes_swa, SWA_WINDOW, sinks[l]).reshape(B, S, SWA_WIDTH)
        gate_a, gate_b = jnp.split(jax.nn.sigmoid(g_merge), 2, axis=-1)
        mix = (gate_a * (o_a @ w_a[l]) + gate_b * (o_b @ w_b[l])) @ w_o[l]
        x = x + mix
        x = x + hier_moe(rms_norm(x, norm_ffn_g[l]), w_group[l], b_group[l], w_expert[l], b_expert[l],
                         w_gate_e[l], w_up_e[l], w_down_e[l])
    return rms_norm(x, norm_final_g)
```

```cpp
#include <hip/hip_runtime.h>
#include <stdint.h>

typedef unsigned short bf16_t;
__device__ __forceinline__ float bf2f(bf16_t v) { return __uint_as_float(((unsigned)v) << 16); }
__device__ __forceinline__ bf16_t f2bf(float f) { unsigned u = __float_as_uint(f); return (bf16_t)((u + 0x7fffu + ((u >> 16) & 1u)) >> 16); }
__device__ __forceinline__ float wave_sum(float v) {
#pragma unroll
  for (int o = 1; o < 64; o <<= 1) v += __shfl_xor(v, o);
  return v;
}
__device__ __forceinline__ float wave_max(float v) {
#pragma unroll
  for (int o = 1; o < 64; o <<= 1) v = fmaxf(v, __shfl_xor(v, o));
  return v;
}
__device__ __forceinline__ float sigmoidf_(float v) { return 1.f / (1.f + __expf(-v)); }

constexpr int NB = 8, S = 2048, D = 1024, NTOK = NB * S;
constexpr int INW = 4120;
constexpr int NSLOT = 40960;
constexpr size_t MiB = 1u << 20;
constexpr size_t WS_CTL = 0;
constexpr size_t WS_SMALL = 1 * MiB;
constexpr size_t WS_XN = 66 * MiB;
constexpr size_t WS_OA = 66 * MiB, WS_OB = 82 * MiB;
constexpr size_t WS_YS = 66 * MiB;
constexpr size_t WS_GM = 98 * MiB;
constexpr size_t WS_H2 = 98 * MiB, WS_H2LO = 130 * MiB;
constexpr size_t WS_QA = 162 * MiB, WS_QB = 178 * MiB, WS_KVC = 194 * MiB, WS_KVS = 202 * MiB, WS_KVW = 210 * MiB, WS_KVB = 218 * MiB;
constexpr size_t WS_MG = 162 * MiB;
constexpr size_t WS_HB = 162 * MiB;
constexpr size_t WS_GTMP = 182 * MiB;
constexpr size_t WS_GN = 226 * MiB;
constexpr size_t WS_KC = 228 * MiB, WS_VC = WS_KC + 256 * 1024, WS_T1 = 229 * MiB;
constexpr int SM_OFF = 0, SM_TILE_E = 64, SM_EID = 256, SM_WT = SM_EID + 2 * NTOK, SM_RANK = SM_WT + 2 * NTOK, SM_SLOT = SM_RANK + 2 * NTOK, SM_ROWTOK = SM_SLOT + 2 * NTOK;
static_assert((SM_ROWTOK + NSLOT) * 4 <= (int)MiB, "small");

__global__ void __launch_bounds__(256) k_prep_xn(const float* __restrict__ x, const float* __restrict__ g, bf16_t* __restrict__ xn) {
  const int lane = threadIdx.x & 63, wave = (blockIdx.x * 256 + threadIdx.x) >> 6, nw = (gridDim.x * 256) >> 6;
  for (int r = wave; r < NTOK; r += nw) {
    const float4* xr = (const float4*)(x + (size_t)r * D);
    float4 v[4]; float s = 0.f;
#pragma unroll
    for (int j = 0; j < 4; ++j) { v[j] = xr[lane + 64 * j]; s += v[j].x * v[j].x + v[j].y * v[j].y + v[j].z * v[j].z + v[j].w * v[j].w; }
    s = wave_sum(s);
    const float rstd = rsqrtf(s * (1.f / D) + 1e-6f);
#pragma unroll
    for (int j = 0; j < 4; ++j) {
      const float4 gg = ((const float4*)g)[lane + 64 * j];
      ushort4 o; o.x = f2bf(v[j].x * rstd * gg.x); o.y = f2bf(v[j].y * rstd * gg.y); o.z = f2bf(v[j].z * rstd * gg.z); o.w = f2bf(v[j].w * rstd * gg.w);
      ((ushort4*)(xn + (size_t)r * D))[lane + 64 * j] = o;
    }
  }
}

template <class AL, class BL, class EP>
__global__ void __launch_bounds__(256) k_gemm64(AL al, BL bl, EP ep, int K) {
  __shared__ float As[16][68];
  __shared__ float Bs[16][68];
  const int tid = threadIdx.x, tx = tid & 15, ty = tid >> 4;
  const int m0 = blockIdx.y * 64, n0 = blockIdx.x * 64;
  if (!al.active(m0)) return;
  float acc[4][4];
#pragma unroll
  for (int i = 0; i < 4; ++i)
#pragma unroll
    for (int j = 0; j < 4; ++j) acc[i][j] = 0.f;
  for (int k0 = 0; k0 < K; k0 += 16) {
#pragma unroll
    for (int i = 0; i < 4; ++i) { const int e = tid + i * 256, r = e >> 4, kk = e & 15; As[kk][r] = al(m0 + r, k0 + kk); }
#pragma unroll
    for (int i = 0; i < 4; ++i) { const int e = tid + i * 256, kk = e >> 6, c = e & 63; Bs[kk][c] = bl(m0, k0 + kk, n0 + c); }
    __syncthreads();
#pragma unroll
    for (int kk = 0; kk < 16; ++kk) {
      const float4 a = *(const float4*)&As[kk][ty * 4];
      const float4 b = *(const float4*)&Bs[kk][tx * 4];
      const float av[4] = {a.x, a.y, a.z, a.w}, bv[4] = {b.x, b.y, b.z, b.w};
#pragma unroll
      for (int i = 0; i < 4; ++i)
#pragma unroll
        for (int j = 0; j < 4; ++j) acc[i][j] += av[i] * bv[j];
    }
    __syncthreads();
  }
#pragma unroll
  for (int i = 0; i < 4; ++i)
#pragma unroll
    for (int j = 0; j < 4; ++j) ep(m0 + ty * 4 + i, n0 + tx * 4 + j, acc[i][j]);
}

struct AL_bf16 { const bf16_t* A; int lda, M; __device__ bool active(int) const { return true; } __device__ float operator()(int m, int k) const { return m < M ? bf2f(A[(size_t)m * lda + k]) : 0.f; } };
struct AL_f32 { const float* A; int lda, M; __device__ bool active(int) const { return true; } __device__ float operator()(int m, int k) const { return m < M ? A[(size_t)m * lda + k] : 0.f; } };
struct BL_f32 { const float* B; int ldb, N; __device__ float operator()(int, int k, int n) const { return n < N ? B[(size_t)k * ldb + n] : 0.f; } };

struct EP_proj {
  bf16_t *QA, *QB, *KVC, *KVS, *KVW, *KVB, *GM; float* GN;
  __device__ void operator()(int m, int c, float v) const {
    if (c >= INW) return;
    if (c < 512) QA[(size_t)m * 512 + c] = f2bf(v);
    else if (c < 768) KVC[(size_t)m * 256 + (c - 512)] = f2bf(v);
    else if (c < 1024) KVS[(size_t)m * 256 + (c - 768)] = f2bf(v);
    else if (c < 1280) KVW[(size_t)m * 256 + (c - 1024)] = f2bf(v);
    else if (c < 1304) GN[(size_t)m * 32 + (c - 1280)] = sigmoidf_(v);
    else if (c < 1816) QB[(size_t)m * 512 + (c - 1304)] = f2bf(v);
    else if (c < 2072) KVB[(size_t)m * 256 + (c - 1816)] = f2bf(v);
    else GM[(size_t)m * 2048 + (c - 2072)] = f2bf(sigmoidf_(v));
  }
};
struct AL_cmp { const bf16_t* KVC; const float* pos; int sel; __device__ bool active(int) const { return true; }
  __device__ float operator()(int m, int k) const { if (m >= 2032) return 0.f; const int h = m & 1, bc = m >> 1, b = bc / 127, c = bc % 127, i = k >> 6, d = k & 63;
    return bf2f(KVC[((size_t)b * S + 16 * c + i) * 256 + sel * 128 + h * 64 + d]) + pos[k]; } };
struct EP_silu { float* T; int M, N; __device__ void operator()(int m, int n, float v) const { if (m < M && n < N) T[(size_t)m * N + n] = v / (1.f + __expf(-v)); } };
struct EP_kc { bf16_t* KC; __device__ void operator()(int m, int n, float v) const { if (m >= 2032 || n >= 64) return; const int h = m & 1, bc = m >> 1, b = bc / 127, c = bc % 127; KC[(((size_t)b * 128 + c) * 2 + h) * 64 + n] = f2bf(v); } };
struct EP_mg1 { float* tmp; const bf16_t* GM; __device__ void operator()(int m, int n, float v) const { tmp[(size_t)m * 1024 + n] = bf2f(GM[(size_t)m * 2048 + n]) * v; } };
struct EP_mg2 { const float* tmp; const bf16_t* GM; bf16_t* MG; __device__ void operator()(int m, int n, float v) const { MG[(size_t)m * 1024 + n] = f2bf(tmp[(size_t)m * 1024 + n] + bf2f(GM[(size_t)m * 2048 + 1024 + n]) * v); } };
struct EP_x1 { const float* x; float* out; __device__ void operator()(int m, int n, float v) const { out[(size_t)m * 1024 + n] = x[(size_t)m * 1024 + n] + v; } };
struct AL_moe { const bf16_t* H2; const int* rowtok; const int* tile_e; __device__ bool active(int m0) const { return tile_e[m0 >> 8] >= 0; }
  __device__ float operator()(int m, int k) const { const int t = rowtok[m]; return t >= 0 ? bf2f(H2[(size_t)t * 1024 + k]) : 0.f; } };
struct BL_moe { const float* W; const int* tile_e; int K, N; __device__ float operator()(int m0, int k, int n) const { const int e = tile_e[m0 >> 8]; return W[((size_t)e * K + k) * N + n]; } };
struct EP_g { float* G; __device__ void operator()(int m, int n, float v) const { G[(size_t)m * 256 + n] = v; } };
struct EP_hb { const float* G; bf16_t* HB; __device__ void operator()(int m, int n, float v) const { const float g = G[(size_t)m * 256 + n]; HB[(size_t)m * 256 + n] = f2bf(g / (1.f + __expf(-g)) * v); } };
struct AL_hb { const bf16_t* HB; const int* tile_e; __device__ bool active(int m0) const { return tile_e[m0 >> 8] >= 0; } __device__ float operator()(int m, int k) const { return bf2f(HB[(size_t)m * 256 + k]); } };
struct EP_ys { bf16_t* YS; __device__ void operator()(int m, int n, float v) const { YS[(size_t)m * 1024 + n] = f2bf(v); } };

__global__ void __launch_bounds__(256) k_nsa_naive(const bf16_t* __restrict__ QA, const bf16_t* __restrict__ KC, const bf16_t* __restrict__ VC, const bf16_t* __restrict__ KVS,
                                                   const bf16_t* __restrict__ KVW, const float* __restrict__ GN, bf16_t* __restrict__ OA) {
  const int item = blockIdx.x, t = item & 2047, hkv = (item >> 11) & 1, b = item >> 12;
  const int tid = threadIdx.x, g = tid >> 6, lane = tid & 63, head = hkv * 4 + g;
  __shared__ float q[4][64];
  __shared__ float pc[4][128];
  __shared__ float sc[4][512];
  __shared__ float sscore[32];
  __shared__ int sel_idx[8];
  __shared__ int sel_valid[8];
  const float slope = exp2f(-0.5f * (float)(9 + head));
  const size_t row = (size_t)b * S + t;
  q[g][lane] = bf2f(QA[row * 512 + head * 64 + lane]) * 0.125f;
  __syncthreads();
  {
    float sv[2]; bool vv[2]; float m = -1e30f;
#pragma unroll
    for (int i = 0; i < 2; ++i) {
      const int c = lane + 64 * i, dist = t - (16 * c + 31); vv[i] = (c < 127) && dist >= 0; float s = 0.f;
      if (vv[i]) { const bf16_t* kr = KC + (((size_t)b * 128 + c) * 2 + hkv) * 64; for (int d = 0; d < 64; ++d) s += q[g][d] * bf2f(kr[d]); s -= slope * (float)dist; m = fmaxf(m, s); }
      sv[i] = s;
    }
    m = wave_max(m);
    float z = 0.f;
#pragma unroll
    for (int i = 0; i < 2; ++i) { sv[i] = vv[i] ? __expf(sv[i] - m) : 0.f; z += sv[i]; }
    z = wave_sum(z);
    const float inv = z > 0.f ? 1.f / z : 1.f;
#pragma unroll
    for (int i = 0; i < 2; ++i) pc[g][lane + 64 * i] = sv[i] * inv;
  }
  __syncthreads();
  float ocmp = 0.f;
  {
    int ncv = (t >= 31) ? (t - 31) / 16 + 1 : 0; if (ncv > 127) ncv = 127;
    for (int c = 0; c < ncv; ++c) ocmp += pc[g][c] * bf2f(VC[(((size_t)b * 128 + c) * 2 + hkv) * 64 + lane]);
  }
  if (tid < 32) {
    const int j = tid;
    float ps[5];
#pragma unroll
    for (int u = 0; u < 5; ++u) { const int c = 4 * j - 1 + u; ps[u] = (c >= 0 && c < 127) ? (pc[0][c] + pc[1][c] + pc[2][c] + pc[3][c]) : 0.f; }
    const float imp = 0.5f * ps[0] + ps[1] + ps[2] + ps[3] + 0.5f * ps[4];
    const int cur = t >> 6; const bool forced = (j == 0) || (j == cur) || (j == cur - 1), valid = j <= cur;
    sscore[j] = forced ? 1e9f : (valid ? imp : -1e30f);
  }
  __syncthreads();
  if (tid < 32) {
    const int j = tid; const float sj = sscore[j]; int rank = 0;
    for (int i = 0; i < 32; ++i) { const float si = sscore[i]; rank += ((si > sj) || (si == sj && i < j)) ? 1 : 0; }
    if (rank < 8) { sel_idx[rank] = j; sel_valid[rank] = sj > -5e29f ? 1 : 0; }
  }
  __syncthreads();
  float oslc = 0.f;
  {
    float s8[8]; float m = -1e30f;
#pragma unroll
    for (int i = 0; i < 8; ++i) {
      const int kpos = sel_idx[i] * 64 + lane; const bool ok = sel_valid[i] && kpos <= t; float s = -1e30f;
      if (ok) { const bf16_t* kr = KVS + ((size_t)b * S + kpos) * 256 + hkv * 64; s = 0.f; for (int d = 0; d < 64; ++d) s += q[g][d] * bf2f(kr[d]); s -= slope * (float)(t - kpos); m = fmaxf(m, s); }
      s8[i] = s;
    }
    m = wave_max(m);
    float z = 0.f;
#pragma unroll
    for (int i = 0; i < 8; ++i) { const float p = s8[i] > -5e29f ? __expf(s8[i] - m) : 0.f; sc[g][i * 64 + lane] = p; z += p; }
    z = wave_sum(z);
    __syncthreads();
    for (int i = 0; i < 8; ++i) {
      if (!sel_valid[i]) continue;
      const int k0 = sel_idx[i] * 64;
      for (int l = 0; l < 64; ++l) { const int kpos = k0 + l; if (kpos > t) break; oslc += sc[g][i * 64 + l] * bf2f(KVS[((size_t)b * S + kpos) * 256 + 128 + hkv * 64 + lane]); }
    }
    oslc *= (z > 0.f ? 1.f / z : 1.f);
    __syncthreads();
  }
  float owin = 0.f;
  {
    float s4[4]; float m = -1e30f;
#pragma unroll
    for (int i = 0; i < 4; ++i) {
      const int dist = lane + 64 * i, kpos = t - dist; float s = -1e30f;
      if (kpos >= 0) { const bf16_t* kr = KVW + ((size_t)b * S + kpos) * 256 + hkv * 64; s = 0.f; for (int d = 0; d < 64; ++d) s += q[g][d] * bf2f(kr[d]); s -= slope * (float)dist; m = fmaxf(m, s); }
      s4[i] = s;
    }
    m = wave_max(m);
    float z = 0.f;
#pragma unroll
    for (int i = 0; i < 4; ++i) { const float p = s4[i] > -5e29f ? __expf(s4[i] - m) : 0.f; sc[g][i * 64 + lane] = p; z += p; }
    z = wave_sum(z);
    __syncthreads();
    for (int dist = 0; dist < 256; ++dist) { const int kpos = t - dist; if (kpos < 0) break; owin += sc[g][dist] * bf2f(KVW[((size_t)b * S + kpos) * 256 + 128 + hkv * 64 + lane]); }
    owin /= z;
  }
  const float* gn = GN + row * 32 + hkv * 12 + g * 3;
  const float o = gn[0] * ocmp + gn[1] * oslc + gn[2] * owin;
  OA[row * 512 + head * 64 + lane] = f2bf(o);
}

__global__ void __launch_bounds__(256) k_swa_naive(const bf16_t* __restrict__ QB, const bf16_t* __restrict__ KVB, const float* __restrict__ sinks, bf16_t* __restrict__ OB) {
  const int item = blockIdx.x, t = item & 2047, hkv = (item >> 11) & 1, b = item >> 12;
  const int tid = threadIdx.x, g = tid >> 6, lane = tid & 63, head = hkv * 4 + g;
  __shared__ float q[4][64];
  __shared__ float sc[4][128];
  const float slope = exp2f(-0.5f * (float)(1 + head));
  const float sink = sinks[head];
  const size_t row = (size_t)b * S + t;
  q[g][lane] = bf2f(QB[row * 512 + head * 64 + lane]) * 0.125f;
  __syncthreads();
  float s2[2]; float m = sink;
#pragma unroll
  for (int i = 0; i < 2; ++i) {
    const int dist = lane + 64 * i, kpos = t - dist; float s = -1e30f;
    if (kpos >= 0) { const bf16_t* kr = KVB + ((size_t)b * S + kpos) * 256 + hkv * 64; s = 0.f; for (int d = 0; d < 64; ++d) s += q[g][d] * bf2f(kr[d]); s -= slope * (float)dist; m = fmaxf(m, s); }
    s2[i] = s;
  }
  m = wave_max(m);
  float z = 0.f;
#pragma unroll
  for (int i = 0; i < 2; ++i) { const float p = s2[i] > -5e29f ? __expf(s2[i] - m) : 0.f; sc[g][i * 64 + lane] = p; z += p; }
  z = wave_sum(z) + __expf(sink - m);
  __syncthreads();
  float o = 0.f;
  for (int dist = 0; dist < 128; ++dist) { const int kpos = t - dist; if (kpos < 0) break; o += sc[g][dist] * bf2f(KVB[((size_t)b * S + kpos) * 256 + 128 + hkv * 64 + lane]); }
  OB[row * 512 + head * 64 + lane] = f2bf(o / z);
}

__global__ void __launch_bounds__(256) k_router(const float* __restrict__ x1, const float* __restrict__ gf, const float* __restrict__ wg, const float* __restrict__ bg, const float* __restrict__ we,
                                                const float* __restrict__ be, bf16_t* __restrict__ H2, bf16_t* __restrict__ H2LO, int* __restrict__ cnt, int* __restrict__ sm) {
  __shared__ float hs[4][1024];
  __shared__ float lgs[4][64];
  const int lane = threadIdx.x & 63, wl = threadIdx.x >> 6, wave = (blockIdx.x * 256 + threadIdx.x) >> 6, nw = (gridDim.x * 256) >> 6;
  for (int r = wave; r < NTOK; r += nw) {
    const float4* xr = (const float4*)(x1 + (size_t)r * D);
    float4 v[4]; float s = 0.f;
#pragma unroll
    for (int j = 0; j < 4; ++j) { v[j] = xr[lane + 64 * j]; s += v[j].x * v[j].x + v[j].y * v[j].y + v[j].z * v[j].z + v[j].w * v[j].w; }
    s = wave_sum(s);
    const float rstd = rsqrtf(s * (1.f / D) + 1e-6f);
#pragma unroll
    for (int j = 0; j < 4; ++j) {
      const float4 gg = ((const float4*)gf)[lane + 64 * j];
      float4 h; h.x = v[j].x * rstd * gg.x; h.y = v[j].y * rstd * gg.y; h.z = v[j].z * rstd * gg.z; h.w = v[j].w * rstd * gg.w;
      ushort4 hi, lo;
      hi.x = f2bf(h.x); hi.y = f2bf(h.y); hi.z = f2bf(h.z); hi.w = f2bf(h.w);
      lo.x = f2bf(h.x - bf2f(hi.x)); lo.y = f2bf(h.y - bf2f(hi.y)); lo.z = f2bf(h.z - bf2f(hi.z)); lo.w = f2bf(h.w - bf2f(hi.w));
      ((ushort4*)(H2 + (size_t)r * D))[lane + 64 * j] = hi;
      ((ushort4*)(H2LO + (size_t)r * D))[lane + 64 * j] = lo;
      ((float4*)hs[wl])[lane + 64 * j] = h;
    }
    __builtin_amdgcn_wave_barrier();
    asm volatile("s_waitcnt lgkmcnt(0)" ::: "memory");
    float acc = 0.f;
    if (lane < 36) {
      const float* wp = lane < 4 ? (wg + lane) : (we + (lane - 4));
      const int ld = lane < 4 ? 4 : 32;
      for (int k = 0; k < 1024; ++k) acc += hs[wl][k] * wp[(size_t)k * ld];
      acc += lane < 4 ? bg[lane] : be[lane - 4];
    }
    lgs[wl][lane] = acc;
    asm volatile("s_waitcnt lgkmcnt(0)" ::: "memory");
    __builtin_amdgcn_wave_barrier();
    if (lane == 0) {
      int grp = 0; float gmax = -1e30f;
      for (int j = 0; j < 4; ++j) { const float gl = lgs[wl][j]; if (gl > gmax) { gmax = gl; grp = j; } }
      float zs = 0.f;
      for (int j = 0; j < 4; ++j) zs += __expf(lgs[wl][j] - gmax);
      const float pgrp = 1.f / zs;
      int i1 = 0; float v1 = -1e30f;
      for (int i = 0; i < 8; ++i) { const float e = lgs[wl][4 + grp * 8 + i]; if (e > v1) { v1 = e; i1 = i; } }
      int i2 = 0; float v2 = -1e30f;
      for (int i = 0; i < 8; ++i) { const float e = lgs[wl][4 + grp * 8 + i]; if (i != i1 && e > v2) { v2 = e; i2 = i; } }
      const float e2 = __expf(v2 - v1), w1 = 1.f / (1.f + e2), w2 = e2 * w1;
      const int e_a = grp * 8 + i1, e_b = grp * 8 + i2;
      const int ra = atomicAdd(&cnt[e_a], 1), rb = atomicAdd(&cnt[e_b], 1);
      sm[SM_EID + 2 * r] = e_a; sm[SM_EID + 2 * r + 1] = e_b;
      ((float*)sm)[SM_WT + 2 * r] = pgrp * w1; ((float*)sm)[SM_WT + 2 * r + 1] = pgrp * w2;
      sm[SM_RANK + 2 * r] = ra; sm[SM_RANK + 2 * r + 1] = rb;
    }
    asm volatile("s_waitcnt lgkmcnt(0)" ::: "memory");
    __builtin_amdgcn_wave_barrier();
  }
}
__global__ void k_offsets(const int* __restrict__ cnt, int* __restrict__ sm) {
  if (threadIdx.x == 0 && blockIdx.x == 0) {
    int off = 0;
    for (int e = 0; e < 32; ++e) { sm[SM_OFF + e] = off; const int nt = (cnt[e] + 255) >> 8; for (int i = 0; i < nt; ++i) sm[SM_TILE_E + (off >> 8) + i] = e; off += nt << 8; }
    sm[SM_OFF + 32] = off;
    for (int i = off >> 8; i < NSLOT / 256; ++i) sm[SM_TILE_E + i] = -1;
  }
}
__global__ void k_fill_rowtok(int* __restrict__ sm) { const int i = blockIdx.x * blockDim.x + threadIdx.x; if (i < NSLOT) sm[SM_ROWTOK + i] = -1; }
__global__ void k_slots(int* __restrict__ sm) {
  const int i = blockIdx.x * blockDim.x + threadIdx.x;
  if (i < 2 * NTOK) { const int slot = sm[SM_OFF + sm[SM_EID + i]] + sm[SM_RANK + i]; sm[SM_SLOT + i] = slot; sm[SM_ROWTOK + slot] = i >> 1; }
}
__global__ void __launch_bounds__(256) k_final(float* __restrict__ out, const bf16_t* __restrict__ YS, const int* __restrict__ sm, const float* __restrict__ gfin) {
  const int lane = threadIdx.x & 63, wave = (blockIdx.x * 256 + threadIdx.x) >> 6, nw = (gridDim.x * 256) >> 6;
  for (int r = wave; r < NTOK; r += nw) {
    const int s0 = sm[SM_SLOT + 2 * r], s1 = sm[SM_SLOT + 2 * r + 1];
    const float w0 = ((const float*)sm)[SM_WT + 2 * r], w1 = ((const float*)sm)[SM_WT + 2 * r + 1];
    float4* xr = (float4*)(out + (size_t)r * D);
    float4 v[4]; float s = 0.f;
#pragma unroll
    for (int j = 0; j < 4; ++j) {
      v[j] = xr[lane + 64 * j];
      const ushort4 a = ((const ushort4*)(YS + (size_t)s0 * D))[lane + 64 * j], c = ((const ushort4*)(YS + (size_t)s1 * D))[lane + 64 * j];
      v[j].x += w0 * bf2f(a.x) + w1 * bf2f(c.x); v[j].y += w0 * bf2f(a.y) + w1 * bf2f(c.y); v[j].z += w0 * bf2f(a.z) + w1 * bf2f(c.z); v[j].w += w0 * bf2f(a.w) + w1 * bf2f(c.w);
      s += v[j].x * v[j].x + v[j].y * v[j].y + v[j].z * v[j].z + v[j].w * v[j].w;
    }
    s = wave_sum(s);
    const float rstd = rsqrtf(s * (1.f / D) + 1e-6f);
#pragma unroll
    for (int j = 0; j < 4; ++j) { const float4 gg = ((const float4*)gfin)[lane + 64 * j]; float4 o; o.x = v[j].x * rstd * gg.x; o.y = v[j].y * rstd * gg.y; o.z = v[j].z * rstd * gg.z; o.w = v[j].w * rstd * gg.w; xr[lane + 64 * j] = o; }
  }
}

extern "C" void kernel_launch(void* const* d_in, const int* in_sizes, int n_in, void* d_out, int out_size, void* d_ws, size_t ws_size, hipStream_t stream) {
  const float* x = (const float*)d_in[0]; const float* g_mix = (const float*)d_in[1]; const float* w_in = (const float*)d_in[2];
  const float* pos_k = (const float*)d_in[3]; const float* w1k = (const float*)d_in[4]; const float* w2k = (const float*)d_in[5];
  const float* pos_v = (const float*)d_in[6]; const float* w1v = (const float*)d_in[7]; const float* w2v = (const float*)d_in[8];
  const float* sinks = (const float*)d_in[9]; const float* w_a = (const float*)d_in[10]; const float* w_b = (const float*)d_in[11]; const float* w_o = (const float*)d_in[12];
  const float* g_ffn = (const float*)d_in[13]; const float* w_group = (const float*)d_in[14]; const float* b_group = (const float*)d_in[15];
  const float* w_expert = (const float*)d_in[16]; const float* b_expert = (const float*)d_in[17];
  const float* w_gate = (const float*)d_in[18]; const float* w_up = (const float*)d_in[19]; const float* w_down = (const float*)d_in[20]; const float* g_final = (const float*)d_in[21];
  float* out = (float*)d_out; unsigned char* ws = (unsigned char*)d_ws;
  int* cnt = (int*)(ws + WS_CTL); int* sm = (int*)(ws + WS_SMALL);
  bf16_t* XN = (bf16_t*)(ws + WS_XN); bf16_t* OA = (bf16_t*)(ws + WS_OA); bf16_t* OB = (bf16_t*)(ws + WS_OB); bf16_t* YS = (bf16_t*)(ws + WS_YS);
  bf16_t* GM = (bf16_t*)(ws + WS_GM); bf16_t* H2 = (bf16_t*)(ws + WS_H2); bf16_t* H2LO = (bf16_t*)(ws + WS_H2LO);
  bf16_t* QA = (bf16_t*)(ws + WS_QA); bf16_t* QB = (bf16_t*)(ws + WS_QB); bf16_t* KVC = (bf16_t*)(ws + WS_KVC); bf16_t* KVS = (bf16_t*)(ws + WS_KVS);
  bf16_t* KVW = (bf16_t*)(ws + WS_KVW); bf16_t* KVB = (bf16_t*)(ws + WS_KVB); bf16_t* MG = (bf16_t*)(ws + WS_MG); bf16_t* HB = (bf16_t*)(ws + WS_HB);
  float* GTMP = (float*)(ws + WS_GTMP); float* GN = (float*)(ws + WS_GN); bf16_t* KC = (bf16_t*)(ws + WS_KC); bf16_t* VC = (bf16_t*)(ws + WS_VC); float* T1 = (float*)(ws + WS_T1);

  (void)hipMemsetAsync(ws + WS_CTL, 0, 4096, stream);
  k_prep_xn<<<1024, 256, 0, stream>>>(x, g_mix, XN);
  k_fill_rowtok<<<NSLOT / 256, 256, 0, stream>>>(sm);
  k_gemm64<<<dim3((INW + 63) / 64, NTOK / 64), 256, 0, stream>>>(AL_bf16{XN, 1024, NTOK}, BL_f32{w_in, INW, INW}, EP_proj{QA, QB, KVC, KVS, KVW, KVB, GM, GN}, 1024);
  k_gemm64<<<dim3(4, 32), 256, 0, stream>>>(AL_cmp{KVC, pos_k, 0}, BL_f32{w1k, 256, 256}, EP_silu{T1, 2032, 256}, 2048);
  k_gemm64<<<dim3(1, 32), 256, 0, stream>>>(AL_f32{T1, 256, 2032}, BL_f32{w2k, 64, 64}, EP_kc{KC}, 256);
  k_gemm64<<<dim3(4, 32), 256, 0, stream>>>(AL_cmp{KVC, pos_v, 1}, BL_f32{w1v, 256, 256}, EP_silu{T1, 2032, 256}, 2048);
  k_gemm64<<<dim3(1, 32), 256, 0, stream>>>(AL_f32{T1, 256, 2032}, BL_f32{w2v, 64, 64}, EP_kc{VC}, 256);
  k_swa_naive<<<NB * 2 * S, 256, 0, stream>>>(QB, KVB, sinks, OB);
  k_nsa_naive<<<NB * 2 * S, 256, 0, stream>>>(QA, KC, VC, KVS, KVW, GN, OA);
  k_gemm64<<<dim3(16, NTOK / 64), 256, 0, stream>>>(AL_bf16{OA, 512, NTOK}, BL_f32{w_a, 1024, 1024}, EP_mg1{out, GM}, 512);
  k_gemm64<<<dim3(16, NTOK / 64), 256, 0, stream>>>(AL_bf16{OB, 512, NTOK}, BL_f32{w_b, 1024, 1024}, EP_mg2{out, GM, MG}, 512);
  k_gemm64<<<dim3(16, NTOK / 64), 256, 0, stream>>>(AL_bf16{MG, 1024, NTOK}, BL_f32{w_o, 1024, 1024}, EP_x1{x, out}, 1024);
  k_router<<<1024, 256, 0, stream>>>(out, g_ffn, w_group, b_group, w_expert, b_expert, H2, H2LO, cnt, sm);
  k_offsets<<<1, 64, 0, stream>>>(cnt, sm);
  k_slots<<<2 * NTOK / 256, 256, 0, stream>>>(sm);
  k_gemm64<<<dim3(4, NSLOT / 64), 256, 0, stream>>>(AL_moe{H2, sm + SM_ROWTOK, sm + SM_TILE_E}, BL_moe{w_gate, sm + SM_TILE_E, 1024, 256}, EP_g{GTMP}, 1024);
  k_gemm64<<<dim3(4, NSLOT / 64), 256, 0, stream>>>(AL_moe{H2, sm + SM_ROWTOK, sm + SM_TILE_E}, BL_moe{w_up, sm + SM_TILE_E, 1024, 256}, EP_hb{GTMP, HB}, 1024);
  k_gemm64<<<dim3(16, NSLOT / 64), 256, 0, stream>>>(AL_hb{HB, sm + SM_TILE_E}, BL_moe{w_down, sm + SM_TILE_E, 256, 1024}, EP_ys{YS}, 256);
  k_final<<<1024, 256, 0, stream>>>(out, YS, sm, g_final);
}
```

```cpp
#include <hip/hip_runtime.h>
#include <stdint.h>
#include <cstdio>

typedef unsigned short bf16_t;
#define LAS __attribute__((address_space(3)))
__device__ __forceinline__ float bf2f(bf16_t v) { return __uint_as_float(((unsigned)v) << 16); }
__device__ __forceinline__ bf16_t f2bf(float f) { unsigned u = __float_as_uint(f); return (bf16_t)((u + 0x7fffu + ((u >> 16) & 1u)) >> 16); }
__device__ __forceinline__ float wave_sum(float v) {
#pragma unroll
  for (int o = 1; o < 64; o <<= 1) v += __shfl_xor(v, o);
  return v;
}
__device__ __forceinline__ float wave_max(float v) {
#pragma unroll
  for (int o = 1; o < 64; o <<= 1) v = fmaxf(v, __shfl_xor(v, o));
  return v;
}
__device__ __forceinline__ float sigmoidf_(float v) { return 1.f / (1.f + __expf(-v)); }

constexpr int NB = 8, S = 2048, D = 1024, NTOK = NB * S;
constexpr int INW = 4120;
constexpr int NSLOT = 40960;
constexpr size_t MiB = 1u << 20;
constexpr size_t WS_CTL = 0;
constexpr int CW_CNT = 4096;
constexpr size_t CTL_ZERO_BYTES = 65536;
constexpr size_t WS_SMALL = 1 * MiB;
constexpr size_t WS_LIST = 2 * MiB;
constexpr size_t WS_XN = 66 * MiB;
constexpr size_t WS_OA = 66 * MiB, WS_OB = 82 * MiB;
constexpr size_t WS_YS = 66 * MiB;
constexpr size_t WS_GM = 98 * MiB;
constexpr size_t WS_H2 = 98 * MiB, WS_H2LO = 130 * MiB;
constexpr size_t WS_QA = 162 * MiB, WS_QB = 178 * MiB, WS_KVC = 194 * MiB, WS_KVS = 202 * MiB, WS_KVW = 210 * MiB, WS_KVB = 218 * MiB;
constexpr size_t WS_MG = 162 * MiB;
constexpr size_t WS_HB = 162 * MiB;
constexpr size_t WS_GTMP = 182 * MiB;
constexpr size_t WS_GN = 226 * MiB;
constexpr size_t WS_KC = 228 * MiB, WS_VC = WS_KC + 256 * 1024, WS_T1K = 229 * MiB, WS_T1V = 231 * MiB;
constexpr int SM_EID = 0, SM_WT = SM_EID + 2 * NTOK, SM_RANK = SM_WT + 2 * NTOK;
static_assert((SM_RANK + 2 * NTOK) * 4 <= (int)MiB, "small");

constexpr int LDS_BYTES = 147456;
constexpr int MISC_OFF = 131072 + 320;

#define XB_TMO      128
#define XB_XCNT(j)  (256  + 64 * (j))
#define XB_XSUB(j)  (1280 + 64 * (j))
#define XB_XGEN(j)  (2304 + 64 * (j))
#define XB_TOP      3328
#define XB_TOPGEN   3392
#define XCD_BAR_WORDS 3456
#define XB_SPIN_CAP (1u << 20)
__device__ __forceinline__ unsigned xb_ld(unsigned* p)              { return __hip_atomic_load(p, __ATOMIC_RELAXED, __HIP_MEMORY_SCOPE_AGENT); }
__device__ __forceinline__ unsigned xb_add(unsigned* p, unsigned v) { return __hip_atomic_fetch_add(p, v, __ATOMIC_RELAXED, __HIP_MEMORY_SCOPE_AGENT); }
__device__ __forceinline__ unsigned xb_xcc_id() { return (unsigned)__builtin_amdgcn_s_getreg((3 << 11) | 20) & 0xFu; }
#define XB_SPIN(cond, bar) do { unsigned _sp = 0; while (cond) { __builtin_amdgcn_s_sleep(1); \
    if ((++_sp & 255u) == 0u) { if (xb_ld(&(bar)[XB_TMO])) break; if (_sp > XB_SPIN_CAP) { atomicAdd(&(bar)[XB_TMO], 1u); break; } } } } while (0)
struct XcdBarrier { unsigned* bar; unsigned x; volatile LAS unsigned* st; };
__device__ __forceinline__ XcdBarrier xcd_barrier_post(unsigned* bar, volatile LAS unsigned* st) {
    XcdBarrier b; b.bar = bar; b.x = xb_xcc_id(); b.st = st;
    if (threadIdx.x == 0) (void)xb_add(&bar[XB_XCNT(b.x)], 1u);
    return b;
}
__device__ __forceinline__ void xcd_barrier_complete(unsigned* bar, unsigned x, unsigned& nloc, unsigned& nx) {
    const unsigned G = gridDim.x * gridDim.y * gridDim.z;
    unsigned sum, cnt, mine, sp = 0u;
    for (;;) {
        sum = 0u; cnt = 0u; mine = 0u;
#pragma unroll
        for (unsigned j = 0; j < 16; ++j) { const unsigned c = xb_ld(&bar[XB_XCNT(j)]); sum += c; cnt += (c > 0u) ? 1u : 0u; mine = (j == x) ? c : mine; }
        if (sum == G) break;
        __builtin_amdgcn_s_sleep(1);
        if ((++sp & 255u) == 0u) { if (xb_ld(&bar[XB_TMO])) break; if (sp > XB_SPIN_CAP) { atomicAdd(&bar[XB_TMO], 1u); break; } }
    }
    nloc = mine > 0u ? mine : 1u; nx = cnt > 0u ? cnt : 1u;
}
__device__ __forceinline__ void xcd_barrier(const XcdBarrier& b) {
    asm volatile("s_waitcnt vmcnt(0)" ::: "memory");
    __syncthreads();
    if (threadIdx.x == 0) {
        unsigned* bar = b.bar;
        __builtin_amdgcn_s_waitcnt(0);
        unsigned nloc = b.st[0], nx = b.st[1];
        if (nloc == 0u) { xcd_barrier_complete(bar, b.x, nloc, nx); b.st[0] = nloc; b.st[1] = nx; }
        const unsigned old = xb_add(&bar[XB_XSUB(b.x)], 1u);
        const unsigned gen = old / nloc;
        if (old + 1u == (gen + 1u) * nloc) {
            __builtin_amdgcn_fence(__ATOMIC_RELEASE, "agent");
            asm volatile("s_waitcnt vmcnt(0)" ::: "memory");
            const unsigned og = xb_add(&bar[XB_TOP], 1u);
            const unsigned tg = og / nx;
            if (og + 1u == (tg + 1u) * nx) xb_add(&bar[XB_TOPGEN], 1u);
            else XB_SPIN(xb_ld(&bar[XB_TOPGEN]) == tg, bar);
            __builtin_amdgcn_fence(__ATOMIC_ACQUIRE, "agent");
            xb_add(&bar[XB_XGEN(b.x)], 1u);
            asm volatile("s_waitcnt vmcnt(0)" ::: "memory");
        } else {
            XB_SPIN(xb_ld(&bar[XB_XGEN(b.x)]) == gen, bar);
            __builtin_amdgcn_fence(__ATOMIC_ACQUIRE, "agent");
            asm volatile("s_waitcnt vmcnt(0)" ::: "memory");
        }
    }
    __syncthreads();
}

__device__ __forceinline__ void ph_prep_xn(const float* __restrict__ x, const float* __restrict__ g, bf16_t* __restrict__ xn) {
  const int lane = threadIdx.x & 63, wave = (blockIdx.x * 512 + threadIdx.x) >> 6, nw = (gridDim.x * 512) >> 6;
  for (int r = wave; r < NTOK; r += nw) {
    const float4* xr = (const float4*)(x + (size_t)r * D);
    float4 v[4]; float s = 0.f;
#pragma unroll
    for (int j = 0; j < 4; ++j) { v[j] = xr[lane + 64 * j]; s += v[j].x * v[j].x + v[j].y * v[j].y + v[j].z * v[j].z + v[j].w * v[j].w; }
    s = wave_sum(s);
    const float rstd = rsqrtf(s * (1.f / D) + 1e-6f);
#pragma unroll
    for (int j = 0; j < 4; ++j) {
      const float4 gg = ((const float4*)g)[lane + 64 * j];
      ushort4 o; o.x = f2bf(v[j].x * rstd * gg.x); o.y = f2bf(v[j].y * rstd * gg.y); o.z = f2bf(v[j].z * rstd * gg.z); o.w = f2bf(v[j].w * rstd * gg.w);
      ((ushort4*)(xn + (size_t)r * D))[lane + 64 * j] = o;
    }
  }
}

template <class AL, class BL, class EP>
__device__ __forceinline__ void naive_gemm_phase(unsigned char* lds, const AL al, const BL bl, const EP ep, int K, int ntm, int ntn) {
  const int half = threadIdx.x >> 8, tid = threadIdx.x & 255, tx = tid & 15, ty = tid >> 4;
  float (*As)[68] = (float (*)[68])(lds + half * 8704);
  float (*Bs)[68] = As + 16;
  const int ntiles = ntm * ntn;
  for (int it0 = blockIdx.x * 2; it0 < ntiles; it0 += 2 * gridDim.x) {
    const int it = it0 + half, tm = it / ntn, tn = it - tm * ntn, m0 = tm * 64, n0 = tn * 64;
    const bool act = it < ntiles && al.active(m0);
    float acc[4][4];
#pragma unroll
    for (int i = 0; i < 4; ++i)
#pragma unroll
      for (int j = 0; j < 4; ++j) acc[i][j] = 0.f;
    for (int k0 = 0; k0 < K; k0 += 16) {
#pragma unroll
      for (int i = 0; i < 4; ++i) { const int e = tid + i * 256, r = e >> 4, kk = e & 15; As[kk][r] = act ? al(m0 + r, k0 + kk) : 0.f; }
#pragma unroll
      for (int i = 0; i < 4; ++i) { const int e = tid + i * 256, kk = e >> 6, c = e & 63; Bs[kk][c] = act ? bl(m0, k0 + kk, n0 + c) : 0.f; }
      __syncthreads();
#pragma unroll
      for (int kk = 0; kk < 16; ++kk) {
        const float4 a = *(const float4*)&As[kk][ty * 4];
        const float4 b = *(const float4*)&Bs[kk][tx * 4];
        const float av[4] = {a.x, a.y, a.z, a.w}, bv[4] = {b.x, b.y, b.z, b.w};
#pragma unroll
        for (int i = 0; i < 4; ++i)
#pragma unroll
          for (int j = 0; j < 4; ++j) acc[i][j] += av[i] * bv[j];
      }
      __syncthreads();
    }
    if (act) {
#pragma unroll
      for (int i = 0; i < 4; ++i)
#pragma unroll
        for (int j = 0; j < 4; ++j) ep(m0 + ty * 4 + i, n0 + tx * 4 + j, acc[i][j]);
    }
  }
}

struct AL_bf16 { const bf16_t* A; int lda, M; __device__ bool active(int) const { return true; } __device__ float operator()(int m, int k) const { return m < M ? bf2f(A[(size_t)m * lda + k]) : 0.f; } };
struct AL_f32 { const float* A; int lda, M; __device__ bool active(int) const { return true; } __device__ float operator()(int m, int k) const { return m < M ? A[(size_t)m * lda + k] : 0.f; } };
struct BL_f32 { const float* B; int ldb, N; __device__ float operator()(int, int k, int n) const { return n < N ? B[(size_t)k * ldb + n] : 0.f; } };
struct EP_proj {
  bf16_t *QA, *QB, *KVC, *KVS, *KVW, *KVB, *GM; float* GN;
  __device__ void operator()(int m, int c, float v) const {
    if (c >= INW) return;
    if (c < 512) QA[(size_t)m * 512 + c] = f2bf(v);
    else if (c < 768) KVC[(size_t)m * 256 + (c - 512)] = f2bf(v);
    else if (c < 1024) KVS[(size_t)m * 256 + (c - 768)] = f2bf(v);
    else if (c < 1280) KVW[(size_t)m * 256 + (c - 1024)] = f2bf(v);
    else if (c < 1304) GN[(size_t)m * 32 + (c - 1280)] = sigmoidf_(v);
    else if (c < 1816) QB[(size_t)m * 512 + (c - 1304)] = f2bf(v);
    else if (c < 2072) KVB[(size_t)m * 256 + (c - 1816)] = f2bf(v);
    else GM[(size_t)m * 2048 + (c - 2072)] = f2bf(sigmoidf_(v));
  }
};
struct AL_cmp { const bf16_t* KVC; const float* pos; int sel; __device__ bool active(int) const { return true; }
  __device__ float operator()(int m, int k) const { if (m >= 2032) return 0.f; const int h = m & 1, bc = m >> 1, b = bc / 127, c = bc % 127, i = k >> 6, d = k & 63;
    return bf2f(KVC[((size_t)b * S + 16 * c + i) * 256 + sel * 128 + h * 64 + d]) + pos[k]; } };
struct EP_silu { float* T; int M, N; __device__ void operator()(int m, int n, float v) const { if (m < M && n < N) T[(size_t)m * N + n] = v / (1.f + __expf(-v)); } };
struct EP_kc { bf16_t* KC; __device__ void operator()(int m, int n, float v) const { if (m >= 2032 || n >= 64) return; const int h = m & 1, bc = m >> 1, b = bc / 127, c = bc % 127; KC[(((size_t)b * 128 + c) * 2 + h) * 64 + n] = f2bf(v); } };
struct EP_mg1 { float* tmp; const bf16_t* GM; __device__ void operator()(int m, int n, float v) const { tmp[(size_t)m * 1024 + n] = bf2f(GM[(size_t)m * 2048 + n]) * v; } };
struct EP_mg2 { const float* tmp; const bf16_t* GM; bf16_t* MG; __device__ void operator()(int m, int n, float v) const { MG[(size_t)m * 1024 + n] = f2bf(tmp[(size_t)m * 1024 + n] + bf2f(GM[(size_t)m * 2048 + 1024 + n]) * v); } };
struct EP_x1 { const float* x; float* out; __device__ void operator()(int m, int n, float v) const { out[(size_t)m * 1024 + n] = x[(size_t)m * 1024 + n] + v; } };
struct AL_moe { const bf16_t* H2; const int* list; const int* cnt; const int* l_off; const int* l_te; __device__ bool active(int m0) const { return l_te[m0 >> 8] >= 0; }
  __device__ float operator()(int m, int k) const { const int e = l_te[m >> 8], r = m - l_off[e]; if (r >= cnt[e]) return 0.f; const int t = list[(size_t)e * NTOK + r]; return bf2f(H2[(size_t)t * 1024 + k]); } };
struct BL_moe { const float* W; const int* l_te; int K, N; __device__ float operator()(int m0, int k, int n) const { const int e = l_te[m0 >> 8]; return W[((size_t)e * K + k) * N + n]; } };
struct EP_g { float* G; __device__ void operator()(int m, int n, float v) const { G[(size_t)m * 256 + n] = v; } };
struct EP_hb { const float* G; bf16_t* HB; __device__ void operator()(int m, int n, float v) const { const float g = G[(size_t)m * 256 + n]; HB[(size_t)m * 256 + n] = f2bf(g / (1.f + __expf(-g)) * v); } };
struct AL_hb { const bf16_t* HB; const int* l_te; __device__ bool active(int m0) const { return l_te[m0 >> 8] >= 0; } __device__ float operator()(int m, int k) const { return bf2f(HB[(size_t)m * 256 + k]); } };
struct EP_ys { bf16_t* YS; __device__ void operator()(int m, int n, float v) const { YS[(size_t)m * 1024 + n] = f2bf(v); } };

__device__ __forceinline__ void moe_tables(const int* cnt, int* l_off, int* l_te) {
  __syncthreads();
  if (threadIdx.x == 0) {
    int off = 0;
    for (int e = 0; e < 32; ++e) { l_off[e] = off; const int c = __hip_atomic_load(cnt + e, __ATOMIC_RELAXED, __HIP_MEMORY_SCOPE_AGENT); const int nt = (c + 255) >> 8; for (int i = 0; i < nt; ++i) l_te[(off >> 8) + i] = e; off += nt << 8; }
    l_off[32] = off;
    for (int i = off >> 8; i < NSLOT / 256; ++i) l_te[i] = -1;
  }
  __syncthreads();
}

__device__ __forceinline__ void naive_nsa_phase(unsigned char* lds, const bf16_t* __restrict__ QA, const bf16_t* __restrict__ KC, const bf16_t* __restrict__ VC, const bf16_t* __restrict__ KVS,
                                                const bf16_t* __restrict__ KVW, const float* __restrict__ GN, bf16_t* __restrict__ OA) {
  const int half = threadIdx.x >> 8, tid = threadIdx.x & 255, g = tid >> 6, lane = tid & 63;
  unsigned char* base = lds + half * 12288;
  float (*q)[64] = (float (*)[64])base;
  float (*pc)[128] = (float (*)[128])(base + 1024);
  float (*sc)[512] = (float (*)[512])(base + 3072);
  float* sscore = (float*)(base + 11264);
  int* sel_idx = (int*)(base + 11264 + 128);
  int* sel_valid = (int*)(base + 11264 + 160);
  for (int item = blockIdx.x * 2 + half; item < NB * 2 * S; item += 2 * gridDim.x) {
    const int t = item & 2047, hkv = (item >> 11) & 1, b = item >> 12, head = hkv * 4 + g;
    const float slope = exp2f(-0.5f * (float)(9 + head));
    const size_t row = (size_t)b * S + t;
    q[g][lane] = bf2f(QA[row * 512 + head * 64 + lane]) * 0.125f;
    __syncthreads();
    {
      float sv[2]; bool vv[2]; float m = -1e30f;
#pragma unroll
      for (int i = 0; i < 2; ++i) {
        const int c = lane + 64 * i, dist = t - (16 * c + 31); vv[i] = (c < 127) && dist >= 0; float s = 0.f;
        if (vv[i]) { const bf16_t* kr = KC + (((size_t)b * 128 + c) * 2 + hkv) * 64; for (int d = 0; d < 64; ++d) s += q[g][d] * bf2f(kr[d]); s -= slope * (float)dist; m = fmaxf(m, s); }
        sv[i] = s;
      }
      m = wave_max(m);
      float z = 0.f;
#pragma unroll
      for (int i = 0; i < 2; ++i) { sv[i] = vv[i] ? __expf(sv[i] - m) : 0.f; z += sv[i]; }
      z = wave_sum(z);
      const float inv = z > 0.f ? 1.f / z : 1.f;
#pragma unroll
      for (int i = 0; i < 2; ++i) pc[g][lane + 64 * i] = sv[i] * inv;
    }
    __syncthreads();
    float ocmp = 0.f;
    {
      int ncv = (t >= 31) ? (t - 31) / 16 + 1 : 0; if (ncv > 127) ncv = 127;
      for (int c = 0; c < ncv; ++c) ocmp += pc[g][c] * bf2f(VC[(((size_t)b * 128 + c) * 2 + hkv) * 64 + lane]);
    }
    if (tid < 32) {
      const int j = tid;
      float ps[5];
#pragma unroll
      for (int u = 0; u < 5; ++u) { const int c = 4 * j - 1 + u; ps[u] = (c >= 0 && c < 127) ? (pc[0][c] + pc[1][c] + pc[2][c] + pc[3][c]) : 0.f; }
      const float imp = 0.5f * ps[0] + ps[1] + ps[2] + ps[3] + 0.5f * ps[4];
      const int cur = t >> 6; const bool forced = (j == 0) || (j == cur) || (j == cur - 1), valid = j <= cur;
      sscore[j] = forced ? 1e9f : (valid ? imp : -1e30f);
    }
    __syncthreads();
    if (tid < 32) {
      const int j = tid; const float sj = sscore[j]; int rank = 0;
      for (int i = 0; i < 32; ++i) { const float si = sscore[i]; rank += ((si > sj) || (si == sj && i < j)) ? 1 : 0; }
      if (rank < 8) { sel_idx[rank] = j; sel_valid[rank] = sj > -5e29f ? 1 : 0; }
    }
    __syncthreads();
    float oslc = 0.f;
    {
      float s8[8]; float m = -1e30f;
#pragma unroll
      for (int i = 0; i < 8; ++i) {
        const int kpos = sel_idx[i] * 64 + lane; const bool ok = sel_valid[i] && kpos <= t; float s = -1e30f;
        if (ok) { const bf16_t* kr = KVS + ((size_t)b * S + kpos) * 256 + hkv * 64; s = 0.f; for (int d = 0; d < 64; ++d) s += q[g][d] * bf2f(kr[d]); s -= slope * (float)(t - kpos); m = fmaxf(m, s); }
        s8[i] = s;
      }
      m = wave_max(m);
      float z = 0.f;
#pragma unroll
      for (int i = 0; i < 8; ++i) { const float p = s8[i] > -5e29f ? __expf(s8[i] - m) : 0.f; sc[g][i * 64 + lane] = p; z += p; }
      z = wave_sum(z);
      __syncthreads();
      for (int i = 0; i < 8; ++i) {
        if (!sel_valid[i]) continue;
        const int k0 = sel_idx[i] * 64;
        for (int l = 0; l < 64; ++l) { const int kpos = k0 + l; if (kpos > t) break; oslc += sc[g][i * 64 + l] * bf2f(KVS[((size_t)b * S + kpos) * 256 + 128 + hkv * 64 + lane]); }
      }
      oslc *= (z > 0.f ? 1.f / z : 1.f);
      __syncthreads();
    }
    float owin = 0.f;
    {
      float s4[4]; float m = -1e30f;
#pragma unroll
      for (int i = 0; i < 4; ++i) {
        const int dist = lane + 64 * i, kpos = t - dist; float s = -1e30f;
        if (kpos >= 0) { const bf16_t* kr = KVW + ((size_t)b * S + kpos) * 256 + hkv * 64; s = 0.f; for (int d = 0; d < 64; ++d) s += q[g][d] * bf2f(kr[d]); s -= slope * (float)dist; m = fmaxf(m, s); }
        s4[i] = s;
      }
      m = wave_max(m);
      float z = 0.f;
#pragma unroll
      for (int i = 0; i < 4; ++i) { const float p = s4[i] > -5e29f ? __expf(s4[i] - m) : 0.f; sc[g][i * 64 + lane] = p; z += p; }
      z = wave_sum(z);
      __syncthreads();
      for (int dist = 0; dist < 256; ++dist) { const int kpos = t - dist; if (kpos < 0) break; owin += sc[g][dist] * bf2f(KVW[((size_t)b * S + kpos) * 256 + 128 + hkv * 64 + lane]); }
      owin /= z;
    }
    const float* gn = GN + row * 32 + hkv * 12 + g * 3;
    OA[row * 512 + head * 64 + lane] = f2bf(gn[0] * ocmp + gn[1] * oslc + gn[2] * owin);
    __syncthreads();
  }
}

__device__ __forceinline__ void naive_swa_phase(unsigned char* lds, const bf16_t* __restrict__ QB, const bf16_t* __restrict__ KVB, const float* __restrict__ sinks, bf16_t* __restrict__ OB) {
  const int half = threadIdx.x >> 8, tid = threadIdx.x & 255, g = tid >> 6, lane = tid & 63;
  unsigned char* base = lds + half * 4096;
  float (*q)[64] = (float (*)[64])base;
  float (*sc)[128] = (float (*)[128])(base + 1024);
  for (int item = blockIdx.x * 2 + half; item < NB * 2 * S; item += 2 * gridDim.x) {
    const int t = item & 2047, hkv = (item >> 11) & 1, b = item >> 12, head = hkv * 4 + g;
    const float slope = exp2f(-0.5f * (float)(1 + head));
    const float sink = sinks[head];
    const size_t row = (size_t)b * S + t;
    q[g][lane] = bf2f(QB[row * 512 + head * 64 + lane]) * 0.125f;
    __syncthreads();
    float s2[2]; float m = sink;
#pragma unroll
    for (int i = 0; i < 2; ++i) {
      const int dist = lane + 64 * i, kpos = t - dist; float s = -1e30f;
      if (kpos >= 0) { const bf16_t* kr = KVB + ((size_t)b * S + kpos) * 256 + hkv * 64; s = 0.f; for (int d = 0; d < 64; ++d) s += q[g][d] * bf2f(kr[d]); s -= slope * (float)dist; m = fmaxf(m, s); }
      s2[i] = s;
    }
    m = wave_max(m);
    float z = 0.f;
#pragma unroll
    for (int i = 0; i < 2; ++i) { const float p = s2[i] > -5e29f ? __expf(s2[i] - m) : 0.f; sc[g][i * 64 + lane] = p; z += p; }
    z = wave_sum(z) + __expf(sink - m);
    __syncthreads();
    float o = 0.f;
    for (int dist = 0; dist < 128; ++dist) { const int kpos = t - dist; if (kpos < 0) break; o += sc[g][dist] * bf2f(KVB[((size_t)b * S + kpos) * 256 + 128 + hkv * 64 + lane]); }
    OB[row * 512 + head * 64 + lane] = f2bf(o / z);
    __syncthreads();
  }
}

__device__ __forceinline__ void ph_router(unsigned char* lds, const float* __restrict__ x1, const float* __restrict__ gf, const float* __restrict__ wg, const float* __restrict__ bg, const float* __restrict__ we,
                                          const float* __restrict__ be, bf16_t* __restrict__ H2, bf16_t* __restrict__ H2LO, int* __restrict__ cnt, int* __restrict__ sm, int* __restrict__ list) {
  const int lane = threadIdx.x & 63, wl = threadIdx.x >> 6, wave = (blockIdx.x * 512 + threadIdx.x) >> 6, nw = (gridDim.x * 512) >> 6;
  float* hs = (float*)lds + wl * 1024;
  float* lgs = (float*)(lds + 32768) + wl * 64;
  for (int r = wave; r < NTOK; r += nw) {
    const float4* xr = (const float4*)(x1 + (size_t)r * D);
    float4 v[4]; float s = 0.f;
#pragma unroll
    for (int j = 0; j < 4; ++j) { v[j] = xr[lane + 64 * j]; s += v[j].x * v[j].x + v[j].y * v[j].y + v[j].z * v[j].z + v[j].w * v[j].w; }
    s = wave_sum(s);
    const float rstd = rsqrtf(s * (1.f / D) + 1e-6f);
#pragma unroll
    for (int j = 0; j < 4; ++j) {
      const float4 gg = ((const float4*)gf)[lane + 64 * j];
      float4 h; h.x = v[j].x * rstd * gg.x; h.y = v[j].y * rstd * gg.y; h.z = v[j].z * rstd * gg.z; h.w = v[j].w * rstd * gg.w;
      ushort4 hi, lo;
      hi.x = f2bf(h.x); hi.y = f2bf(h.y); hi.z = f2bf(h.z); hi.w = f2bf(h.w);
      lo.x = f2bf(h.x - bf2f(hi.x)); lo.y = f2bf(h.y - bf2f(hi.y)); lo.z = f2bf(h.z - bf2f(hi.z)); lo.w = f2bf(h.w - bf2f(hi.w));
      ((ushort4*)(H2 + (size_t)r * D))[lane + 64 * j] = hi;
      ((ushort4*)(H2LO + (size_t)r * D))[lane + 64 * j] = lo;
      ((float4*)hs)[lane + 64 * j] = h;
    }
    __builtin_amdgcn_wave_barrier();
    asm volatile("s_waitcnt lgkmcnt(0)" ::: "memory");
    float acc = 0.f;
    if (lane < 36) {
      const float* wp = lane < 4 ? (wg + lane) : (we + (lane - 4));
      const int ld = lane < 4 ? 4 : 32;
      for (int k = 0; k < 1024; ++k) acc += hs[k] * wp[(size_t)k * ld];
      acc += lane < 4 ? bg[lane] : be[lane - 4];
    }
    lgs[lane] = acc;
    asm volatile("s_waitcnt lgkmcnt(0)" ::: "memory");
    __builtin_amdgcn_wave_barrier();
    if (lane == 0) {
      int grp = 0; float gmax = -1e30f;
      for (int j = 0; j < 4; ++j) { const float gl = lgs[j]; if (gl > gmax) { gmax = gl; grp = j; } }
      float zs = 0.f;
      for (int j = 0; j < 4; ++j) zs += __expf(lgs[j] - gmax);
      const float pgrp = 1.f / zs;
      int i1 = 0; float v1 = -1e30f;
      for (int i = 0; i < 8; ++i) { const float e = lgs[4 + grp * 8 + i]; if (e > v1) { v1 = e; i1 = i; } }
      int i2 = 0; float v2 = -1e30f;
      for (int i = 0; i < 8; ++i) { const float e = lgs[4 + grp * 8 + i]; if (i != i1 && e > v2) { v2 = e; i2 = i; } }
      const float e2 = __expf(v2 - v1), w1 = 1.f / (1.f + e2), w2 = e2 * w1;
      const int e_a = grp * 8 + i1, e_b = grp * 8 + i2;
      const int ra = atomicAdd(&cnt[e_a], 1), rb = atomicAdd(&cnt[e_b], 1);
      sm[SM_EID + 2 * r] = e_a; sm[SM_EID + 2 * r + 1] = e_b;
      ((float*)sm)[SM_WT + 2 * r] = pgrp * w1; ((float*)sm)[SM_WT + 2 * r + 1] = pgrp * w2;
      sm[SM_RANK + 2 * r] = ra; sm[SM_RANK + 2 * r + 1] = rb;
      list[(size_t)e_a * NTOK + ra] = r; list[(size_t)e_b * NTOK + rb] = r;
    }
    asm volatile("s_waitcnt lgkmcnt(0)" ::: "memory");
    __builtin_amdgcn_wave_barrier();
  }
}
__device__ __forceinline__ void ph_final(float* __restrict__ out, const bf16_t* __restrict__ YS, const int* __restrict__ sm, const int* l_off, const float* __restrict__ gfin) {
  const int lane = threadIdx.x & 63, wave = (blockIdx.x * 512 + threadIdx.x) >> 6, nw = (gridDim.x * 512) >> 6;
  for (int r = wave; r < NTOK; r += nw) {
    const int s0 = l_off[sm[SM_EID + 2 * r]] + sm[SM_RANK + 2 * r], s1 = l_off[sm[SM_EID + 2 * r + 1]] + sm[SM_RANK + 2 * r + 1];
    const float w0 = ((const float*)sm)[SM_WT + 2 * r], w1 = ((const float*)sm)[SM_WT + 2 * r + 1];
    float4* xr = (float4*)(out + (size_t)r * D);
    float4 v[4]; float s = 0.f;
#pragma unroll
    for (int j = 0; j < 4; ++j) {
      v[j] = xr[lane + 64 * j];
      const ushort4 a = ((const ushort4*)(YS + (size_t)s0 * D))[lane + 64 * j], c = ((const ushort4*)(YS + (size_t)s1 * D))[lane + 64 * j];
      v[j].x += w0 * bf2f(a.x) + w1 * bf2f(c.x); v[j].y += w0 * bf2f(a.y) + w1 * bf2f(c.y); v[j].z += w0 * bf2f(a.z) + w1 * bf2f(c.z); v[j].w += w0 * bf2f(a.w) + w1 * bf2f(c.w);
      s += v[j].x * v[j].x + v[j].y * v[j].y + v[j].z * v[j].z + v[j].w * v[j].w;
    }
    s = wave_sum(s);
    const float rstd = rsqrtf(s * (1.f / D) + 1e-6f);
#pragma unroll
    for (int j = 0; j < 4; ++j) { const float4 gg = ((const float4*)gfin)[lane + 64 * j]; float4 o; o.x = v[j].x * rstd * gg.x; o.y = v[j].y * rstd * gg.y; o.z = v[j].z * rstd * gg.z; o.w = v[j].w * rstd * gg.w; xr[lane + 64 * j] = o; }
  }
}

struct Args { const float* in[22]; float* out; unsigned char* ws; };
__global__ void __launch_bounds__(512, 2) mega_fwd(Args a) {
  extern __shared__ __attribute__((aligned(16))) unsigned char lds[];
  const float* x = a.in[0]; const float* g_mix = a.in[1]; const float* w_in = a.in[2];
  const float* pos_k = a.in[3]; const float* w1k = a.in[4]; const float* w2k = a.in[5];
  const float* pos_v = a.in[6]; const float* w1v = a.in[7]; const float* w2v = a.in[8];
  const float* sinks = a.in[9]; const float* w_a = a.in[10]; const float* w_b = a.in[11]; const float* w_o = a.in[12];
  const float* g_ffn = a.in[13]; const float* w_group = a.in[14]; const float* b_group = a.in[15];
  const float* w_expert = a.in[16]; const float* b_expert = a.in[17];
  const float* w_gate = a.in[18]; const float* w_up = a.in[19]; const float* w_down = a.in[20]; const float* g_final = a.in[21];
  float* out = a.out; unsigned char* ws = a.ws;
  unsigned* ctl = (unsigned*)(ws + WS_CTL);
  int* cnt = (int*)(ctl + CW_CNT); int* sm = (int*)(ws + WS_SMALL); int* list = (int*)(ws + WS_LIST);
  bf16_t* XN = (bf16_t*)(ws + WS_XN); bf16_t* OA = (bf16_t*)(ws + WS_OA); bf16_t* OB = (bf16_t*)(ws + WS_OB); bf16_t* YS = (bf16_t*)(ws + WS_YS);
  bf16_t* GM = (bf16_t*)(ws + WS_GM); bf16_t* H2 = (bf16_t*)(ws + WS_H2); bf16_t* H2LO = (bf16_t*)(ws + WS_H2LO);
  bf16_t* QA = (bf16_t*)(ws + WS_QA); bf16_t* QB = (bf16_t*)(ws + WS_QB); bf16_t* KVC = (bf16_t*)(ws + WS_KVC); bf16_t* KVS = (bf16_t*)(ws + WS_KVS);
  bf16_t* KVW = (bf16_t*)(ws + WS_KVW); bf16_t* KVB = (bf16_t*)(ws + WS_KVB); bf16_t* MG = (bf16_t*)(ws + WS_MG); bf16_t* HB = (bf16_t*)(ws + WS_HB);
  float* GTMP = (float*)(ws + WS_GTMP); float* GN = (float*)(ws + WS_GN); bf16_t* KC = (bf16_t*)(ws + WS_KC); bf16_t* VC = (bf16_t*)(ws + WS_VC);
  float* T1K = (float*)(ws + WS_T1K); float* T1V = (float*)(ws + WS_T1V);

  volatile LAS unsigned* MISC = (volatile LAS unsigned*)((LAS unsigned char*)lds + MISC_OFF);
  if (threadIdx.x < 32) MISC[threadIdx.x] = 0u;
  __syncthreads();
  XcdBarrier bar = xcd_barrier_post(ctl, MISC + 8);
  int* l_off = (int*)(lds + 131072 + 1024);
  int* l_te = (int*)(lds + 131072 + 1024 + 256);
#define GRID_BAR() xcd_barrier(bar)

  ph_prep_xn(x, g_mix, XN);
  GRID_BAR();
  naive_gemm_phase(lds, AL_bf16{XN, 1024, NTOK}, BL_f32{w_in, INW, INW}, EP_proj{QA, QB, KVC, KVS, KVW, KVB, GM, GN}, 1024, NTOK / 64, (INW + 63) / 64);
  GRID_BAR();
  naive_gemm_phase(lds, AL_cmp{KVC, pos_k, 0}, BL_f32{w1k, 256, 256}, EP_silu{T1K, 2032, 256}, 2048, 32, 4);
  naive_gemm_phase(lds, AL_cmp{KVC, pos_v, 1}, BL_f32{w1v, 256, 256}, EP_silu{T1V, 2032, 256}, 2048, 32, 4);
  naive_swa_phase(lds, QB, KVB, sinks, OB);
  GRID_BAR();
  naive_gemm_phase(lds, AL_f32{T1K, 256, 2032}, BL_f32{w2k, 64, 64}, EP_kc{KC}, 256, 32, 1);
  naive_gemm_phase(lds, AL_f32{T1V, 256, 2032}, BL_f32{w2v, 64, 64}, EP_kc{VC}, 256, 32, 1);
  GRID_BAR();
  naive_nsa_phase(lds, QA, KC, VC, KVS, KVW, GN, OA);
  GRID_BAR();
  naive_gemm_phase(lds, AL_bf16{OA, 512, NTOK}, BL_f32{w_a, 1024, 1024}, EP_mg1{out, GM}, 512, NTOK / 64, 16);
  naive_gemm_phase(lds, AL_bf16{OB, 512, NTOK}, BL_f32{w_b, 1024, 1024}, EP_mg2{out, GM, MG}, 512, NTOK / 64, 16);
  GRID_BAR();
  naive_gemm_phase(lds, AL_bf16{MG, 1024, NTOK}, BL_f32{w_o, 1024, 1024}, EP_x1{x, out}, 1024, NTOK / 64, 16);
  GRID_BAR();
  ph_router(lds, out, g_ffn, w_group, b_group, w_expert, b_expert, H2, H2LO, cnt, sm, list);
  GRID_BAR();
  moe_tables(cnt, l_off, l_te);
  naive_gemm_phase(lds, AL_moe{H2, list, cnt, l_off, l_te}, BL_moe{w_gate, l_te, 1024, 256}, EP_g{GTMP}, 1024, NSLOT / 64, 4);
  naive_gemm_phase(lds, AL_moe{H2, list, cnt, l_off, l_te}, BL_moe{w_up, l_te, 1024, 256}, EP_hb{GTMP, HB}, 1024, NSLOT / 64, 4);
  GRID_BAR();
  naive_gemm_phase(lds, AL_hb{HB, l_te}, BL_moe{w_down, l_te, 256, 1024}, EP_ys{YS}, 256, NSLOT / 64, 16);
  GRID_BAR();
  ph_final(out, YS, sm, l_off, g_final);
}

extern "C" void kernel_launch(void* const* d_in, const int* in_sizes, int n_in, void* d_out, int out_size, void* d_ws, size_t ws_size, hipStream_t stream) {
  static int grid = 0;
  if (grid == 0) {
    int dev = 0, cus = 0, per_cu = 0;
    if (hipGetDevice(&dev) != hipSuccess || hipDeviceGetAttribute(&cus, hipDeviceAttributeMultiprocessorCount, dev) != hipSuccess) { fprintf(stderr, "kernel_launch: device query failed\n"); grid = -1; return; }
    if (hipFuncSetAttribute((const void*)mega_fwd, hipFuncAttributeMaxDynamicSharedMemorySize, LDS_BYTES) != hipSuccess) { fprintf(stderr, "kernel_launch: hipFuncSetAttribute failed\n"); grid = -1; return; }
    if (hipOccupancyMaxActiveBlocksPerMultiprocessor(&per_cu, (const void*)mega_fwd, 512, LDS_BYTES) != hipSuccess || per_cu < 1) { fprintf(stderr, "kernel_launch: occupancy query says %d blocks/CU\n", per_cu); (void)hipGetLastError(); grid = -1; return; }
    grid = cus;
  }
  if (grid < 0) return;
  (void)hipMemsetAsync((char*)d_ws + WS_CTL, 0, CTL_ZERO_BYTES, stream);
  Args a{};
  for (int i = 0; i < 22; ++i) a.in[i] = (const float*)d_in[i];
  a.out = (float*)d_out; a.ws = (unsigned char*)d_ws;
  hipLaunchKernelGGL(mega_fwd, dim3(grid), dim3(512), LDS_BYTES, stream, a);
}
```

```cpp
#include <hip/hip_runtime.h>
#include <stdint.h>
#include <cstdio>

typedef unsigned short bf16_t;
#define LAS __attribute__((address_space(3)))
#define GAS __attribute__((address_space(1)))
__device__ __forceinline__ float bf2f(bf16_t v) { return __uint_as_float(((unsigned)v) << 16); }
__device__ __forceinline__ bf16_t f2bf(float f) { unsigned u = __float_as_uint(f); return (bf16_t)((u + 0x7fffu + ((u >> 16) & 1u)) >> 16); }
__device__ __forceinline__ float wave_sum(float v) {
#pragma unroll
  for (int o = 1; o < 64; o <<= 1) v += __shfl_xor(v, o);
  return v;
}
__device__ __forceinline__ float wave_max(float v) {
#pragma unroll
  for (int o = 1; o < 64; o <<= 1) v = fmaxf(v, __shfl_xor(v, o));
  return v;
}
__device__ __forceinline__ float sigmoidf_(float v) { return 1.f / (1.f + __expf(-v)); }

__device__ __forceinline__ int tid_fresh() { int t = threadIdx.x; asm volatile("" : "+v"(t)); return t; }
typedef unsigned long long u64_t;
__device__ __forceinline__ const void* ldptr(const LAS u64_t* tab, int i) {
  const u64_t v = tab[i]; const unsigned lo = __builtin_amdgcn_readfirstlane((unsigned)v), hi = __builtin_amdgcn_readfirstlane((unsigned)(v >> 32));
  return (const void*)(((u64_t)hi << 32) | lo);
}

constexpr int NB = 8, S = 2048, D = 1024, NTOK = NB * S;
constexpr int INW = 4120;
constexpr int NSLOT = 40960;
constexpr size_t MiB = 1u << 20;
constexpr size_t WS_CTL = 0;
constexpr int CW_CNT = 4096;
constexpr size_t CTL_ZERO_BYTES = 65536;
constexpr size_t WS_SMALL = 1 * MiB;
constexpr size_t WS_LIST = 233 * MiB;
constexpr size_t WS_W1KT = 2 * MiB, WS_W1VT = 3 * MiB;
constexpr size_t WS_W2KT = 4 * MiB, WS_W2VT = 4 * MiB + 32768;
constexpr size_t WS_WGNT = 4 * MiB + 65536;
constexpr size_t WS_WRT_HI = 4 * MiB + 131072, WS_WRT_LO = 4 * MiB + 262144;
constexpr size_t WS_WABT = 5 * MiB;
constexpr size_t WS_WOT = 7 * MiB;
constexpr size_t WS_WGUT = 10 * MiB;
constexpr size_t WS_WDT = 42 * MiB;
constexpr size_t WS_WINT = 58 * MiB;
constexpr size_t WS_OAB = 66 * MiB;
constexpr size_t WS_XN = 66 * MiB;
constexpr size_t WS_OA = 66 * MiB, WS_OB = 82 * MiB;
constexpr size_t WS_YS = 66 * MiB;
constexpr size_t WS_GM = 98 * MiB;
constexpr size_t WS_H2 = 98 * MiB, WS_H2LO = 130 * MiB;
constexpr size_t WS_QA = 162 * MiB, WS_QB = 178 * MiB, WS_KVC = 194 * MiB, WS_KVS = 202 * MiB, WS_KVW = 210 * MiB, WS_KVB = 218 * MiB;
constexpr size_t WS_MG = 162 * MiB;
constexpr size_t WS_HB = 162 * MiB;
constexpr size_t WS_GTMP = 182 * MiB;
constexpr size_t WS_GN = 226 * MiB;
constexpr size_t WS_KC = 228 * MiB, WS_VC = WS_KC + 256 * 1024, WS_T1K = 229 * MiB, WS_T1V = 231 * MiB;
constexpr int SM_EID = 0, SM_WT = SM_EID + 2 * NTOK, SM_RANK = SM_WT + 2 * NTOK;
static_assert((SM_RANK + 2 * NTOK) * 4 <= (int)MiB, "small");

constexpr int LDS_BYTES = 147456;
constexpr int MISC_OFF = 131072 + 320;

#define XB_TMO      128
#define XB_XCNT(j)  (256  + 64 * (j))
#define XB_XSUB(j)  (1280 + 64 * (j))
#define XB_XGEN(j)  (2304 + 64 * (j))
#define XB_TOP      3328
#define XB_TOPGEN   3392
#define XCD_BAR_WORDS 3456
#define XB_SPIN_CAP (1u << 20)
__device__ __forceinline__ unsigned xb_ld(unsigned* p)              { return __hip_atomic_load(p, __ATOMIC_RELAXED, __HIP_MEMORY_SCOPE_AGENT); }
__device__ __forceinline__ unsigned xb_add(unsigned* p, unsigned v) { return __hip_atomic_fetch_add(p, v, __ATOMIC_RELAXED, __HIP_MEMORY_SCOPE_AGENT); }
__device__ __forceinline__ unsigned xb_xcc_id() { return (unsigned)__builtin_amdgcn_s_getreg((3 << 11) | 20) & 0xFu; }
#define XB_SPIN(cond, bar) do { unsigned _sp = 0; while (cond) { __builtin_amdgcn_s_sleep(1); \
    if ((++_sp & 255u) == 0u) { if (xb_ld(&(bar)[XB_TMO])) break; if (_sp > XB_SPIN_CAP) { atomicAdd(&(bar)[XB_TMO], 1u); break; } } } } while (0)
struct XcdBarrier { unsigned* bar; unsigned x; volatile LAS unsigned* st; };
__device__ __forceinline__ XcdBarrier xcd_barrier_post(unsigned* bar, volatile LAS unsigned* st) {
    XcdBarrier b; b.bar = bar; b.x = xb_xcc_id(); b.st = st;
    if (threadIdx.x == 0) (void)xb_add(&bar[XB_XCNT(b.x)], 1u);
    return b;
}
__device__ __forceinline__ void xcd_barrier_complete(unsigned* bar, unsigned x, unsigned& nloc, unsigned& nx) {
    const unsigned G = gridDim.x * gridDim.y * gridDim.z;
    unsigned sum, cnt, mine, sp = 0u;
    for (;;) {
        sum = 0u; cnt = 0u; mine = 0u;
#pragma unroll
        for (unsigned j = 0; j < 16; ++j) { const unsigned c = xb_ld(&bar[XB_XCNT(j)]); sum += c; cnt += (c > 0u) ? 1u : 0u; mine = (j == x) ? c : mine; }
        if (sum == G) break;
        __builtin_amdgcn_s_sleep(1);
        if ((++sp & 255u) == 0u) { if (xb_ld(&bar[XB_TMO])) break; if (sp > XB_SPIN_CAP) { atomicAdd(&bar[XB_TMO], 1u); break; } }
    }
    nloc = mine > 0u ? mine : 1u; nx = cnt > 0u ? cnt : 1u;
}
__device__ __forceinline__ void xcd_barrier(const XcdBarrier& b) {
    asm volatile("s_waitcnt vmcnt(0)" ::: "memory");
    __syncthreads();
    if (threadIdx.x == 0) {
        unsigned* bar = b.bar;
        __builtin_amdgcn_s_waitcnt(0);
        unsigned nloc = b.st[0], nx = b.st[1];
        if (nloc == 0u) { xcd_barrier_complete(bar, b.x, nloc, nx); b.st[0] = nloc; b.st[1] = nx; }
        const unsigned old = xb_add(&bar[XB_XSUB(b.x)], 1u);
        const unsigned gen = old / nloc;
        if (old + 1u == (gen + 1u) * nloc) {
            __builtin_amdgcn_fence(__ATOMIC_RELEASE, "agent");
            asm volatile("s_waitcnt vmcnt(0)" ::: "memory");
            const unsigned og = xb_add(&bar[XB_TOP], 1u);
            const unsigned tg = og / nx;
            if (og + 1u == (tg + 1u) * nx) xb_add(&bar[XB_TOPGEN], 1u);
            else XB_SPIN(xb_ld(&bar[XB_TOPGEN]) == tg, bar);
            __builtin_amdgcn_fence(__ATOMIC_ACQUIRE, "agent");
            xb_add(&bar[XB_XGEN(b.x)], 1u);
            asm volatile("s_waitcnt vmcnt(0)" ::: "memory");
        } else {
            XB_SPIN(xb_ld(&bar[XB_XGEN(b.x)]) == gen, bar);
            __builtin_amdgcn_fence(__ATOMIC_ACQUIRE, "agent");
            asm volatile("s_waitcnt vmcnt(0)" ::: "memory");
        }
    }
    __syncthreads();
}


namespace pg8 {
typedef short bf16x8 __attribute__((ext_vector_type(8)));
typedef float f32x4 __attribute__((ext_vector_type(4)));
typedef unsigned u32x4 __attribute__((ext_vector_type(4)));
typedef unsigned u32x2 __attribute__((ext_vector_type(2)));
constexpr int BM = 256, BK = 64, HALF = 128, HTB = HALF * BK * 2, STAGE_BYTES = 8 * HTB, NXCD = 8, WGM = 8;
__host__ __device__ __forceinline__ int lds_byte(int r, int c) { const int st = (r >> 4) * 2 + (c >> 5), rr = r & 15, cc = c & 31, ob = rr * 64 + cc * 2; return st * 1024 + (ob ^ (((ob >> 9) & 1) << 5)); }
__host__ __device__ __forceinline__ void stage_rc(int b, int& R, int& C) { const int st = b / 1024, sb = b % 1024, swz = sb ^ (((sb >> 9) & 1) << 5); R = (st >> 1) * 16 + swz / 64; C = (st & 1) * 32 + (swz % 64) / 2; }
__host__ __device__ __forceinline__ int perm32(int rho) { const int n = rho >> 4, i = rho & 15; return 8 * (i >> 2) + 4 * n + (i & 3); }
struct Unit { int pm, pn; const char* A; const char* B; };
__device__ __forceinline__ unsigned cvt_pk_bf16(float lo, float hi) { unsigned r; asm volatile("v_cvt_pk_bf16_f32 %0, %1, %2" : "=v"(r) : "v"(lo), "v"(hi)); return r; }

template <class Epi, class Sched, bool ALIGN_EPI>
__device__ __forceinline__ void gemm_phase(LAS unsigned char* lds, const int K, const int kstepA, const Sched& S, const Epi& E) {
    const int tid = tid_fresh(), wid = __builtin_amdgcn_readfirstlane(tid >> 6), lane = tid & 63, wr = wid >> 2, wc = wid & 3, fr = lane & 15, fq = lane >> 4;
    const int nt = K / BK;
    int Rr[2], Cc[2]; unsigned voffB[2];
#pragma unroll
    for (int i = 0; i < 2; ++i) { stage_rc(tid * 16 + i * 8192, Rr[i], Cc[i]); const int Rb = Epi::PERM ? ((Rr[i] & ~31) + perm32(Rr[i] & 31)) : Rr[i]; voffB[i] = (unsigned)(Rb * K + Cc[i]) * 2u; }
    const size_t kstepB = (size_t)(BK * 2);
    const size_t hstepB = (size_t)HALF * K * 2;
    const unsigned ldsw = (unsigned)wid * 1024u;
    const int aoff = lds_byte(wr * 64 + fr, fq * 8), boff = lds_byte(wc * 32 + fr, fq * 8);
#define PG8_SA(b, h) (((b) * 2 + (h)) * HTB)
#define PG8_SB(b, h) ((4 + (b) * 2 + (h)) * HTB)
#define PG8_STAGEB(bufoff, gbase) do { _Pragma("unroll") for (int _i = 0; _i < 2; ++_i) \
        __builtin_amdgcn_global_load_lds((const unsigned*)((const char*)(gbase) + voffB[_i]), (LAS unsigned*)(lds + (bufoff) + ldsw + _i * 8192), 16, 0, 0); } while (0)
#define PG8_STAGEA(bufoff, gbase, v0, v1) do { \
        __builtin_amdgcn_global_load_lds((const unsigned*)((const char*)(gbase) + (v0)), (LAS unsigned*)(lds + (bufoff) + ldsw), 16, 0, 0); \
        __builtin_amdgcn_global_load_lds((const unsigned*)((const char*)(gbase) + (v1)), (LAS unsigned*)(lds + (bufoff) + ldsw + 8192), 16, 0, 0); } while (0)
#define PG8_LDA(dst, b, h) do { _Pragma("unroll") for (int m = 0; m < 4; ++m) _Pragma("unroll") for (int k = 0; k < 2; ++k) dst[m][k] = *(const LAS bf16x8*)(lds + PG8_SA(b, h) + aoff + m * 2048 + k * 1024); } while (0)
#define PG8_LDB(dst, b, h) do { _Pragma("unroll") for (int n = 0; n < 2; ++n) _Pragma("unroll") for (int k = 0; k < 2; ++k) dst[n][k] = *(const LAS bf16x8*)(lds + PG8_SB(b, h) + boff + n * 2048 + k * 1024); } while (0)
#define PG8_MMA(ai, bj, At, Bt) do { __builtin_amdgcn_s_setprio(1); _Pragma("unroll") for (int m = 0; m < 4; ++m) _Pragma("unroll") for (int n = 0; n < 2; ++n) _Pragma("unroll") for (int k = 0; k < 2; ++k) \
        acc[ai][bj][m][n] = __builtin_amdgcn_mfma_f32_16x16x32_bf16(Bt[n][k], At[m][k], acc[ai][bj][m][n], 0, 0, 0); __builtin_amdgcn_s_setprio(0); } while (0)
#define PG8_WAIT_V(n) asm volatile("s_waitcnt vmcnt(" #n ")" ::: "memory")
#define PG8_WAIT_L(n) asm volatile("s_waitcnt lgkmcnt(" #n ")" ::: "memory")
#define PG8_BAR __builtin_amdgcn_s_barrier()
#define PG8_SCHED __builtin_amdgcn_sched_barrier(0)
    Unit cur, nxt; int ui = 0;
    if (!S.next(0, cur)) return;
    f32x4 acc[2][2][4][2];
#pragma unroll
    for (int a = 0; a < 2; ++a)
#pragma unroll
        for (int b = 0; b < 2; ++b)
#pragma unroll
            for (int m = 0; m < 4; ++m)
#pragma unroll
                for (int n = 0; n < 2; ++n) acc[a][b][m][n] = (f32x4){0.f, 0.f, 0.f, 0.f};
    bf16x8 At[4][2], B0[2][2], B1[2][2];
    unsigned vc00, vc01, vc10, vc11;
    vc00 = S.arow(cur, Rr[0]) + (unsigned)Cc[0] * 2u; vc01 = S.arow(cur, Rr[1]) + (unsigned)Cc[1] * 2u;
    vc10 = S.arow(cur, HALF + Rr[0]) + (unsigned)Cc[0] * 2u; vc11 = S.arow(cur, HALF + Rr[1]) + (unsigned)Cc[1] * 2u;
    const char* cA = cur.A; const char* cB = cur.B;
    PG8_STAGEB(PG8_SB(0, 0), cB); PG8_STAGEB(PG8_SB(0, 1), cB + hstepB); PG8_STAGEA(PG8_SA(0, 0), cA, vc00, vc01); PG8_STAGEA(PG8_SA(0, 1), cA, vc10, vc11);
    if (wr == 1) PG8_BAR;
    PG8_WAIT_V(2); PG8_BAR;
    PG8_STAGEB(PG8_SB(1, 0), cB + kstepB); PG8_STAGEA(PG8_SA(1, 0), cA + kstepA, vc00, vc01); PG8_STAGEB(PG8_SB(1, 1), cB + hstepB + kstepB);
    PG8_WAIT_V(6); PG8_BAR;
    for (;;) {
        const bool has_next = S.next(ui + 1, nxt);
        const char* nA = has_next ? nxt.A : cA; const char* nB = has_next ? nxt.B : cB;
        unsigned vn00 = vc00, vn01 = vc01, vn10 = vc10, vn11 = vc11;
        if (Sched::GATHER && has_next) {
            vn00 = S.arow(nxt, Rr[0]) + (unsigned)Cc[0] * 2u; vn01 = S.arow(nxt, Rr[1]) + (unsigned)Cc[1] * 2u;
            vn10 = S.arow(nxt, HALF + Rr[0]) + (unsigned)Cc[0] * 2u; vn11 = S.arow(nxt, HALF + Rr[1]) + (unsigned)Cc[1] * 2u;
        }
#pragma unroll 1
        for (int t = 0; t < nt; t += 2) {
            const bool last = (t == nt - 2);
            if (Epi::HOOK) { if (t == nt / 2) E.mid(acc, cur, wr, wc, fr, fq); }
            const char* a1 = cA + (size_t)(t + 1) * kstepA;
            const char* a2 = last ? nA : cA + (size_t)(t + 2) * kstepA; const char* b2 = last ? nB : cB + (size_t)(t + 2) * kstepB;
            const char* a3 = a2 + kstepA; const char* b3 = b2 + kstepB;
            const unsigned w00 = last ? vn00 : vc00, w01 = last ? vn01 : vc01, w10 = last ? vn10 : vc10, w11 = last ? vn11 : vc11;
            PG8_LDB(B0, 0, 0); PG8_LDB(B1, 0, 1); PG8_SCHED; PG8_LDA(At, 0, 0); PG8_STAGEA(PG8_SA(1, 1), a1, vc10, vc11);
            PG8_WAIT_V(8); PG8_WAIT_L(0); PG8_BAR; PG8_MMA(0, 0, At, B0); PG8_MMA(0, 1, At, B1); PG8_BAR; PG8_SCHED;
            PG8_LDA(At, 0, 1); PG8_STAGEB(PG8_SB(0, 0), b2); PG8_STAGEB(PG8_SB(0, 1), b2 + hstepB); PG8_STAGEA(PG8_SA(0, 0), a2, w00, w01);
            PG8_WAIT_V(8); PG8_WAIT_L(0); PG8_BAR; PG8_MMA(1, 0, At, B0); PG8_MMA(1, 1, At, B1); PG8_BAR; PG8_SCHED;
            PG8_LDB(B0, 1, 0); PG8_LDB(B1, 1, 1); PG8_SCHED; PG8_LDA(At, 1, 0); PG8_STAGEA(PG8_SA(0, 1), a2, w10, w11);
            PG8_WAIT_V(8); PG8_WAIT_L(0); PG8_BAR; PG8_MMA(0, 0, At, B0); PG8_MMA(0, 1, At, B1); PG8_BAR; PG8_SCHED;
            PG8_LDA(At, 1, 1); PG8_STAGEB(PG8_SB(1, 0), b3); PG8_STAGEB(PG8_SB(1, 1), b3 + hstepB); PG8_STAGEA(PG8_SA(1, 0), a3, w00, w01);
            PG8_WAIT_V(8); PG8_WAIT_L(0); PG8_BAR; PG8_MMA(1, 0, At, B0); PG8_MMA(1, 1, At, B1); PG8_BAR; PG8_SCHED;
        }
        if constexpr (ALIGN_EPI) { if (wr == 0) PG8_BAR; }
        E(acc, cur, wr, wc, fr, fq);
        if (!has_next) break;
#pragma unroll
        for (int a = 0; a < 2; ++a)
#pragma unroll
            for (int b = 0; b < 2; ++b)
#pragma unroll
                for (int m = 0; m < 4; ++m)
#pragma unroll
                    for (int n = 0; n < 2; ++n) acc[a][b][m][n] = (f32x4){0.f, 0.f, 0.f, 0.f};
        cur = nxt; cA = nA; cB = nB; vc00 = vn00; vc01 = vn01; vc10 = vn10; vc11 = vn11; ++ui;
        if constexpr (ALIGN_EPI) { if (wr == 1) PG8_BAR; }
    }
    PG8_WAIT_V(0);
    if constexpr (!ALIGN_EPI) { if (wr == 0) PG8_BAR; }
    PG8_BAR;
#undef PG8_SA
#undef PG8_SB
#undef PG8_STAGEA
#undef PG8_STAGEB
#undef PG8_LDA
#undef PG8_LDB
#undef PG8_MMA
#undef PG8_WAIT_V
#undef PG8_WAIT_L
#undef PG8_BAR
#undef PG8_SCHED
}

struct SchedDense {
    static constexpr bool GATHER = false;
    const char* A; const char* B; int pitchA  ; int K; int nM, nN, nwg, G, c;
    __device__ void init(const void* A_, int pitchA_, const void* B_, int M, int N, int K_, int G_, int c_) { A = (const char*)A_; B = (const char*)B_; pitchA = pitchA_; K = K_; nM = M / BM; nN = N / BM; nwg = nM * nN; G = G_; c = c_; }
    __device__ bool next(int i, Unit& u) const {
        const long L = (long)i * G + c; if (L >= nwg) return false;
        int wgid = (int)L; { const int q = nwg / NXCD, r = nwg % NXCD, xcd = wgid % NXCD, off = wgid / NXCD; wgid = (xcd < r ? xcd * (q + 1) : r * (q + 1) + (xcd - r) * q) + off; }
        const int nig = WGM * nN, gid = wgid / nig, fm = gid * WGM, gsz = (nM - fm) < WGM ? (nM - fm) : WGM;
        u.pm = fm + ((wgid % nig) % gsz); u.pn = (wgid % nig) / gsz;
        u.A = A + (size_t)u.pm * BM * pitchA; u.B = B + (size_t)u.pn * BM * K * 2; return true;
    }
    __device__ unsigned arow(const Unit&, int r) const { return (unsigned)(r * pitchA); }
};
struct SchedMoeUp {
    static constexpr bool GATHER = true;
    const char* H2; const char* W; const int* list; const int* cnt; const int* l_off; const int* l_te; int G, c;
    __device__ bool next(int i, Unit& u) const {
        const int L = i * G + c, tix = L >> 1; if (tix >= (l_off[32] >> 8)) return false;
        u.pm = tix; u.pn = L & 1; const int e = l_te[tix];
        u.A = H2; u.B = W + (size_t)e * (512 * 1024 * 2) + (size_t)u.pn * (256 * 1024 * 2); return true;
    }
    __device__ unsigned arow(const Unit& u, int r) const { const int e = l_te[u.pm]; int ri = u.pm * 256 + r - l_off[e]; if (ri >= cnt[e]) ri = 0; return (unsigned)list[(size_t)e * NTOK + ri] * 2048u; }
};
struct SchedMoeDown {
    static constexpr bool GATHER = false;
    const char* HB; const char* W; const int* l_off; const int* l_te; int G, c;
    __device__ bool next(int i, Unit& u) const {
        const int L = i * G + c, tix = L >> 2; if (tix >= (l_off[32] >> 8)) return false;
        u.pm = tix; u.pn = L & 3; const int e = l_te[tix];
        u.A = HB + (size_t)tix * (256 * 512); u.B = W + (size_t)e * (1024 * 256 * 2) + (size_t)u.pn * (256 * 256 * 2); return true;
    }
    __device__ unsigned arow(const Unit&, int r) const { return (unsigned)(r * 512); }
};

__device__ __forceinline__ float sigm(float v) { return __builtin_amdgcn_rcpf(1.f + __expf(-v)); }
struct EpiProj {
    static constexpr bool PERM = true, HOOK = false;
    bf16_t *QA, *QB, *KVC, *KVS, *KVW, *KVB, *GM;
    __device__ __forceinline__ void mid(f32x4 (&)[2][2][4][2], const Unit&, int, int, int, int) const {}
    __device__ __forceinline__ void operator()(const f32x4 (&acc)[2][2][4][2], const Unit& u, int wr, int wc, int fr, int fq) const {
        const int pn = u.pn; bf16_t* base; int ldc, colt; bool sg = false;
        if (pn < 2) { base = QA; ldc = 512; colt = pn * 256; }
        else if (pn == 2) { base = KVC; ldc = 256; colt = 0; }
        else if (pn == 3) { base = KVS; ldc = 256; colt = 0; }
        else if (pn == 4) { base = KVW; ldc = 256; colt = 0; }
        else if (pn < 7) { base = QB; ldc = 512; colt = (pn - 5) * 256; }
        else if (pn == 7) { base = KVB; ldc = 256; colt = 0; }
        else { base = GM; ldc = 2048; colt = (pn - 8) * 256; sg = true; }
        const int row0 = u.pm * BM + wr * 64 + fr, col0 = colt + wc * 32 + 8 * fq;
#pragma unroll
        for (int ai = 0; ai < 2; ++ai)
#pragma unroll
            for (int m = 0; m < 4; ++m) { bf16_t* rowp = base + (size_t)(row0 + ai * HALF + m * 16) * ldc + col0;
#pragma unroll
                for (int bj = 0; bj < 2; ++bj) { f32x4 v0 = acc[ai][bj][m][0], v1 = acc[ai][bj][m][1];
                    if (sg) { v0 = (f32x4){sigm(v0[0]), sigm(v0[1]), sigm(v0[2]), sigm(v0[3])}; v1 = (f32x4){sigm(v1[0]), sigm(v1[1]), sigm(v1[2]), sigm(v1[3])}; }
                    u32x4 w; w.x = cvt_pk_bf16(v0[0], v0[1]); w.y = cvt_pk_bf16(v0[2], v0[3]); w.z = cvt_pk_bf16(v1[0], v1[1]); w.w = cvt_pk_bf16(v1[2], v1[3]);
                    *(u32x4*)(rowp + bj * HALF) = w; } }
    }
};
struct EpiMerge {
    static constexpr bool PERM = true, HOOK = true;
    const bf16_t* GM; bf16_t* MG;
    __device__ __forceinline__ void mid(f32x4 (&acc)[2][2][4][2], const Unit& u, int wr, int wc, int fr, int fq) const {
        const int row0 = u.pm * BM + wr * 64 + fr, col0 = u.pn * BM + wc * 32 + 8 * fq;
        const GAS char* gm = (const GAS char*)GM + ((size_t)row0 * 2048 + col0) * 2;
#pragma unroll
        for (int ai = 0; ai < 2; ++ai)
#pragma unroll
            for (int m = 0; m < 4; ++m) { unsigned ro = (unsigned)(ai * HALF + m * 16) * 4096u; asm volatile("" : "+v"(ro));
#pragma unroll
                for (int bj = 0; bj < 2; ++bj) { const u32x4 ga = *(const GAS u32x4*)(gm + ro + bj * 256), gb = *(const GAS u32x4*)(gm + ro + 2048 + bj * 256);
                    const unsigned gaw[4] = {ga.x, ga.y, ga.z, ga.w}, gbw[4] = {gb.x, gb.y, gb.z, gb.w};
#pragma unroll
                    for (int q = 0; q < 4; ++q) { const float a0 = __uint_as_float(gaw[q] << 16), a1 = __uint_as_float(gaw[q] & 0xffff0000u), b0 = __uint_as_float(gbw[q] << 16), b1 = __uint_as_float(gbw[q] & 0xffff0000u);
                        acc[ai][bj][m][q >> 1][(q & 1) * 2] *= b0 * __builtin_amdgcn_rcpf(a0); acc[ai][bj][m][q >> 1][(q & 1) * 2 + 1] *= b1 * __builtin_amdgcn_rcpf(a1); } } }
    }
    __device__ __forceinline__ void operator()(const f32x4 (&acc)[2][2][4][2], const Unit& u, int wr, int wc, int fr, int fq) const {
        const int row0 = u.pm * BM + wr * 64 + fr, col0 = u.pn * BM + wc * 32 + 8 * fq;
        const GAS char* gm = (const GAS char*)GM + ((size_t)row0 * 2048 + col0) * 2;
        GAS char* mg = (GAS char*)MG + ((size_t)row0 * 1024 + col0) * 2;
#pragma unroll
        for (int ai = 0; ai < 2; ++ai)
#pragma unroll
            for (int m = 0; m < 4; ++m) { unsigned ro = (unsigned)(ai * HALF + m * 16) * 2048u; asm volatile("" : "+v"(ro));
#pragma unroll
                for (int bj = 0; bj < 2; ++bj) { const u32x4 ga = *(const GAS u32x4*)(gm + 2 * ro + bj * 256); const unsigned gaw[4] = {ga.x, ga.y, ga.z, ga.w}; float o[8];
#pragma unroll
                    for (int q = 0; q < 4; ++q) { o[2 * q] = acc[ai][bj][m][q >> 1][(q & 1) * 2] * __uint_as_float(gaw[q] << 16); o[2 * q + 1] = acc[ai][bj][m][q >> 1][(q & 1) * 2 + 1] * __uint_as_float(gaw[q] & 0xffff0000u); }
                    u32x4 w; w.x = cvt_pk_bf16(o[0], o[1]); w.y = cvt_pk_bf16(o[2], o[3]); w.z = cvt_pk_bf16(o[4], o[5]); w.w = cvt_pk_bf16(o[6], o[7]);
                    *(GAS u32x4*)(mg + ro + bj * 256) = w; } }
    }
};
struct EpiX1 {
    static constexpr bool PERM = false, HOOK = false;
    const float* x; float* out;
    __device__ __forceinline__ void mid(f32x4 (&)[2][2][4][2], const Unit&, int, int, int, int) const {}
    __device__ __forceinline__ void operator()(const f32x4 (&acc)[2][2][4][2], const Unit& u, int wr, int wc, int fr, int fq) const {
        const int row0 = u.pm * BM + wr * 64 + fr, col0 = u.pn * BM + wc * 32 + 4 * fq;
#pragma unroll
        for (int ai = 0; ai < 2; ++ai)
#pragma unroll
            for (int m = 0; m < 4; ++m) { const size_t off = (size_t)(row0 + ai * HALF + m * 16) * 1024 + col0;
#pragma unroll
                for (int bj = 0; bj < 2; ++bj)
#pragma unroll
                    for (int n = 0; n < 2; ++n) { const f32x4 bs = *(const f32x4*)(x + off + bj * HALF + n * 16); *(f32x4*)(out + off + bj * HALF + n * 16) = bs + acc[ai][bj][m][n]; } }
    }
};
struct EpiHB {
    static constexpr bool PERM = true, HOOK = false;
    bf16_t* HB;
    __device__ __forceinline__ void mid(f32x4 (&)[2][2][4][2], const Unit&, int, int, int, int) const {}
    __device__ __forceinline__ void operator()(const f32x4 (&acc)[2][2][4][2], const Unit& u, int wr, int wc, int fr, int fq) const {
        const int row0 = u.pm * BM + wr * 64 + fr, col0 = u.pn * HALF + wc * 32 + 8 * fq;
#pragma unroll
        for (int ai = 0; ai < 2; ++ai)
#pragma unroll
            for (int m = 0; m < 4; ++m) { float o[8];
#pragma unroll
                for (int n = 0; n < 2; ++n)
#pragma unroll
                    for (int j = 0; j < 4; ++j) { const float g = acc[ai][0][m][n][j]; o[n * 4 + j] = g * sigm(g) * acc[ai][1][m][n][j]; }
                u32x4 w; w.x = cvt_pk_bf16(o[0], o[1]); w.y = cvt_pk_bf16(o[2], o[3]); w.z = cvt_pk_bf16(o[4], o[5]); w.w = cvt_pk_bf16(o[6], o[7]);
                *(u32x4*)(HB + (size_t)(row0 + ai * HALF + m * 16) * 256 + col0) = w; }
    }
};
struct EpiYS {
    static constexpr bool PERM = true, HOOK = false;
    bf16_t* YS;
    __device__ __forceinline__ void mid(f32x4 (&)[2][2][4][2], const Unit&, int, int, int, int) const {}
    __device__ __forceinline__ void operator()(const f32x4 (&acc)[2][2][4][2], const Unit& u, int wr, int wc, int fr, int fq) const {
        const int row0 = u.pm * BM + wr * 64 + fr, col0 = u.pn * BM + wc * 32 + 8 * fq;
#pragma unroll
        for (int ai = 0; ai < 2; ++ai)
#pragma unroll
            for (int m = 0; m < 4; ++m) { bf16_t* rowp = YS + (size_t)(row0 + ai * HALF + m * 16) * 1024 + col0;
#pragma unroll
                for (int bj = 0; bj < 2; ++bj) { const f32x4 v0 = acc[ai][bj][m][0], v1 = acc[ai][bj][m][1];
                    u32x4 w; w.x = cvt_pk_bf16(v0[0], v0[1]); w.y = cvt_pk_bf16(v0[2], v0[3]); w.z = cvt_pk_bf16(v1[0], v1[1]); w.w = cvt_pk_bf16(v1[2], v1[3]);
                    *(u32x4*)(rowp + bj * HALF) = w; } }
    }
};
}

__device__ __forceinline__ unsigned pk2(float lo, float hi) { return (unsigned)f2bf(lo) | ((unsigned)f2bf(hi) << 16); }
__device__ __forceinline__ void tr_item(const float* __restrict__ W, int ldw, int c0, int nvalid, int k0, bf16_t* __restrict__ WT, int ldt, int r0, int kd0, LAS float* scr, int lane) {
#pragma unroll 8
  for (int i = 0; i < 32; ++i) { const int kk = 2 * i + (lane >> 5), n = lane & 31; scr[kk * 33 + n] = n < nvalid ? W[(size_t)(k0 + kk) * ldw + c0 + n] : 0.f; }
  asm volatile("s_waitcnt lgkmcnt(0)" ::: "memory");
  const int c = lane & 7;
#pragma unroll
  for (int j = 0; j < 4; ++j) { const int n = (lane >> 3) + 8 * j; const LAS float* s = scr + (8 * c) * 33 + n;
    pg8::u32x4 o; o.x = pk2(s[0 * 33], s[1 * 33]); o.y = pk2(s[2 * 33], s[3 * 33]); o.z = pk2(s[4 * 33], s[5 * 33]); o.w = pk2(s[6 * 33], s[7 * 33]);
    *(pg8::u32x4*)(WT + (size_t)(r0 + n) * ldt + kd0 + k0 + 8 * c) = o; }
  asm volatile("s_waitcnt lgkmcnt(0)" ::: "memory");
}

__device__ __forceinline__ void ph_prep_xn(const float* __restrict__ x, const float* __restrict__ g, bf16_t* __restrict__ xn) {
  const int tid_ = tid_fresh(), lane = tid_ & 63, wave = (blockIdx.x * 512 + tid_) >> 6, nw = (gridDim.x * 512) >> 6;
  for (int r = wave; r < NTOK; r += nw) {
    const float4* xr = (const float4*)(x + (size_t)r * D);
    float4 v[4]; float s = 0.f;
#pragma unroll
    for (int j = 0; j < 4; ++j) { v[j] = xr[lane + 64 * j]; s += v[j].x * v[j].x + v[j].y * v[j].y + v[j].z * v[j].z + v[j].w * v[j].w; }
    s = wave_sum(s);
    const float rstd = rsqrtf(s * (1.f / D) + 1e-6f);
#pragma unroll
    for (int j = 0; j < 4; ++j) {
      const float4 gg = ((const float4*)g)[lane + 64 * j];
      ushort4 o; o.x = f2bf(v[j].x * rstd * gg.x); o.y = f2bf(v[j].y * rstd * gg.y); o.z = f2bf(v[j].z * rstd * gg.z); o.w = f2bf(v[j].w * rstd * gg.w);
      ((ushort4*)(xn + (size_t)r * D))[lane + 64 * j] = o;
    }
  }
}

template <class AL, class BL, class EP>
__device__ __forceinline__ void naive_gemm_phase(unsigned char* lds, const AL al, const BL bl, const EP ep, int K, int ntm, int ntn) {
  const int tid_ = tid_fresh(), half = tid_ >> 8, tid = tid_ & 255, tx = tid & 15, ty = tid >> 4;
  float (*As)[68] = (float (*)[68])(lds + half * 8704);
  float (*Bs)[68] = As + 16;
  const int ntiles = ntm * ntn;
  for (int it0 = blockIdx.x * 2; it0 < ntiles; it0 += 2 * gridDim.x) {
    const int it = it0 + half, tm = it / ntn, tn = it - tm * ntn, m0 = tm * 64, n0 = tn * 64;
    const bool act = it < ntiles && al.active(m0);
    float acc[4][4];
#pragma unroll
    for (int i = 0; i < 4; ++i)
#pragma unroll
      for (int j = 0; j < 4; ++j) acc[i][j] = 0.f;
    for (int k0 = 0; k0 < K; k0 += 16) {
#pragma unroll
      for (int i = 0; i < 4; ++i) { const int e = tid + i * 256, r = e >> 4, kk = e & 15; As[kk][r] = act ? al(m0 + r, k0 + kk) : 0.f; }
#pragma unroll
      for (int i = 0; i < 4; ++i) { const int e = tid + i * 256, kk = e >> 6, c = e & 63; Bs[kk][c] = act ? bl(m0, k0 + kk, n0 + c) : 0.f; }
      __syncthreads();
#pragma unroll
      for (int kk = 0; kk < 16; ++kk) {
        const float4 a = *(const float4*)&As[kk][ty * 4];
        const float4 b = *(const float4*)&Bs[kk][tx * 4];
        const float av[4] = {a.x, a.y, a.z, a.w}, bv[4] = {b.x, b.y, b.z, b.w};
#pragma unroll
        for (int i = 0; i < 4; ++i)
#pragma unroll
          for (int j = 0; j < 4; ++j) acc[i][j] += av[i] * bv[j];
      }
      __syncthreads();
    }
    if (act) {
#pragma unroll
      for (int i = 0; i < 4; ++i)
#pragma unroll
        for (int j = 0; j < 4; ++j) ep(m0 + ty * 4 + i, n0 + tx * 4 + j, acc[i][j]);
    }
  }
}

struct AL_bf16 { const bf16_t* A; int lda, M; __device__ bool active(int) const { return true; } __device__ float operator()(int m, int k) const { return m < M ? bf2f(A[(size_t)m * lda + k]) : 0.f; } };
struct AL_f32 { const float* A; int lda, M; __device__ bool active(int) const { return true; } __device__ float operator()(int m, int k) const { return m < M ? A[(size_t)m * lda + k] : 0.f; } };
struct BL_f32 { const float* B; int ldb, N; __device__ float operator()(int, int k, int n) const { return n < N ? B[(size_t)k * ldb + n] : 0.f; } };
struct EP_proj {
  bf16_t *QA, *QB, *KVC, *KVS, *KVW, *KVB, *GM; float* GN;
  __device__ void operator()(int m, int c, float v) const {
    if (c >= INW) return;
    if (c < 512) QA[(size_t)m * 512 + c] = f2bf(v);
    else if (c < 768) KVC[(size_t)m * 256 + (c - 512)] = f2bf(v);
    else if (c < 1024) KVS[(size_t)m * 256 + (c - 768)] = f2bf(v);
    else if (c < 1280) KVW[(size_t)m * 256 + (c - 1024)] = f2bf(v);
    else if (c < 1304) GN[(size_t)m * 32 + (c - 1280)] = sigmoidf_(v);
    else if (c < 1816) QB[(size_t)m * 512 + (c - 1304)] = f2bf(v);
    else if (c < 2072) KVB[(size_t)m * 256 + (c - 1816)] = f2bf(v);
    else GM[(size_t)m * 2048 + (c - 2072)] = f2bf(sigmoidf_(v));
  }
};
struct AL_cmp { const bf16_t* KVC; const float* pos; int sel; __device__ bool active(int) const { return true; }
  __device__ float operator()(int m, int k) const { if (m >= 2032) return 0.f; const int h = m & 1, bc = m >> 1, b = bc / 127, c = bc % 127, i = k >> 6, d = k & 63;
    return bf2f(KVC[((size_t)b * S + 16 * c + i) * 256 + sel * 128 + h * 64 + d]) + pos[k]; } };
struct EP_silu { float* T; int M, N; __device__ void operator()(int m, int n, float v) const { if (m < M && n < N) T[(size_t)m * N + n] = v / (1.f + __expf(-v)); } };
struct EP_kc { bf16_t* KC; __device__ void operator()(int m, int n, float v) const { if (m >= 2032 || n >= 64) return; const int h = m & 1, bc = m >> 1, b = bc / 127, c = bc % 127; KC[(((size_t)b * 128 + c) * 2 + h) * 64 + n] = f2bf(v); } };
struct EP_mg1 { float* tmp; const bf16_t* GM; __device__ void operator()(int m, int n, float v) const { tmp[(size_t)m * 1024 + n] = bf2f(GM[(size_t)m * 2048 + n]) * v; } };
struct EP_mg2 { const float* tmp; const bf16_t* GM; bf16_t* MG; __device__ void operator()(int m, int n, float v) const { MG[(size_t)m * 1024 + n] = f2bf(tmp[(size_t)m * 1024 + n] + bf2f(GM[(size_t)m * 2048 + 1024 + n]) * v); } };
struct EP_x1 { const float* x; float* out; __device__ void operator()(int m, int n, float v) const { out[(size_t)m * 1024 + n] = x[(size_t)m * 1024 + n] + v; } };
struct AL_moe { const bf16_t* H2; const int* list; const int* cnt; const int* l_off; const int* l_te; __device__ bool active(int m0) const { return l_te[m0 >> 8] >= 0; }
  __device__ float operator()(int m, int k) const { const int e = l_te[m >> 8], r = m - l_off[e]; if (r >= cnt[e]) return 0.f; const int t = list[(size_t)e * NTOK + r]; return bf2f(H2[(size_t)t * 1024 + k]); } };
struct BL_moe { const float* W; const int* l_te; int K, N; __device__ float operator()(int m0, int k, int n) const { const int e = l_te[m0 >> 8]; return W[((size_t)e * K + k) * N + n]; } };
struct EP_g { float* G; __device__ void operator()(int m, int n, float v) const { G[(size_t)m * 256 + n] = v; } };
struct EP_hb { const float* G; bf16_t* HB; __device__ void operator()(int m, int n, float v) const { const float g = G[(size_t)m * 256 + n]; HB[(size_t)m * 256 + n] = f2bf(g / (1.f + __expf(-g)) * v); } };
struct AL_hb { const bf16_t* HB; const int* l_te; __device__ bool active(int m0) const { return l_te[m0 >> 8] >= 0; } __device__ float operator()(int m, int k) const { return bf2f(HB[(size_t)m * 256 + k]); } };
struct EP_ys { bf16_t* YS; __device__ void operator()(int m, int n, float v) const { YS[(size_t)m * 1024 + n] = f2bf(v); } };

__device__ __forceinline__ void moe_tables(const int* cnt, int* l_off, int* l_te) {
  __syncthreads();
  if (threadIdx.x == 0) {
    int off = 0;
    for (int e = 0; e < 32; ++e) { l_off[e] = off; const int c = __hip_atomic_load(cnt + e, __ATOMIC_RELAXED, __HIP_MEMORY_SCOPE_AGENT); const int nt = (c + 255) >> 8; for (int i = 0; i < nt; ++i) l_te[(off >> 8) + i] = e; off += nt << 8; }
    l_off[32] = off;
    for (int i = off >> 8; i < NSLOT / 256; ++i) l_te[i] = -1;
  }
  __syncthreads();
}

__device__ __forceinline__ void naive_nsa_phase(unsigned char* lds, const bf16_t* __restrict__ QA, const bf16_t* __restrict__ KC, const bf16_t* __restrict__ VC, const bf16_t* __restrict__ KVS,
                                                const bf16_t* __restrict__ KVW, const float* __restrict__ GN, bf16_t* __restrict__ OA) {
  const int tid_ = tid_fresh(), half = tid_ >> 8, tid = tid_ & 255, g = tid >> 6, lane = tid & 63;
  unsigned char* base = lds + half * 12288;
  float (*q)[64] = (float (*)[64])base;
  float (*pc)[128] = (float (*)[128])(base + 1024);
  float (*sc)[512] = (float (*)[512])(base + 3072);
  float* sscore = (float*)(base + 11264);
  int* sel_idx = (int*)(base + 11264 + 128);
  int* sel_valid = (int*)(base + 11264 + 160);
  for (int item = blockIdx.x * 2 + half; item < NB * 2 * S; item += 2 * gridDim.x) {
    const int t = item & 2047, hkv = (item >> 11) & 1, b = item >> 12, head = hkv * 4 + g;
    const float slope = exp2f(-0.5f * (float)(9 + head));
    const size_t row = (size_t)b * S + t;
    q[g][lane] = bf2f(QA[row * 512 + head * 64 + lane]) * 0.125f;
    __syncthreads();
    {
      float sv[2]; bool vv[2]; float m = -1e30f;
#pragma unroll
      for (int i = 0; i < 2; ++i) {
        const int c = lane + 64 * i, dist = t - (16 * c + 31); vv[i] = (c < 127) && dist >= 0; float s = 0.f;
        if (vv[i]) { const bf16_t* kr = KC + (((size_t)b * 128 + c) * 2 + hkv) * 64; for (int d = 0; d < 64; ++d) s += q[g][d] * bf2f(kr[d]); s -= slope * (float)dist; m = fmaxf(m, s); }
        sv[i] = s;
      }
      m = wave_max(m);
      float z = 0.f;
#pragma unroll
      for (int i = 0; i < 2; ++i) { sv[i] = vv[i] ? __expf(sv[i] - m) : 0.f; z += sv[i]; }
      z = wave_sum(z);
      const float inv = z > 0.f ? 1.f / z : 1.f;
#pragma unroll
      for (int i = 0; i < 2; ++i) pc[g][lane + 64 * i] = sv[i] * inv;
    }
    __syncthreads();
    float ocmp = 0.f;
    {
      int ncv = (t >= 31) ? (t - 31) / 16 + 1 : 0; if (ncv > 127) ncv = 127;
      for (int c = 0; c < ncv; ++c) ocmp += pc[g][c] * bf2f(VC[(((size_t)b * 128 + c) * 2 + hkv) * 64 + lane]);
    }
    if (tid < 32) {
      const int j = tid;
      float ps[5];
#pragma unroll
      for (int u = 0; u < 5; ++u) { const int c = 4 * j - 1 + u; ps[u] = (c >= 0 && c < 127) ? (pc[0][c] + pc[1][c] + pc[2][c] + pc[3][c]) : 0.f; }
      const float imp = 0.5f * ps[0] + ps[1] + ps[2] + ps[3] + 0.5f * ps[4];
      const int cur = t >> 6; const bool forced = (j == 0) || (j == cur) || (j == cur - 1), valid = j <= cur;
      sscore[j] = forced ? 1e9f : (valid ? imp : -1e30f);
    }
    __syncthreads();
    if (tid < 32) {
      const int j = tid; const float sj = sscore[j]; int rank = 0;
      for (int i = 0; i < 32; ++i) { const float si = sscore[i]; rank += ((si > sj) || (si == sj && i < j)) ? 1 : 0; }
      if (rank < 8) { sel_idx[rank] = j; sel_valid[rank] = sj > -5e29f ? 1 : 0; }
    }
    __syncthreads();
    float oslc = 0.f;
    {
      float s8[8]; float m = -1e30f;
#pragma unroll
      for (int i = 0; i < 8; ++i) {
        const int kpos = sel_idx[i] * 64 + lane; const bool ok = sel_valid[i] && kpos <= t; float s = -1e30f;
        if (ok) { const bf16_t* kr = KVS + ((size_t)b * S + kpos) * 256 + hkv * 64; s = 0.f; for (int d = 0; d < 64; ++d) s += q[g][d] * bf2f(kr[d]); s -= slope * (float)(t - kpos); m = fmaxf(m, s); }
        s8[i] = s;
      }
      m = wave_max(m);
      float z = 0.f;
#pragma unroll
      for (int i = 0; i < 8; ++i) { const float p = s8[i] > -5e29f ? __expf(s8[i] - m) : 0.f; sc[g][i * 64 + lane] = p; z += p; }
      z = wave_sum(z);
      __syncthreads();
      for (int i = 0; i < 8; ++i) {
        if (!sel_valid[i]) continue;
        const int k0 = sel_idx[i] * 64;
        for (int l = 0; l < 64; ++l) { const int kpos = k0 + l; if (kpos > t) break; oslc += sc[g][i * 64 + l] * bf2f(KVS[((size_t)b * S + kpos) * 256 + 128 + hkv * 64 + lane]); }
      }
      oslc *= (z > 0.f ? 1.f / z : 1.f);
      __syncthreads();
    }
    float owin = 0.f;
    {
      float s4[4]; float m = -1e30f;
#pragma unroll
      for (int i = 0; i < 4; ++i) {
        const int dist = lane + 64 * i, kpos = t - dist; float s = -1e30f;
        if (kpos >= 0) { const bf16_t* kr = KVW + ((size_t)b * S + kpos) * 256 + hkv * 64; s = 0.f; for (int d = 0; d < 64; ++d) s += q[g][d] * bf2f(kr[d]); s -= slope * (float)dist; m = fmaxf(m, s); }
        s4[i] = s;
      }
      m = wave_max(m);
      float z = 0.f;
#pragma unroll
      for (int i = 0; i < 4; ++i) { const float p = s4[i] > -5e29f ? __expf(s4[i] - m) : 0.f; sc[g][i * 64 + lane] = p; z += p; }
      z = wave_sum(z);
      __syncthreads();
      for (int dist = 0; dist < 256; ++dist) { const int kpos = t - dist; if (kpos < 0) break; owin += sc[g][dist] * bf2f(KVW[((size_t)b * S + kpos) * 256 + 128 + hkv * 64 + lane]); }
      owin /= z;
    }
    const float* gn = GN + row * 32 + hkv * 12 + g * 3;
    OA[row * 1024 + 512 + head * 64 + lane] = f2bf(gn[0] * ocmp + gn[1] * oslc + gn[2] * owin);
    __syncthreads();
  }
}

__device__ __forceinline__ void naive_swa_phase(unsigned char* lds, const bf16_t* __restrict__ QB, const bf16_t* __restrict__ KVB, const float* __restrict__ sinks, bf16_t* __restrict__ OB) {
  const int tid_ = tid_fresh(), half = tid_ >> 8, tid = tid_ & 255, g = tid >> 6, lane = tid & 63;
  unsigned char* base = lds + half * 4096;
  float (*q)[64] = (float (*)[64])base;
  float (*sc)[128] = (float (*)[128])(base + 1024);
  for (int item = blockIdx.x * 2 + half; item < NB * 2 * S; item += 2 * gridDim.x) {
    const int t = item & 2047, hkv = (item >> 11) & 1, b = item >> 12, head = hkv * 4 + g;
    const float slope = exp2f(-0.5f * (float)(1 + head));
    const float sink = sinks[head];
    const size_t row = (size_t)b * S + t;
    q[g][lane] = bf2f(QB[row * 512 + head * 64 + lane]) * 0.125f;
    __syncthreads();
    float s2[2]; float m = sink;
#pragma unroll
    for (int i = 0; i < 2; ++i) {
      const int dist = lane + 64 * i, kpos = t - dist; float s = -1e30f;
      if (kpos >= 0) { const bf16_t* kr = KVB + ((size_t)b * S + kpos) * 256 + hkv * 64; s = 0.f; for (int d = 0; d < 64; ++d) s += q[g][d] * bf2f(kr[d]); s -= slope * (float)dist; m = fmaxf(m, s); }
      s2[i] = s;
    }
    m = wave_max(m);
    float z = 0.f;
#pragma unroll
    for (int i = 0; i < 2; ++i) { const float p = s2[i] > -5e29f ? __expf(s2[i] - m) : 0.f; sc[g][i * 64 + lane] = p; z += p; }
    z = wave_sum(z) + __expf(sink - m);
    __syncthreads();
    float o = 0.f;
    for (int dist = 0; dist < 128; ++dist) { const int kpos = t - dist; if (kpos < 0) break; o += sc[g][dist] * bf2f(KVB[((size_t)b * S + kpos) * 256 + 128 + hkv * 64 + lane]); }
    OB[row * 1024 + head * 64 + lane] = f2bf(o / z);
    __syncthreads();
  }
}

__device__ __forceinline__ void ph_router(unsigned char* lds, const float* __restrict__ x1, const float* __restrict__ gf, const float* __restrict__ wg, const float* __restrict__ bg, const float* __restrict__ we,
                                          const float* __restrict__ be, bf16_t* __restrict__ H2, bf16_t* __restrict__ H2LO, int* __restrict__ cnt, int* __restrict__ sm, int* __restrict__ list) {
  const int tid_ = tid_fresh(), lane = tid_ & 63, wl = tid_ >> 6, wave = (blockIdx.x * 512 + tid_) >> 6, nw = (gridDim.x * 512) >> 6;
  float* hs = (float*)lds + wl * 1024;
  float* lgs = (float*)(lds + 32768) + wl * 64;
  for (int r = wave; r < NTOK; r += nw) {
    const float4* xr = (const float4*)(x1 + (size_t)r * D);
    float4 v[4]; float s = 0.f;
#pragma unroll
    for (int j = 0; j < 4; ++j) { v[j] = xr[lane + 64 * j]; s += v[j].x * v[j].x + v[j].y * v[j].y + v[j].z * v[j].z + v[j].w * v[j].w; }
    s = wave_sum(s);
    const float rstd = rsqrtf(s * (1.f / D) + 1e-6f);
#pragma unroll
    for (int j = 0; j < 4; ++j) {
      const float4 gg = ((const float4*)gf)[lane + 64 * j];
      float4 h; h.x = v[j].x * rstd * gg.x; h.y = v[j].y * rstd * gg.y; h.z = v[j].z * rstd * gg.z; h.w = v[j].w * rstd * gg.w;
      ushort4 hi, lo;
      hi.x = f2bf(h.x); hi.y = f2bf(h.y); hi.z = f2bf(h.z); hi.w = f2bf(h.w);
      lo.x = f2bf(h.x - bf2f(hi.x)); lo.y = f2bf(h.y - bf2f(hi.y)); lo.z = f2bf(h.z - bf2f(hi.z)); lo.w = f2bf(h.w - bf2f(hi.w));
      ((ushort4*)(H2 + (size_t)r * D))[lane + 64 * j] = hi;
      ((ushort4*)(H2LO + (size_t)r * D))[lane + 64 * j] = lo;
      ((float4*)hs)[lane + 64 * j] = h;
    }
    __builtin_amdgcn_wave_barrier();
    asm volatile("s_waitcnt lgkmcnt(0)" ::: "memory");
    float acc = 0.f;
    if (lane < 36) {
      const float* wp = lane < 4 ? (wg + lane) : (we + (lane - 4));
      const int ld = lane < 4 ? 4 : 32;
      for (int k = 0; k < 1024; ++k) acc += hs[k] * wp[(size_t)k * ld];
      acc += lane < 4 ? bg[lane] : be[lane - 4];
    }
    lgs[lane] = acc;
    asm volatile("s_waitcnt lgkmcnt(0)" ::: "memory");
    __builtin_amdgcn_wave_barrier();
    if (lane == 0) {
      int grp = 0; float gmax = -1e30f;
      for (int j = 0; j < 4; ++j) { const float gl = lgs[j]; if (gl > gmax) { gmax = gl; grp = j; } }
      float zs = 0.f;
      for (int j = 0; j < 4; ++j) zs += __expf(lgs[j] - gmax);
      const float pgrp = 1.f / zs;
      int i1 = 0; float v1 = -1e30f;
      for (int i = 0; i < 8; ++i) { const float e = lgs[4 + grp * 8 + i]; if (e > v1) { v1 = e; i1 = i; } }
      int i2 = 0; float v2 = -1e30f;
      for (int i = 0; i < 8; ++i) { const float e = lgs[4 + grp * 8 + i]; if (i != i1 && e > v2) { v2 = e; i2 = i; } }
      const float e2 = __expf(v2 - v1), w1 = 1.f / (1.f + e2), w2 = e2 * w1;
      const int e_a = grp * 8 + i1, e_b = grp * 8 + i2;
      const int ra = atomicAdd(&cnt[e_a], 1), rb = atomicAdd(&cnt[e_b], 1);
      sm[SM_EID + 2 * r] = e_a; sm[SM_EID + 2 * r + 1] = e_b;
      ((float*)sm)[SM_WT + 2 * r] = pgrp * w1; ((float*)sm)[SM_WT + 2 * r + 1] = pgrp * w2;
      sm[SM_RANK + 2 * r] = ra; sm[SM_RANK + 2 * r + 1] = rb;
      list[(size_t)e_a * NTOK + ra] = r; list[(size_t)e_b * NTOK + rb] = r;
    }
    asm volatile("s_waitcnt lgkmcnt(0)" ::: "memory");
    __builtin_amdgcn_wave_barrier();
  }
}
__device__ __forceinline__ void ph_final(float* __restrict__ out, const bf16_t* __restrict__ YS, const int* __restrict__ sm, const int* l_off, const float* __restrict__ gfin) {
  const int tid_ = tid_fresh(), lane = tid_ & 63, wave = (blockIdx.x * 512 + tid_) >> 6, nw = (gridDim.x * 512) >> 6;
  for (int r = wave; r < NTOK; r += nw) {
    const int s0 = l_off[sm[SM_EID + 2 * r]] + sm[SM_RANK + 2 * r], s1 = l_off[sm[SM_EID + 2 * r + 1]] + sm[SM_RANK + 2 * r + 1];
    const float w0 = ((const float*)sm)[SM_WT + 2 * r], w1 = ((const float*)sm)[SM_WT + 2 * r + 1];
    float4* xr = (float4*)(out + (size_t)r * D);
    float4 v[4]; float s = 0.f;
#pragma unroll
    for (int j = 0; j < 4; ++j) {
      v[j] = xr[lane + 64 * j];
      const ushort4 a = ((const ushort4*)(YS + (size_t)s0 * D))[lane + 64 * j], c = ((const ushort4*)(YS + (size_t)s1 * D))[lane + 64 * j];
      v[j].x += w0 * bf2f(a.x) + w1 * bf2f(c.x); v[j].y += w0 * bf2f(a.y) + w1 * bf2f(c.y); v[j].z += w0 * bf2f(a.z) + w1 * bf2f(c.z); v[j].w += w0 * bf2f(a.w) + w1 * bf2f(c.w);
      s += v[j].x * v[j].x + v[j].y * v[j].y + v[j].z * v[j].z + v[j].w * v[j].w;
    }
    s = wave_sum(s);
    const float rstd = rsqrtf(s * (1.f / D) + 1e-6f);
#pragma unroll
    for (int j = 0; j < 4; ++j) { const float4 gg = ((const float4*)gfin)[lane + 64 * j]; float4 o; o.x = v[j].x * rstd * gg.x; o.y = v[j].y * rstd * gg.y; o.z = v[j].z * rstd * gg.z; o.w = v[j].w * rstd * gg.w; xr[lane + 64 * j] = o; }
  }
}


struct WPtrs { const float *w_in, *w1k, *w2k, *w1v, *w2v, *w_a, *w_b, *w_o, *w_group, *w_expert, *w_gate, *w_up, *w_down;
               bf16_t *WinT, *WgnT, *W1kT, *W1vT, *W2kT, *W2vT, *WabT, *WoT, *WguT, *WdT, *WrtHi, *WrtLo; };
__device__ __forceinline__ void ph_weights(LAS unsigned char* lds, const WPtrs& w) {
  const int tid_ = tid_fresh(), lane = tid_ & 63, wl = __builtin_amdgcn_readfirstlane(tid_ >> 6);
  const int gw = blockIdx.x * 8 + wl, NGW = gridDim.x * 8;
  LAS float* scr = (LAS float*)(lds + wl * 16384);
  constexpr int I_IN = 2048, I_GN = 16, I_W1 = 256, I_W2 = 8, I_AB = 256, I_O = 512, I_GU = 4096, I_D = 4096;
  constexpr int NITEMS = I_IN + I_GN + 2 * I_W1 + 2 * I_W2 + 2 * I_AB + I_O + 2 * I_GU + I_D;
  for (int it = gw; it < NITEMS; it += NGW) {
    int r = it;
    if (r < I_IN) { const int rb = r >> 4, kb = r & 15, n0 = rb * 32; tr_item(w.w_in, INW, n0 + (n0 >= 1280 ? 24 : 0), 32, kb * 64, w.WinT, 1024, n0, 0, scr, lane); continue; } r -= I_IN;
    if (r < I_GN) { tr_item(w.w_in, INW, 1280, 24, r * 64, w.WgnT, 1024, 0, 0, scr, lane); continue; } r -= I_GN;
    if (r < I_W1) { const int rb = r >> 5, kb = r & 31; tr_item(w.w1k, 256, rb * 32, 32, kb * 64, w.W1kT, 2048, rb * 32, 0, scr, lane); continue; } r -= I_W1;
    if (r < I_W1) { const int rb = r >> 5, kb = r & 31; tr_item(w.w1v, 256, rb * 32, 32, kb * 64, w.W1vT, 2048, rb * 32, 0, scr, lane); continue; } r -= I_W1;
    if (r < I_W2) { const int rb = r >> 2, kb = r & 3; tr_item(w.w2k, 64, rb * 32, 32, kb * 64, w.W2kT, 256, rb * 32, 0, scr, lane); continue; } r -= I_W2;
    if (r < I_W2) { const int rb = r >> 2, kb = r & 3; tr_item(w.w2v, 64, rb * 32, 32, kb * 64, w.W2vT, 256, rb * 32, 0, scr, lane); continue; } r -= I_W2;
    if (r < I_AB) { const int rb = r >> 3, kb = r & 7; tr_item(w.w_b, 1024, rb * 32, 32, kb * 64, w.WabT, 1024, rb * 32, 0, scr, lane); continue; } r -= I_AB;
    if (r < I_AB) { const int rb = r >> 3, kb = r & 7; tr_item(w.w_a, 1024, rb * 32, 32, kb * 64, w.WabT, 1024, rb * 32, 512, scr, lane); continue; } r -= I_AB;
    if (r < I_O) { const int rb = r >> 4, kb = r & 15; tr_item(w.w_o, 1024, rb * 32, 32, kb * 64, w.WoT, 1024, rb * 32, 0, scr, lane); continue; } r -= I_O;
    if (r < I_GU) { const int e = r >> 7, q = r & 127, cb = q >> 4, kb = q & 15, c0 = cb * 32; tr_item(w.w_gate + (size_t)e * 1024 * 256, 256, c0, 32, kb * 64, w.WguT + (size_t)e * 512 * 1024, 1024, (c0 >> 7) * 256 + (c0 & 127), 0, scr, lane); continue; } r -= I_GU;
    if (r < I_GU) { const int e = r >> 7, q = r & 127, cb = q >> 4, kb = q & 15, c0 = cb * 32; tr_item(w.w_up + (size_t)e * 1024 * 256, 256, c0, 32, kb * 64, w.WguT + (size_t)e * 512 * 1024, 1024, (c0 >> 7) * 256 + 128 + (c0 & 127), 0, scr, lane); continue; } r -= I_GU;
    { const int e = r >> 7, q = r & 127, cb = q >> 2, kb = q & 3; tr_item(w.w_down + (size_t)e * 256 * 1024, 1024, cb * 32, 32, kb * 64, w.WdT + (size_t)e * 1024 * 256, 256, cb * 32, 0, scr, lane); }
  }
  for (int i = blockIdx.x * 512 + tid_; i < 64 * 1024; i += gridDim.x * 512) {
    const int j = i >> 10, k = i & 1023; const float v = j < 4 ? w.w_group[k * 4 + j] : (j < 36 ? w.w_expert[k * 32 + (j - 4)] : 0.f);
    const bf16_t hi = f2bf(v); w.WrtHi[i] = hi; w.WrtLo[i] = f2bf(v - bf2f(hi));
  }
}
struct BL_gn { const float* W; __device__ float operator()(int, int k, int n) const { return n < 24 ? W[(size_t)k * INW + 1280 + n] : 0.f; } };
struct EP_gn { float* GN; __device__ void operator()(int m, int n, float v) const { if (n < 24) GN[(size_t)m * 32 + n] = sigmoidf_(v); } };

struct Args { const float* in[22]; float* out; unsigned char* ws; };
constexpr int PTAB_OFF = 131072 + 4096;
#define PIN(i) ((const float*)ldptr(ptab, (i)))
#define POUT ((float*)ldptr(ptab, 22))
#define PWS ((unsigned char*)ldptr(ptab, 23))
#define WSB(off) ((bf16_t*)(ws + (off)))
__global__ void __launch_bounds__(512, 2) mega_fwd(Args a) {
  extern __shared__ __attribute__((aligned(16))) unsigned char lds[];
  LAS unsigned char* ldsl = (LAS unsigned char*)lds;
  LAS u64_t* ptab = (LAS u64_t*)(ldsl + PTAB_OFF);
  volatile LAS unsigned* MISC = (volatile LAS unsigned*)(ldsl + MISC_OFF);
  if (threadIdx.x == 0) {
#pragma unroll
    for (int i = 0; i < 22; ++i) ptab[i] = (u64_t)a.in[i];
    ptab[22] = (u64_t)a.out; ptab[23] = (u64_t)a.ws;
  }
  if (threadIdx.x < 32) MISC[threadIdx.x] = 0u;
  __syncthreads();
  XcdBarrier bar = xcd_barrier_post((unsigned*)PWS, MISC + 8);
  int* l_off = (int*)(lds + 131072 + 1024);
  int* l_te = (int*)(lds + 131072 + 1024 + 256);
#define GRID_BAR() do { bar.bar = (unsigned*)PWS; xcd_barrier(bar); } while (0)

  {
    unsigned char* ws = PWS;
    WPtrs w{PIN(2), PIN(4), PIN(5), PIN(7), PIN(8), PIN(10), PIN(11), PIN(12), PIN(14), PIN(16), PIN(18), PIN(19), PIN(20),
            WSB(WS_WINT), WSB(WS_WGNT), WSB(WS_W1KT), WSB(WS_W1VT), WSB(WS_W2KT), WSB(WS_W2VT), WSB(WS_WABT), WSB(WS_WOT), WSB(WS_WGUT), WSB(WS_WDT), WSB(WS_WRT_HI), WSB(WS_WRT_LO)};
    ph_weights(ldsl, w);
    ph_prep_xn(PIN(0), PIN(1), WSB(WS_XN));
  }
  GRID_BAR();
  {
    unsigned char* ws = PWS;
    pg8::SchedDense Sd; Sd.init(ws + WS_XN, 2048, ws + WS_WINT, NTOK, 4096, 1024, gridDim.x, blockIdx.x);
    pg8::EpiProj E{WSB(WS_QA), WSB(WS_QB), WSB(WS_KVC), WSB(WS_KVS), WSB(WS_KVW), WSB(WS_KVB), WSB(WS_GM)};
    pg8::gemm_phase<pg8::EpiProj, pg8::SchedDense, true>(ldsl, 1024, 128, Sd, E);
  }
  {
    unsigned char* ws = PWS;
    naive_gemm_phase(lds, AL_bf16{WSB(WS_XN), 1024, NTOK}, BL_gn{PIN(2)}, EP_gn{(float*)(ws + WS_GN)}, 1024, NTOK / 64, 1);
  }
  GRID_BAR();
  {
    unsigned char* ws = PWS;
    naive_gemm_phase(lds, AL_cmp{WSB(WS_KVC), PIN(3), 0}, BL_f32{PIN(4), 256, 256}, EP_silu{(float*)(ws + WS_T1K), 2032, 256}, 2048, 32, 4);
    naive_gemm_phase(lds, AL_cmp{WSB(WS_KVC), PIN(6), 1}, BL_f32{PIN(7), 256, 256}, EP_silu{(float*)(ws + WS_T1V), 2032, 256}, 2048, 32, 4);
    naive_swa_phase(lds, WSB(WS_QB), WSB(WS_KVB), PIN(9), WSB(WS_OAB));
  }
  GRID_BAR();
  {
    unsigned char* ws = PWS;
    naive_gemm_phase(lds, AL_f32{(const float*)(ws + WS_T1K), 256, 2032}, BL_f32{PIN(5), 64, 64}, EP_kc{WSB(WS_KC)}, 256, 32, 1);
    naive_gemm_phase(lds, AL_f32{(const float*)(ws + WS_T1V), 256, 2032}, BL_f32{PIN(8), 64, 64}, EP_kc{WSB(WS_VC)}, 256, 32, 1);
  }
  GRID_BAR();
  {
    unsigned char* ws = PWS;
    naive_nsa_phase(lds, WSB(WS_QA), WSB(WS_KC), WSB(WS_VC), WSB(WS_KVS), WSB(WS_KVW), (const float*)(ws + WS_GN), WSB(WS_OAB));
  }
  GRID_BAR();
  {
    unsigned char* ws = PWS;
    pg8::SchedDense Sd; Sd.init(ws + WS_OAB, 2048, ws + WS_WABT, NTOK, 1024, 1024, gridDim.x, blockIdx.x);
    pg8::EpiMerge E{WSB(WS_GM), WSB(WS_MG)};
    pg8::gemm_phase<pg8::EpiMerge, pg8::SchedDense, true>(ldsl, 1024, 128, Sd, E);
  }
  GRID_BAR();
  {
    unsigned char* ws = PWS;
    pg8::SchedDense Sd; Sd.init(ws + WS_MG, 2048, ws + WS_WOT, NTOK, 1024, 1024, gridDim.x, blockIdx.x);
    pg8::EpiX1 E{PIN(0), POUT};
    pg8::gemm_phase<pg8::EpiX1, pg8::SchedDense, true>(ldsl, 1024, 128, Sd, E);
  }
  GRID_BAR();
  {
    unsigned char* ws = PWS;
    ph_router(lds, POUT, PIN(13), PIN(14), PIN(15), PIN(16), PIN(17), WSB(WS_H2), WSB(WS_H2LO), (int*)(ws + WS_CTL) + CW_CNT, (int*)(ws + WS_SMALL), (int*)(ws + WS_LIST));
  }
  GRID_BAR();
  {
    unsigned char* ws = PWS;
    const int* cnt = (const int*)(ws + WS_CTL) + CW_CNT;
    moe_tables(cnt, l_off, l_te);
    pg8::SchedMoeUp Sm{(const char*)(ws + WS_H2), (const char*)(ws + WS_WGUT), (const int*)(ws + WS_LIST), cnt, l_off, l_te, (int)gridDim.x, (int)blockIdx.x};
    pg8::EpiHB E{WSB(WS_HB)};
    pg8::gemm_phase<pg8::EpiHB, pg8::SchedMoeUp, true>(ldsl, 1024, 128, Sm, E);
  }
  GRID_BAR();
  {
    unsigned char* ws = PWS;
    pg8::SchedMoeDown Sm{(const char*)(ws + WS_HB), (const char*)(ws + WS_WDT), l_off, l_te, (int)gridDim.x, (int)blockIdx.x};
    pg8::EpiYS E{WSB(WS_YS)};
    pg8::gemm_phase<pg8::EpiYS, pg8::SchedMoeDown, true>(ldsl, 256, 128, Sm, E);
  }
  GRID_BAR();
  {
    unsigned char* ws = PWS;
    ph_final(POUT, WSB(WS_YS), (const int*)(ws + WS_SMALL), l_off, PIN(21));
  }
}

extern "C" void kernel_launch(void* const* d_in, const int* in_sizes, int n_in, void* d_out, int out_size, void* d_ws, size_t ws_size, hipStream_t stream) {
  static int grid = 0;
  if (grid == 0) {
    int dev = 0, cus = 0, per_cu = 0;
    if (hipGetDevice(&dev) != hipSuccess || hipDeviceGetAttribute(&cus, hipDeviceAttributeMultiprocessorCount, dev) != hipSuccess) { fprintf(stderr, "kernel_launch: device query failed\n"); grid = -1; return; }
    if (hipFuncSetAttribute((const void*)mega_fwd, hipFuncAttributeMaxDynamicSharedMemorySize, LDS_BYTES) != hipSuccess) { fprintf(stderr, "kernel_launch: hipFuncSetAttribute failed\n"); grid = -1; return; }
    if (hipOccupancyMaxActiveBlocksPerMultiprocessor(&per_cu, (const void*)mega_fwd, 512, LDS_BYTES) != hipSuccess || per_cu < 1) { fprintf(stderr, "kernel_launch: occupancy query says %d blocks/CU\n", per_cu); (void)hipGetLastError(); grid = -1; return; }
    grid = cus;
  }
  if (grid < 0) return;
  (void)hipMemsetAsync((char*)d_ws + WS_CTL, 0, CTL_ZERO_BYTES, stream);
  Args a{};
  for (int i = 0; i < 22; ++i) a.in[i] = (const float*)d_in[i];
  a.out = (float*)d_out; a.ws = (unsigned char*)d_ws;
  hipLaunchKernelGGL(mega_fwd, dim3(grid), dim3(512), LDS_BYTES, stream, a);
}
```

```cpp
#include <hip/hip_runtime.h>
#include <stdint.h>
#include <cstdio>

typedef unsigned short bf16_t;
#define LAS __attribute__((address_space(3)))
#define GAS __attribute__((address_space(1)))
__device__ __forceinline__ float bf2f(bf16_t v) { return __uint_as_float(((unsigned)v) << 16); }
__device__ __forceinline__ bf16_t f2bf(float f) { unsigned u = __float_as_uint(f); return (bf16_t)((u + 0x7fffu + ((u >> 16) & 1u)) >> 16); }
__device__ __forceinline__ float wave_sum(float v) {
#pragma unroll
  for (int o = 1; o < 64; o <<= 1) v += __shfl_xor(v, o);
  return v;
}
__device__ __forceinline__ float wave_max(float v) {
#pragma unroll
  for (int o = 1; o < 64; o <<= 1) v = fmaxf(v, __shfl_xor(v, o));
  return v;
}
__device__ __forceinline__ float sigmoidf_(float v) { return 1.f / (1.f + __expf(-v)); }

__device__ __forceinline__ int tid_fresh() { int t = threadIdx.x; asm volatile("" : "+v"(t)); return t; }
typedef unsigned long long u64_t;
__device__ __forceinline__ const void* ldptr(const LAS u64_t* tab, int i) {
  const u64_t v = tab[i]; const unsigned lo = __builtin_amdgcn_readfirstlane((unsigned)v), hi = __builtin_amdgcn_readfirstlane((unsigned)(v >> 32));
  return (const void*)(((u64_t)hi << 32) | lo);
}

constexpr int NB = 8, S = 2048, D = 1024, NTOK = NB * S;
constexpr int INW = 4120;
constexpr int NSLOT = 40960;
constexpr size_t MiB = 1u << 20;
constexpr size_t WS_CTL = 0;
constexpr int CW_CNT = 4096;
constexpr size_t CTL_ZERO_BYTES = 65536;
constexpr size_t WS_SMALL = 1 * MiB;
constexpr size_t WS_LIST = 233 * MiB;
constexpr size_t WS_W1KT = 2 * MiB, WS_W1VT = 3 * MiB;
constexpr size_t WS_W2KT = 4 * MiB, WS_W2VT = 4 * MiB + 32768;
constexpr size_t WS_WGNT = 4 * MiB + 65536;
constexpr size_t WS_WRT_HI = 4 * MiB + 131072, WS_WRT_LO = 4 * MiB + 262144;
constexpr size_t WS_WABT = 5 * MiB;
constexpr size_t WS_WOT = 7 * MiB;
constexpr size_t WS_WGUT = 10 * MiB;
constexpr size_t WS_WDT = 42 * MiB;
constexpr size_t WS_WINT = 58 * MiB;
constexpr size_t WS_OAB = 66 * MiB;
constexpr size_t WS_XN = 66 * MiB;
constexpr size_t WS_OA = 66 * MiB, WS_OB = 82 * MiB;
constexpr size_t WS_YS = 66 * MiB;
constexpr size_t WS_GM = 98 * MiB;
constexpr size_t WS_H2 = 98 * MiB, WS_H2LO = 130 * MiB;
constexpr size_t WS_QA = 162 * MiB, WS_QB = 178 * MiB, WS_KVC = 194 * MiB, WS_KVS = 202 * MiB, WS_KVW = 210 * MiB, WS_KVB = 218 * MiB;
constexpr size_t WS_MG = 162 * MiB;
constexpr size_t WS_HB = 162 * MiB;
constexpr size_t WS_GTMP = 182 * MiB;
constexpr size_t WS_GN = 226 * MiB;
constexpr size_t WS_KC = 228 * MiB, WS_VC = WS_KC + 256 * 1024, WS_T1K = 229 * MiB, WS_T1V = 231 * MiB;
constexpr int SM_EID = 0, SM_WT = SM_EID + 2 * NTOK, SM_RANK = SM_WT + 2 * NTOK;
static_assert((SM_RANK + 2 * NTOK) * 4 <= (int)MiB, "small");

constexpr int LDS_BYTES = 147456;
constexpr int MISC_OFF = 131072 + 320;

#define XB_TMO      128
#define XB_XCNT(j)  (256  + 64 * (j))
#define XB_XSUB(j)  (1280 + 64 * (j))
#define XB_XGEN(j)  (2304 + 64 * (j))
#define XB_TOP      3328
#define XB_TOPGEN   3392
#define XCD_BAR_WORDS 3456
#define XB_SPIN_CAP (1u << 20)
__device__ __forceinline__ unsigned xb_ld(unsigned* p)              { return __hip_atomic_load(p, __ATOMIC_RELAXED, __HIP_MEMORY_SCOPE_AGENT); }
__device__ __forceinline__ unsigned xb_add(unsigned* p, unsigned v) { return __hip_atomic_fetch_add(p, v, __ATOMIC_RELAXED, __HIP_MEMORY_SCOPE_AGENT); }
__device__ __forceinline__ unsigned xb_xcc_id() { return (unsigned)__builtin_amdgcn_s_getreg((3 << 11) | 20) & 0xFu; }
#define XB_SPIN(cond, bar) do { unsigned _sp = 0; while (cond) { __builtin_amdgcn_s_sleep(1); \
    if ((++_sp & 255u) == 0u) { if (xb_ld(&(bar)[XB_TMO])) break; if (_sp > XB_SPIN_CAP) { atomicAdd(&(bar)[XB_TMO], 1u); break; } } } } while (0)
struct XcdBarrier { unsigned* bar; unsigned x; volatile LAS unsigned* st; };
__device__ __forceinline__ XcdBarrier xcd_barrier_post(unsigned* bar, volatile LAS unsigned* st) {
    XcdBarrier b; b.bar = bar; b.x = xb_xcc_id(); b.st = st;
    if (threadIdx.x == 0) (void)xb_add(&bar[XB_XCNT(b.x)], 1u);
    return b;
}
__device__ __forceinline__ void xcd_barrier_complete(unsigned* bar, unsigned x, unsigned& nloc, unsigned& nx) {
    const unsigned G = gridDim.x * gridDim.y * gridDim.z;
    unsigned sum, cnt, mine, sp = 0u;
    for (;;) {
        sum = 0u; cnt = 0u; mine = 0u;
#pragma unroll
        for (unsigned j = 0; j < 16; ++j) { const unsigned c = xb_ld(&bar[XB_XCNT(j)]); sum += c; cnt += (c > 0u) ? 1u : 0u; mine = (j == x) ? c : mine; }
        if (sum == G) break;
        __builtin_amdgcn_s_sleep(1);
        if ((++sp & 255u) == 0u) { if (xb_ld(&bar[XB_TMO])) break; if (sp > XB_SPIN_CAP) { atomicAdd(&bar[XB_TMO], 1u); break; } }
    }
    nloc = mine > 0u ? mine : 1u; nx = cnt > 0u ? cnt : 1u;
}
__device__ __forceinline__ void xcd_barrier(const XcdBarrier& b) {
    asm volatile("s_waitcnt vmcnt(0)" ::: "memory");
    __syncthreads();
    if (threadIdx.x == 0) {
        unsigned* bar = b.bar;
        __builtin_amdgcn_s_waitcnt(0);
        unsigned nloc = b.st[0], nx = b.st[1];
        if (nloc == 0u) { xcd_barrier_complete(bar, b.x, nloc, nx); b.st[0] = nloc; b.st[1] = nx; }
        const unsigned old = xb_add(&bar[XB_XSUB(b.x)], 1u);
        const unsigned gen = old / nloc;
        if (old + 1u == (gen + 1u) * nloc) {
            __builtin_amdgcn_fence(__ATOMIC_RELEASE, "agent");
            asm volatile("s_waitcnt vmcnt(0)" ::: "memory");
            const unsigned og = xb_add(&bar[XB_TOP], 1u);
            const unsigned tg = og / nx;
            if (og + 1u == (tg + 1u) * nx) xb_add(&bar[XB_TOPGEN], 1u);
            else XB_SPIN(xb_ld(&bar[XB_TOPGEN]) == tg, bar);
            __builtin_amdgcn_fence(__ATOMIC_ACQUIRE, "agent");
            xb_add(&bar[XB_XGEN(b.x)], 1u);
            asm volatile("s_waitcnt vmcnt(0)" ::: "memory");
        } else {
            XB_SPIN(xb_ld(&bar[XB_XGEN(b.x)]) == gen, bar);
            __builtin_amdgcn_fence(__ATOMIC_ACQUIRE, "agent");
            asm volatile("s_waitcnt vmcnt(0)" ::: "memory");
        }
    }
    __syncthreads();
}


namespace pg8 {
typedef short bf16x8 __attribute__((ext_vector_type(8)));
typedef float f32x4 __attribute__((ext_vector_type(4)));
typedef unsigned u32x4 __attribute__((ext_vector_type(4)));
typedef unsigned u32x2 __attribute__((ext_vector_type(2)));
constexpr int BM = 256, BK = 64, HALF = 128, HTB = HALF * BK * 2, STAGE_BYTES = 8 * HTB, NXCD = 8, WGM = 8;
__host__ __device__ __forceinline__ int lds_byte(int r, int c) { const int st = (r >> 4) * 2 + (c >> 5), rr = r & 15, cc = c & 31, ob = rr * 64 + cc * 2; return st * 1024 + (ob ^ (((ob >> 9) & 1) << 5)); }
__host__ __device__ __forceinline__ void stage_rc(int b, int& R, int& C) { const int st = b / 1024, sb = b % 1024, swz = sb ^ (((sb >> 9) & 1) << 5); R = (st >> 1) * 16 + swz / 64; C = (st & 1) * 32 + (swz % 64) / 2; }
__host__ __device__ __forceinline__ int perm32(int rho) { const int n = rho >> 4, i = rho & 15; return 8 * (i >> 2) + 4 * n + (i & 3); }
struct Unit { int pm, pn; const char* A; const char* B; };
__device__ __forceinline__ unsigned cvt_pk_bf16(float lo, float hi) { unsigned r; asm volatile("v_cvt_pk_bf16_f32 %0, %1, %2" : "=v"(r) : "v"(lo), "v"(hi)); return r; }

template <class Epi, class Sched, bool ALIGN_EPI>
__device__ __forceinline__ void gemm_phase(LAS unsigned char* lds, const int K, const int kstepA, const Sched& S, const Epi& E) {
    const int tid = tid_fresh(), wid = __builtin_amdgcn_readfirstlane(tid >> 6), lane = tid & 63, wr = wid >> 2, wc = wid & 3, fr = lane & 15, fq = lane >> 4;
    const int nt = K / BK;
    int Rr[2], Cc[2]; unsigned voffB[2];
#pragma unroll
    for (int i = 0; i < 2; ++i) { stage_rc(tid * 16 + i * 8192, Rr[i], Cc[i]); const int Rb = Epi::PERM ? ((Rr[i] & ~31) + perm32(Rr[i] & 31)) : Rr[i]; voffB[i] = (unsigned)(Rb * K + Cc[i]) * 2u; }
    const size_t kstepB = (size_t)(BK * 2);
    const size_t hstepB = (size_t)HALF * K * 2;
    const unsigned ldsw = (unsigned)wid * 1024u;
    const int aoff = lds_byte(wr * 64 + fr, fq * 8), boff = lds_byte(wc * 32 + fr, fq * 8);
#define PG8_SA(b, h) (((b) * 2 + (h)) * HTB)
#define PG8_SB(b, h) ((4 + (b) * 2 + (h)) * HTB)
#define PG8_STAGEB(bufoff, gbase) do { _Pragma("unroll") for (int _i = 0; _i < 2; ++_i) \
        __builtin_amdgcn_global_load_lds((const unsigned*)((const char*)(gbase) + voffB[_i]), (LAS unsigned*)(lds + (bufoff) + ldsw + _i * 8192), 16, 0, 0); } while (0)
#define PG8_STAGEA(bufoff, gbase, v0, v1) do { \
        __builtin_amdgcn_global_load_lds((const unsigned*)((const char*)(gbase) + (v0)), (LAS unsigned*)(lds + (bufoff) + ldsw), 16, 0, 0); \
        __builtin_amdgcn_global_load_lds((const unsigned*)((const char*)(gbase) + (v1)), (LAS unsigned*)(lds + (bufoff) + ldsw + 8192), 16, 0, 0); } while (0)
#define PG8_LDA(dst, b, h) do { _Pragma("unroll") for (int m = 0; m < 4; ++m) _Pragma("unroll") for (int k = 0; k < 2; ++k) dst[m][k] = *(const LAS bf16x8*)(lds + PG8_SA(b, h) + aoff + m * 2048 + k * 1024); } while (0)
#define PG8_LDB(dst, b, h) do { _Pragma("unroll") for (int n = 0; n < 2; ++n) _Pragma("unroll") for (int k = 0; k < 2; ++k) dst[n][k] = *(const LAS bf16x8*)(lds + PG8_SB(b, h) + boff + n * 2048 + k * 1024); } while (0)
#define PG8_MMA(ai, bj, At, Bt) do { __builtin_amdgcn_s_setprio(1); _Pragma("unroll") for (int m = 0; m < 4; ++m) _Pragma("unroll") for (int n = 0; n < 2; ++n) _Pragma("unroll") for (int k = 0; k < 2; ++k) \
        acc[ai][bj][m][n] = __builtin_amdgcn_mfma_f32_16x16x32_bf16(Bt[n][k], At[m][k], acc[ai][bj][m][n], 0, 0, 0); __builtin_amdgcn_s_setprio(0); } while (0)
#define PG8_WAIT_V(n) asm volatile("s_waitcnt vmcnt(" #n ")" ::: "memory")
#define PG8_WAIT_L(n) asm volatile("s_waitcnt lgkmcnt(" #n ")" ::: "memory")
#define PG8_BAR __builtin_amdgcn_s_barrier()
#define PG8_SCHED __builtin_amdgcn_sched_barrier(0)
    Unit cur, nxt; int ui = 0;
    if (!S.next(0, cur)) return;
    f32x4 acc[2][2][4][2];
#pragma unroll
    for (int a = 0; a < 2; ++a)
#pragma unroll
        for (int b = 0; b < 2; ++b)
#pragma unroll
            for (int m = 0; m < 4; ++m)
#pragma unroll
                for (int n = 0; n < 2; ++n) acc[a][b][m][n] = (f32x4){0.f, 0.f, 0.f, 0.f};
    bf16x8 At[4][2], B0[2][2], B1[2][2];
    unsigned vc00, vc01, vc10, vc11;
    vc00 = S.arow(cur, Rr[0]) + (unsigned)Cc[0] * 2u; vc01 = S.arow(cur, Rr[1]) + (unsigned)Cc[1] * 2u;
    vc10 = S.arow(cur, HALF + Rr[0]) + (unsigned)Cc[0] * 2u; vc11 = S.arow(cur, HALF + Rr[1]) + (unsigned)Cc[1] * 2u;
    const char* cA = cur.A; const char* cB = cur.B;
    PG8_STAGEB(PG8_SB(0, 0), cB); PG8_STAGEB(PG8_SB(0, 1), cB + hstepB); PG8_STAGEA(PG8_SA(0, 0), cA, vc00, vc01); PG8_STAGEA(PG8_SA(0, 1), cA, vc10, vc11);
    if (wr == 1) PG8_BAR;
    PG8_WAIT_V(2); PG8_BAR;
    PG8_STAGEB(PG8_SB(1, 0), cB + kstepB); PG8_STAGEA(PG8_SA(1, 0), cA + kstepA, vc00, vc01); PG8_STAGEB(PG8_SB(1, 1), cB + hstepB + kstepB);
    PG8_WAIT_V(6); PG8_BAR;
    for (;;) {
        const bool has_next = S.next(ui + 1, nxt);
        const char* nA = has_next ? nxt.A : cA; const char* nB = has_next ? nxt.B : cB;
        unsigned vn00 = vc00, vn01 = vc01, vn10 = vc10, vn11 = vc11;
        if (Sched::GATHER && has_next) {
            vn00 = S.arow(nxt, Rr[0]) + (unsigned)Cc[0] * 2u; vn01 = S.arow(nxt, Rr[1]) + (unsigned)Cc[1] * 2u;
            vn10 = S.arow(nxt, HALF + Rr[0]) + (unsigned)Cc[0] * 2u; vn11 = S.arow(nxt, HALF + Rr[1]) + (unsigned)Cc[1] * 2u;
        }
#pragma unroll 1
        for (int t = 0; t < nt; t += 2) {
            const bool last = (t == nt - 2);
            if (Epi::HOOK) { if (t == nt / 2) E.mid(acc, cur, wr, wc, fr, fq); }
            const char* a1 = cA + (size_t)(t + 1) * kstepA;
            const char* a2 = last ? nA : cA + (size_t)(t + 2) * kstepA; const char* b2 = last ? nB : cB + (size_t)(t + 2) * kstepB;
            const char* a3 = a2 + kstepA; const char* b3 = b2 + kstepB;
            const unsigned w00 = last ? vn00 : vc00, w01 = last ? vn01 : vc01, w10 = last ? vn10 : vc10, w11 = last ? vn11 : vc11;
            PG8_LDB(B0, 0, 0); PG8_LDB(B1, 0, 1); PG8_SCHED; PG8_LDA(At, 0, 0); PG8_STAGEA(PG8_SA(1, 1), a1, vc10, vc11);
            PG8_WAIT_V(8); PG8_WAIT_L(0); PG8_BAR; PG8_MMA(0, 0, At, B0); PG8_MMA(0, 1, At, B1); PG8_BAR; PG8_SCHED;
            PG8_LDA(At, 0, 1); PG8_STAGEB(PG8_SB(0, 0), b2); PG8_STAGEB(PG8_SB(0, 1), b2 + hstepB); PG8_STAGEA(PG8_SA(0, 0), a2, w00, w01);
            PG8_WAIT_V(8); PG8_WAIT_L(0); PG8_BAR; PG8_MMA(1, 0, At, B0); PG8_MMA(1, 1, At, B1); PG8_BAR; PG8_SCHED;
            PG8_LDB(B0, 1, 0); PG8_LDB(B1, 1, 1); PG8_SCHED; PG8_LDA(At, 1, 0); PG8_STAGEA(PG8_SA(0, 1), a2, w10, w11);
            PG8_WAIT_V(8); PG8_WAIT_L(0); PG8_BAR; PG8_MMA(0, 0, At, B0); PG8_MMA(0, 1, At, B1); PG8_BAR; PG8_SCHED;
            PG8_LDA(At, 1, 1); PG8_STAGEB(PG8_SB(1, 0), b3); PG8_STAGEB(PG8_SB(1, 1), b3 + hstepB); PG8_STAGEA(PG8_SA(1, 0), a3, w00, w01);
            PG8_WAIT_V(8); PG8_WAIT_L(0); PG8_BAR; PG8_MMA(1, 0, At, B0); PG8_MMA(1, 1, At, B1); PG8_BAR; PG8_SCHED;
        }
        if constexpr (ALIGN_EPI) { if (wr == 0) PG8_BAR; }
        E(acc, cur, wr, wc, fr, fq);
        if (!has_next) break;
#pragma unroll
        for (int a = 0; a < 2; ++a)
#pragma unroll
            for (int b = 0; b < 2; ++b)
#pragma unroll
                for (int m = 0; m < 4; ++m)
#pragma unroll
                    for (int n = 0; n < 2; ++n) acc[a][b][m][n] = (f32x4){0.f, 0.f, 0.f, 0.f};
        cur = nxt; cA = nA; cB = nB; vc00 = vn00; vc01 = vn01; vc10 = vn10; vc11 = vn11; ++ui;
        if constexpr (ALIGN_EPI) { if (wr == 1) PG8_BAR; }
    }
    PG8_WAIT_V(0);
    if constexpr (!ALIGN_EPI) { if (wr == 0) PG8_BAR; }
    PG8_BAR;
#undef PG8_SA
#undef PG8_SB
#undef PG8_STAGEA
#undef PG8_STAGEB
#undef PG8_LDA
#undef PG8_LDB
#undef PG8_MMA
#undef PG8_WAIT_V
#undef PG8_WAIT_L
#undef PG8_BAR
#undef PG8_SCHED
}

struct SchedDense {
    static constexpr bool GATHER = false;
    const char* A; const char* B; int pitchA  ; int K; int nM, nN, nwg, G, c;
    __device__ void init(const void* A_, int pitchA_, const void* B_, int M, int N, int K_, int G_, int c_) { A = (const char*)A_; B = (const char*)B_; pitchA = pitchA_; K = K_; nM = M / BM; nN = N / BM; nwg = nM * nN; G = G_; c = c_; }
    __device__ bool next(int i, Unit& u) const {
        const long L = (long)i * G + c; if (L >= nwg) return false;
        int wgid = (int)L; { const int q = nwg / NXCD, r = nwg % NXCD, xcd = wgid % NXCD, off = wgid / NXCD; wgid = (xcd < r ? xcd * (q + 1) : r * (q + 1) + (xcd - r) * q) + off; }
        const int nig = WGM * nN, gid = wgid / nig, fm = gid * WGM, gsz = (nM - fm) < WGM ? (nM - fm) : WGM;
        u.pm = fm + ((wgid % nig) % gsz); u.pn = (wgid % nig) / gsz;
        u.A = A + (size_t)u.pm * BM * pitchA; u.B = B + (size_t)u.pn * BM * K * 2; return true;
    }
    __device__ unsigned arow(const Unit&, int r) const { return (unsigned)(r * pitchA); }
};
struct SchedMoeUp {
    static constexpr bool GATHER = true;
    const char* H2; const char* W; const int* list; const int* cnt; const int* l_off; const int* l_te; int G, c;
    __device__ bool next(int i, Unit& u) const {
        const int L = i * G + c, tix = L >> 1; if (tix >= (l_off[32] >> 8)) return false;
        u.pm = tix; u.pn = L & 1; const int e = l_te[tix];
        u.A = H2; u.B = W + (size_t)e * (512 * 1024 * 2) + (size_t)u.pn * (256 * 1024 * 2); return true;
    }
    __device__ unsigned arow(const Unit& u, int r) const { const int e = l_te[u.pm]; int ri = u.pm * 256 + r - l_off[e]; if (ri >= cnt[e]) ri = 0; return (unsigned)list[(size_t)e * NTOK + ri] * 2048u; }
};
struct SchedMoeDown {
    static constexpr bool GATHER = false;
    const char* HB; const char* W; const int* l_off; const int* l_te; int G, c;
    __device__ bool next(int i, Unit& u) const {
        const int L = i * G + c, tix = L >> 2; if (tix >= (l_off[32] >> 8)) return false;
        u.pm = tix; u.pn = L & 3; const int e = l_te[tix];
        u.A = HB + (size_t)tix * (256 * 512); u.B = W + (size_t)e * (1024 * 256 * 2) + (size_t)u.pn * (256 * 256 * 2); return true;
    }
    __device__ unsigned arow(const Unit&, int r) const { return (unsigned)(r * 512); }
};

__device__ __forceinline__ float sigm(float v) { return __builtin_amdgcn_rcpf(1.f + __expf(-v)); }
struct EpiProj {
    static constexpr bool PERM = true, HOOK = false;
    bf16_t *QA, *QB, *KVC, *KVS, *KVW, *KVB, *GM;
    __device__ __forceinline__ void mid(f32x4 (&)[2][2][4][2], const Unit&, int, int, int, int) const {}
    __device__ __forceinline__ void operator()(const f32x4 (&acc)[2][2][4][2], const Unit& u, int wr, int wc, int fr, int fq) const {
        const int pn = u.pn; bf16_t* base; int ldc, colt; bool sg = false;
        if (pn < 2) { base = QA; ldc = 512; colt = pn * 256; }
        else if (pn == 2) { base = KVC; ldc = 256; colt = 0; }
        else if (pn == 3) { base = KVS; ldc = 256; colt = 0; }
        else if (pn == 4) { base = KVW; ldc = 256; colt = 0; }
        else if (pn < 7) { base = QB; ldc = 512; colt = (pn - 5) * 256; }
        else if (pn == 7) { base = KVB; ldc = 256; colt = 0; }
        else { base = GM; ldc = 2048; colt = (pn - 8) * 256; sg = true; }
        const int row0 = u.pm * BM + wr * 64 + fr, col0 = colt + wc * 32 + 8 * fq;
#pragma unroll
        for (int ai = 0; ai < 2; ++ai)
#pragma unroll
            for (int m = 0; m < 4; ++m) { bf16_t* rowp = base + (size_t)(row0 + ai * HALF + m * 16) * ldc + col0;
#pragma unroll
                for (int bj = 0; bj < 2; ++bj) { f32x4 v0 = acc[ai][bj][m][0], v1 = acc[ai][bj][m][1];
                    if (sg) { v0 = (f32x4){sigm(v0[0]), sigm(v0[1]), sigm(v0[2]), sigm(v0[3])}; v1 = (f32x4){sigm(v1[0]), sigm(v1[1]), sigm(v1[2]), sigm(v1[3])}; }
                    u32x4 w; w.x = cvt_pk_bf16(v0[0], v0[1]); w.y = cvt_pk_bf16(v0[2], v0[3]); w.z = cvt_pk_bf16(v1[0], v1[1]); w.w = cvt_pk_bf16(v1[2], v1[3]);
                    *(u32x4*)(rowp + bj * HALF) = w; } }
    }
};
struct EpiMerge {
    static constexpr bool PERM = true, HOOK = true;
    const bf16_t* GM; bf16_t* MG;
    __device__ __forceinline__ void mid(f32x4 (&acc)[2][2][4][2], const Unit& u, int wr, int wc, int fr, int fq) const {
        const int row0 = u.pm * BM + wr * 64 + fr, col0 = u.pn * BM + wc * 32 + 8 * fq;
        const GAS char* gm = (const GAS char*)GM + ((size_t)row0 * 2048 + col0) * 2;
#pragma unroll
        for (int ai = 0; ai < 2; ++ai)
#pragma unroll
            for (int m = 0; m < 4; ++m) { unsigned ro = (unsigned)(ai * HALF + m * 16) * 4096u; asm volatile("" : "+v"(ro));
#pragma unroll
                for (int bj = 0; bj < 2; ++bj) { const u32x4 ga = *(const GAS u32x4*)(gm + ro + bj * 256), gb = *(const GAS u32x4*)(gm + ro + 2048 + bj * 256);
                    const unsigned gaw[4] = {ga.x, ga.y, ga.z, ga.w}, gbw[4] = {gb.x, gb.y, gb.z, gb.w};
#pragma unroll
                    for (int q = 0; q < 4; ++q) { const float a0 = __uint_as_float(gaw[q] << 16), a1 = __uint_as_float(gaw[q] & 0xffff0000u), b0 = __uint_as_float(gbw[q] << 16), b1 = __uint_as_float(gbw[q] & 0xffff0000u);
                        acc[ai][bj][m][q >> 1][(q & 1) * 2] *= b0 * __builtin_amdgcn_rcpf(a0); acc[ai][bj][m][q >> 1][(q & 1) * 2 + 1] *= b1 * __builtin_amdgcn_rcpf(a1); } } }
    }
    __device__ __forceinline__ void operator()(const f32x4 (&acc)[2][2][4][2], const Unit& u, int wr, int wc, int fr, int fq) const {
        const int row0 = u.pm * BM + wr * 64 + fr, col0 = u.pn * BM + wc * 32 + 8 * fq;
        const GAS char* gm = (const GAS char*)GM + ((size_t)row0 * 2048 + col0) * 2;
        GAS char* mg = (GAS char*)MG + ((size_t)row0 * 1024 + col0) * 2;
#pragma unroll
        for (int ai = 0; ai < 2; ++ai)
#pragma unroll
            for (int m = 0; m < 4; ++m) { unsigned ro = (unsigned)(ai * HALF + m * 16) * 2048u; asm volatile("" : "+v"(ro));
#pragma unroll
                for (int bj = 0; bj < 2; ++bj) { const u32x4 ga = *(const GAS u32x4*)(gm + 2 * ro + bj * 256); const unsigned gaw[4] = {ga.x, ga.y, ga.z, ga.w}; float o[8];
#pragma unroll
                    for (int q = 0; q < 4; ++q) { o[2 * q] = acc[ai][bj][m][q >> 1][(q & 1) * 2] * __uint_as_float(gaw[q] << 16); o[2 * q + 1] = acc[ai][bj][m][q >> 1][(q & 1) * 2 + 1] * __uint_as_float(gaw[q] & 0xffff0000u); }
                    u32x4 w; w.x = cvt_pk_bf16(o[0], o[1]); w.y = cvt_pk_bf16(o[2], o[3]); w.z = cvt_pk_bf16(o[4], o[5]); w.w = cvt_pk_bf16(o[6], o[7]);
                    *(GAS u32x4*)(mg + ro + bj * 256) = w; } }
    }
};
struct EpiX1 {
    static constexpr bool PERM = false, HOOK = false;
    const float* x; float* out;
    __device__ __forceinline__ void mid(f32x4 (&)[2][2][4][2], const Unit&, int, int, int, int) const {}
    __device__ __forceinline__ void operator()(const f32x4 (&acc)[2][2][4][2], const Unit& u, int wr, int wc, int fr, int fq) const {
        const int row0 = u.pm * BM + wr * 64 + fr, col0 = u.pn * BM + wc * 32 + 4 * fq;
#pragma unroll
        for (int ai = 0; ai < 2; ++ai)
#pragma unroll
            for (int m = 0; m < 4; ++m) { const size_t off = (size_t)(row0 + ai * HALF + m * 16) * 1024 + col0;
#pragma unroll
                for (int bj = 0; bj < 2; ++bj)
#pragma unroll
                    for (int n = 0; n < 2; ++n) { const f32x4 bs = *(const f32x4*)(x + off + bj * HALF + n * 16); *(f32x4*)(out + off + bj * HALF + n * 16) = bs + acc[ai][bj][m][n]; } }
    }
};
struct EpiHB {
    static constexpr bool PERM = true, HOOK = false;
    bf16_t* HB;
    __device__ __forceinline__ void mid(f32x4 (&)[2][2][4][2], const Unit&, int, int, int, int) const {}
    __device__ __forceinline__ void operator()(const f32x4 (&acc)[2][2][4][2], const Unit& u, int wr, int wc, int fr, int fq) const {
        const int row0 = u.pm * BM + wr * 64 + fr, col0 = u.pn * HALF + wc * 32 + 8 * fq;
#pragma unroll
        for (int ai = 0; ai < 2; ++ai)
#pragma unroll
            for (int m = 0; m < 4; ++m) { float o[8];
#pragma unroll
                for (int n = 0; n < 2; ++n)
#pragma unroll
                    for (int j = 0; j < 4; ++j) { const float g = acc[ai][0][m][n][j]; o[n * 4 + j] = g * sigm(g) * acc[ai][1][m][n][j]; }
                u32x4 w; w.x = cvt_pk_bf16(o[0], o[1]); w.y = cvt_pk_bf16(o[2], o[3]); w.z = cvt_pk_bf16(o[4], o[5]); w.w = cvt_pk_bf16(o[6], o[7]);
                *(u32x4*)(HB + (size_t)(row0 + ai * HALF + m * 16) * 256 + col0) = w; }
    }
};
struct EpiYS {
    static constexpr bool PERM = true, HOOK = false;
    bf16_t* YS;
    __device__ __forceinline__ void mid(f32x4 (&)[2][2][4][2], const Unit&, int, int, int, int) const {}
    __device__ __forceinline__ void operator()(const f32x4 (&acc)[2][2][4][2], const Unit& u, int wr, int wc, int fr, int fq) const {
        const int row0 = u.pm * BM + wr * 64 + fr, col0 = u.pn * BM + wc * 32 + 8 * fq;
#pragma unroll
        for (int ai = 0; ai < 2; ++ai)
#pragma unroll
            for (int m = 0; m < 4; ++m) { bf16_t* rowp = YS + (size_t)(row0 + ai * HALF + m * 16) * 1024 + col0;
#pragma unroll
                for (int bj = 0; bj < 2; ++bj) { const f32x4 v0 = acc[ai][bj][m][0], v1 = acc[ai][bj][m][1];
                    u32x4 w; w.x = cvt_pk_bf16(v0[0], v0[1]); w.y = cvt_pk_bf16(v0[2], v0[3]); w.z = cvt_pk_bf16(v1[0], v1[1]); w.w = cvt_pk_bf16(v1[2], v1[3]);
                    *(u32x4*)(rowp + bj * HALF) = w; } }
    }
};
}

__device__ __forceinline__ unsigned pk2(float lo, float hi) { return (unsigned)f2bf(lo) | ((unsigned)f2bf(hi) << 16); }
__device__ __forceinline__ void tr_item(const float* __restrict__ W, int ldw, int c0, int nvalid, int k0, bf16_t* __restrict__ WT, int ldt, int r0, int kd0, LAS float* scr, int lane) {
#pragma unroll 8
  for (int i = 0; i < 32; ++i) { const int kk = 2 * i + (lane >> 5), n = lane & 31; scr[kk * 33 + n] = n < nvalid ? W[(size_t)(k0 + kk) * ldw + c0 + n] : 0.f; }
  asm volatile("s_waitcnt lgkmcnt(0)" ::: "memory");
  const int c = lane & 7;
#pragma unroll
  for (int j = 0; j < 4; ++j) { const int n = (lane >> 3) + 8 * j; const LAS float* s = scr + (8 * c) * 33 + n;
    pg8::u32x4 o; o.x = pk2(s[0 * 33], s[1 * 33]); o.y = pk2(s[2 * 33], s[3 * 33]); o.z = pk2(s[4 * 33], s[5 * 33]); o.w = pk2(s[6 * 33], s[7 * 33]);
    *(pg8::u32x4*)(WT + (size_t)(r0 + n) * ldt + kd0 + k0 + 8 * c) = o; }
  asm volatile("s_waitcnt lgkmcnt(0)" ::: "memory");
}


namespace att {
typedef float f32x16 __attribute__((ext_vector_type(16)));
typedef short bf16x8 __attribute__((ext_vector_type(8)));
typedef short s16x4 __attribute__((ext_vector_type(4)));
typedef unsigned u32x4 __attribute__((ext_vector_type(4)));
constexpr float LOG2E = 1.4426950408889634f, C2 = 0.125f * LOG2E, NEG = -1e30f;
constexpr int L_KS = 0, L_VS = 16384, L_WSC = 32768, L_PS = 36864, L_SCR = 69632, L_MSK = 77824;
__device__ __forceinline__ int crow(int r, int hi) { return (r & 3) + 8 * (r >> 2) + 4 * hi; }
__device__ __forceinline__ unsigned cvtpk(float lo, float hi) { unsigned r; asm volatile("v_cvt_pk_bf16_f32 %0, %1, %2" : "=v"(r) : "v"(lo), "v"(hi)); return r; }
struct KVRegs { u32x4 k, v; };
__device__ __forceinline__ KVRegs kv_load(const bf16_t* kptr, const bf16_t* vptr, int pitch, int wid, int lane) {
  KVRegs r;
  r.k = *(const GAS u32x4*)(kptr + (size_t)lane * pitch + wid * 8);
  r.v = *(const GAS u32x4*)(vptr + (size_t)(16 * (wid & 3) + (lane >> 2)) * pitch + (wid >> 2) * 32 + (lane & 3) * 8);
  return r;
}
__device__ __forceinline__ void kv_store(LAS unsigned char* Ks, LAS unsigned char* Vs, const KVRegs& r, int wid, int lane) {
  *(LAS u32x4*)(Ks + wid * 1024 + lane * 16) = r.k;
  *(LAS u32x4*)(Vs + wid * 1024 + lane * 16) = r.v;
}
__device__ __forceinline__ void qkt(f32x16& p0, f32x16& p1, const LAS unsigned char* Ks, const bf16x8 (&qr)[4], int r32, int hi) {
  const LAS unsigned char* kb = Ks + hi * 1024 + r32 * 16;
  const f32x16 z = {0.f, 0.f, 0.f, 0.f, 0.f, 0.f, 0.f, 0.f, 0.f, 0.f, 0.f, 0.f, 0.f, 0.f, 0.f, 0.f};
  p0 = z; p1 = z;
#pragma unroll
  for (int d0 = 0; d0 < 4; ++d0) {
    const bf16x8 b0 = *(const LAS bf16x8*)(kb + d0 * 2048), b1 = *(const LAS bf16x8*)(kb + d0 * 2048 + 512);
    p0 = __builtin_amdgcn_mfma_f32_32x32x16_bf16(b0, qr[d0], p0, 0, 0, 0);
    p1 = __builtin_amdgcn_mfma_f32_32x32x16_bf16(b1, qr[d0], p1, 0, 0, 0);
  }
}
typedef short v4i16_t __attribute__((ext_vector_type(4)));
__device__ __forceinline__ s16x4 vtr(const LAS unsigned char* p) { return __builtin_bit_cast(s16x4, __builtin_amdgcn_ds_read_tr16_b64_v4i16((LAS v4i16_t*)p)); }
__device__ __forceinline__ void pv(f32x16 (&o)[2], const LAS unsigned char* Vs, const bf16x8 (&pa)[4], int lane) {
  const int hi = lane >> 5;
  const LAS unsigned char* vb = Vs + ((lane >> 4) & 1) * 32 + (lane & 3) * 8 + (4 * hi + ((lane & 15) >> 2)) * 64;
#pragma unroll
  for (int d0 = 0; d0 < 2; ++d0)
#pragma unroll
    for (int ks = 0; ks < 4; ++ks) {
      const s16x4 lo = vtr(vb + d0 * 4096 + ks * 1024), hh = vtr(vb + d0 * 4096 + ks * 1024 + 512);
      const bf16x8 vf = {lo[0], lo[1], lo[2], lo[3], hh[0], hh[1], hh[2], hh[3]};
      o[d0] = __builtin_amdgcn_mfma_f32_32x32x16_bf16(pa[ks], vf, o[d0], 0, 0, 0);
    }
}
__device__ __forceinline__ void pack_p(bf16x8 (&pa)[4], const f32x16& p0, const f32x16& p1) {
  u32x4 w0 = {cvtpk(p0[0], p0[1]), cvtpk(p0[2], p0[3]), cvtpk(p0[4], p0[5]), cvtpk(p0[6], p0[7])};
  u32x4 w1 = {cvtpk(p0[8], p0[9]), cvtpk(p0[10], p0[11]), cvtpk(p0[12], p0[13]), cvtpk(p0[14], p0[15])};
  u32x4 w2 = {cvtpk(p1[0], p1[1]), cvtpk(p1[2], p1[3]), cvtpk(p1[4], p1[5]), cvtpk(p1[6], p1[7])};
  u32x4 w3 = {cvtpk(p1[8], p1[9]), cvtpk(p1[10], p1[11]), cvtpk(p1[12], p1[13]), cvtpk(p1[14], p1[15])};
  pa[0] = __builtin_bit_cast(bf16x8, w0); pa[1] = __builtin_bit_cast(bf16x8, w1); pa[2] = __builtin_bit_cast(bf16x8, w2); pa[3] = __builtin_bit_cast(bf16x8, w3);
}
template <int MODE>
__device__ __forceinline__ float logits(f32x16& p0, f32x16& p1, float slope2, int t, int kbase, int W, bool rowsel, int hi) {
  float mt = NEG;
#pragma unroll
  for (int r = 0; r < 16; ++r) {
    const int key0 = (r & 3) + 8 * (r >> 2) + 4 * hi, key1 = key0 + 32;
    int d0, d1;
    if (MODE == 3) { d0 = t - (16 * (kbase + key0) + 31); d1 = t - (16 * (kbase + key1) + 31); } else { d0 = t - (kbase + key0); d1 = d0 - 32; }
    float s0 = fmaf(p0[r], C2, -slope2 * (float)d0), s1 = fmaf(p1[r], C2, -slope2 * (float)d1);
    if (MODE == 1) { s0 = (d0 >= 0 && d0 < W) ? s0 : NEG; s1 = (d1 >= 0 && d1 < W) ? s1 : NEG; }
    if (MODE == 2) { s0 = (rowsel && d0 >= 0) ? s0 : NEG; s1 = (rowsel && d1 >= 0) ? s1 : NEG; }
    if (MODE == 3) { s0 = (d0 >= 0 && kbase + key0 < 127) ? s0 : NEG; s1 = (d1 >= 0 && kbase + key1 < 127) ? s1 : NEG; }
    p0[r] = s0; p1[r] = s1; mt = fmaxf(mt, fmaxf(s0, s1));
  }
  return fmaxf(mt, __shfl_xor(mt, 32));
}
__device__ __forceinline__ float expo(f32x16& p0, f32x16& p1, float mref) {
  float rs = 0.f;
#pragma unroll
  for (int r = 0; r < 16; ++r) { p0[r] = __builtin_amdgcn_exp2f(p0[r] - mref); p1[r] = __builtin_amdgcn_exp2f(p1[r] - mref); rs += p0[r] + p1[r]; }
  return rs;
}
__device__ __forceinline__ void scale_rows(f32x16 (&o)[2], float f, LAS float* wsc, int r32, int hi) {
  if (hi == 0) wsc[r32] = f;
#pragma unroll
  for (int r = 0; r < 16; ++r) { const float a = wsc[crow(r, hi)]; o[0][r] *= a; o[1][r] *= a; }
}
template <int MODE>
__device__ __forceinline__ void tile_step(f32x16 (&o)[2], float& m, float& l, const bf16x8 (&qr)[4], const LAS unsigned char* Ks, const LAS unsigned char* Vs, LAS float* wsc,
                                          float slope2, int t, int kbase, int W, bool rowsel, int lane) {
  const int r32 = lane & 31, hi = lane >> 5;
  f32x16 p0, p1;
  qkt(p0, p1, Ks, qr, r32, hi);
  const float mt = logits<MODE>(p0, p1, slope2, t, kbase, W, rowsel, hi);
  const float mn = fmaxf(m, mt), alpha = __builtin_amdgcn_exp2f(m - mn), mref = mn < -1e29f ? 0.f : mn;
  m = mn;
  const float rs = expo(p0, p1, mref);
  l = l * alpha + rs;
  scale_rows(o, alpha, wsc, r32, hi);
  bf16x8 pa[4]; pack_p(pa, p0, p1);
  pv(o, Vs, pa, lane);
}
__device__ __forceinline__ void load_q(bf16x8 (&qr)[4], const bf16_t* qrow  , int hi) {
#pragma unroll
  for (int d0 = 0; d0 < 4; ++d0) qr[d0] = *(const GAS bf16x8*)(qrow + d0 * 16 + hi * 8);
}
__device__ __forceinline__ void zero_o(f32x16 (&o)[2]) {
  const f32x16 z = {0.f, 0.f, 0.f, 0.f, 0.f, 0.f, 0.f, 0.f, 0.f, 0.f, 0.f, 0.f, 0.f, 0.f, 0.f, 0.f}; o[0] = z; o[1] = z;
}

__device__ __forceinline__ void swa_unit(LAS unsigned char* lds, int b, int hkv, int qt, const bf16_t* __restrict__ QB, const bf16_t* __restrict__ KVB, const float* __restrict__ sinks, bf16_t* __restrict__ OAB) {
  const int tid = tid_fresh(), lane = tid & 63, wid = __builtin_amdgcn_readfirstlane(tid >> 6), r32 = lane & 31, hi = lane >> 5;
  const int g = wid >> 1, head = hkv * 4 + g, t0 = qt * 64, t = t0 + 32 * (wid & 1) + r32;
  const size_t tokb = (size_t)b * S;
  LAS float* wsc = (LAS float*)(lds + L_WSC) + wid * 64;
  const float slope2 = exp2f(-0.5f * (float)(1 + head)) * LOG2E, sink2 = sinks[head] * LOG2E;
  bf16x8 qr[4]; load_q(qr, QB + (tokb + t) * 512 + head * 64, hi);
  f32x16 o[2]; zero_o(o);
  float m = NEG, l = 0.f;
  const int j0 = qt >= 2 ? qt - 2 : 0, nj = qt - j0 + 1;
  const bf16_t* kp = KVB + tokb * 256 + hkv * 64; const bf16_t* vp = kp + 128;
  KVRegs kr = kv_load(kp + (size_t)j0 * 64 * 256, vp + (size_t)j0 * 64 * 256, 256, wid, lane);
  kv_store(lds + L_KS, lds + L_VS, kr, wid, lane);
  __syncthreads();
  for (int i = 0; i < nj; ++i) {
    const int j = j0 + i, sl = (i & 1) * 8192;
    if (i + 1 < nj) kr = kv_load(kp + (size_t)(j + 1) * 64 * 256, vp + (size_t)(j + 1) * 64 * 256, 256, wid, lane);
    if (j == qt - 1) tile_step<0>(o, m, l, qr, lds + L_KS + sl, lds + L_VS + sl, wsc, slope2, t, j * 64, 128, true, lane);
    else tile_step<1>(o, m, l, qr, lds + L_KS + sl, lds + L_VS + sl, wsc, slope2, t, j * 64, 128, true, lane);
    if (i + 1 < nj) kv_store(lds + L_KS + (sl ^ 8192), lds + L_VS + (sl ^ 8192), kr, wid, lane);
    __syncthreads();
  }
  float lt = l + __shfl_xor(l, 32);
  const float mf = fmaxf(m, sink2), z = lt * __builtin_amdgcn_exp2f(m - mf) + __builtin_amdgcn_exp2f(sink2 - mf);
  scale_rows(o, __builtin_amdgcn_exp2f(m - mf) / z, wsc, r32, hi);
  bf16_t* op = OAB + (tokb + t0 + 32 * (wid & 1)) * 1024 + head * 64 + r32;
#pragma unroll
  for (int r = 0; r < 16; ++r) { const int q = crow(r, hi); op[(size_t)q * 1024] = f2bf(o[0][r]); op[(size_t)q * 1024 + 32] = f2bf(o[1][r]); }
}
__device__ __forceinline__ void swa_phase(LAS unsigned char* lds, const bf16_t* QB, const bf16_t* KVB, const float* sinks, bf16_t* OAB) {
#pragma unroll 1
  for (int u = blockIdx.x; u < NB * 2 * 32; u += gridDim.x) { swa_unit(lds, u >> 6, (u >> 5) & 1, u & 31, QB, KVB, sinks, OAB); }
}

constexpr int L_OACC = 36864;
__device__ __forceinline__ void oacc_store(LAS unsigned char* lds, const f32x16 (&o)[2], int wid, int lane) {
  LAS float* p = (LAS float*)(lds + L_OACC) + wid * 2048 + lane;
#pragma unroll
  for (int r = 0; r < 16; ++r) { p[r * 64] = o[0][r]; p[1024 + r * 64] = o[1][r]; }
}
__device__ __forceinline__ void oacc_add(LAS unsigned char* lds, const f32x16 (&o)[2], int wid, int lane) {
  LAS float* p = (LAS float*)(lds + L_OACC) + wid * 2048 + lane;
#pragma unroll
  for (int r = 0; r < 16; ++r) { p[r * 64] += o[0][r]; p[1024 + r * 64] += o[1][r]; }
}
__device__ __forceinline__ void nsa_unit(LAS unsigned char* lds, int b, int hkv, int qt, const bf16_t* __restrict__ QA, const bf16_t* __restrict__ KC, const bf16_t* __restrict__ VC,
                                         const bf16_t* __restrict__ KVS, const bf16_t* __restrict__ KVW, const float* __restrict__ GN, bf16_t* __restrict__ OAB) {
  const int tid = tid_fresh(), lane = tid & 63, wid = __builtin_amdgcn_readfirstlane(tid >> 6), r32 = lane & 31, hi = lane >> 5;
  const int g = wid >> 1, qh = wid & 1, head = hkv * 4 + g, t0 = qt * 64, ql = 32 * qh + r32, t = t0 + ql;
  const size_t tokb = (size_t)b * S;
  LAS float* wsc = (LAS float*)(lds + L_WSC) + wid * 64;
  LAS float* PS = (LAS float*)(lds + L_PS);
  LAS float* SCR = (LAS float*)(lds + L_SCR);
  LAS unsigned* MSK = (LAS unsigned*)(lds + L_MSK);
  const float slope2 = exp2f(-0.5f * (float)(9 + head)) * LOG2E;
  const float* gnp = GN + (tokb + t) * 32 + hkv * 12 + g * 3;
  bf16x8 qr[4]; load_q(qr, QA + (tokb + t) * 512 + head * 64, hi);
  const int nct = (t0 + 63 >= 31 + 16 * 64) ? 2 : 1;
  f32x16 ocmp[2]; zero_o(ocmp);
  {
    const bf16_t* kp = KC + ((size_t)b * 128 * 2 + hkv) * 64; const bf16_t* vp = VC + ((size_t)b * 128 * 2 + hkv) * 64;
    { KVRegs k0 = kv_load(kp, vp, 128, wid, lane); kv_store(lds + L_KS, lds + L_VS, k0, wid, lane); }
    if (nct == 2) { KVRegs k1 = kv_load(kp + (size_t)64 * 128, vp + (size_t)64 * 128, 128, wid, lane); kv_store(lds + L_KS + 8192, lds + L_VS + 8192, k1, wid, lane); }
    if (tid < 65) MSK[tid] = 0u;
    __syncthreads();
    float m = NEG, l = 0.f;
    for (int ct = 0; ct < nct; ++ct) {
      f32x16 p0, p1;
      qkt(p0, p1, lds + L_KS + ct * 8192, qr, r32, hi);
      const float mt = logits<3>(p0, p1, slope2, t, ct * 64, 0, true, hi);
      const float mn = fmaxf(m, mt), alpha = __builtin_amdgcn_exp2f(m - mn), mref = mn < -1e29f ? 0.f : mn;
      m = mn; l = l * alpha + expo(p0, p1, mref);
    }
    l += __shfl_xor(l, 32);
    const float inv = l > 0.f ? 1.f / l : 1.f, mref = m < -1e29f ? 0.f : m;
    for (int ct = 0; ct < nct; ++ct) {
      f32x16 p0, p1;
      qkt(p0, p1, lds + L_KS + ct * 8192, qr, r32, hi);
      (void)logits<3>(p0, p1, slope2, t, ct * 64, 0, true, hi);
      (void)expo(p0, p1, mref);
#pragma unroll
      for (int r = 0; r < 16; ++r) { p0[r] *= inv; p1[r] *= inv; }
      { bf16x8 pa[4]; pack_p(pa, p0, p1); pv(ocmp, lds + L_VS + ct * 8192, pa, lane); }
      for (int gg = 0; gg < 4; ++gg) {
        if (g == gg) {
#pragma unroll
          for (int r = 0; r < 16; ++r) {
            LAS float* pr = PS + ql * 128 + ct * 64 + crow(r, hi);
            if (gg == 0) { pr[0] = p0[r]; pr[32] = p1[r]; } else { pr[0] += p0[r]; pr[32] += p1[r]; }
          }
        }
        __syncthreads();
      }
    }
    if (nct == 1) {
      if (tid < 64) { LAS float* pr = PS + tid * 128 + 64; pr[0] = 0.f; pr[1] = 0.f; pr[2] = 0.f; pr[3] = 0.f; }
    }
    scale_rows(ocmp, gnp[0], wsc, r32, hi);
    __syncthreads();
  }
  {
    const int cur = qt;
#pragma unroll
    for (int i = 0; i < 4; ++i) {
      const int pi = tid + i * 512, q = pi >> 5, j = pi & 31;
      const LAS float* pr = PS + q * 128;
      float imp = 0.f;
      if (j <= cur) {
        const int c = 4 * j;
        imp = pr[c] + pr[c + 1] + pr[c + 2] + 0.5f * (c + 3 < 127 ? pr[c + 3] : 0.f) + 0.5f * (c > 0 ? pr[c - 1] : 0.f);
      }
      const bool forced = (j == 0) || (j == cur) || (j == cur - 1);
      SCR[pi] = forced ? 1e9f : (j <= cur ? imp : NEG);
    }
    __syncthreads();
#pragma unroll
    for (int i = 0; i < 4; ++i) {
      const int pi = tid + i * 512, q = pi >> 5, j = pi & 31;
      const float sj = SCR[pi]; int rank = 0;
      for (int k = 0; k < 32; ++k) { const float sk = SCR[q * 32 + k]; rank += ((sk > sj) || (sk == sj && k < j)) ? 1 : 0; }
      if (rank < 8 && sj > -5e29f) { __hip_atomic_fetch_or(&MSK[q], 1u << j, __ATOMIC_RELAXED, __HIP_MEMORY_SCOPE_WORKGROUP); __hip_atomic_fetch_or(&MSK[64], 1u << j, __ATOMIC_RELAXED, __HIP_MEMORY_SCOPE_WORKGROUP); }
    }
    __syncthreads();
  }
  const unsigned um = MSK[64], mymask = MSK[ql];
  __syncthreads();
  oacc_store(lds, ocmp, wid, lane);
  {
    f32x16 o[2]; zero_o(o);
    float m = NEG, l = 0.f;
    const bf16_t* kp = KVS + tokb * 256 + hkv * 64; const bf16_t* vp = kp + 128;
    unsigned rem = (unsigned)__builtin_amdgcn_readfirstlane(um);
    int j = __builtin_ctz(rem); rem &= rem - 1;
    KVRegs kr = kv_load(kp + (size_t)j * 64 * 256, vp + (size_t)j * 64 * 256, 256, wid, lane);
    kv_store(lds + L_KS, lds + L_VS, kr, wid, lane);
    __syncthreads();
    int sl = 0;
    for (;;) {
      const int jn = rem ? __builtin_ctz(rem) : -1; if (rem) rem &= rem - 1;
      if (jn >= 0) kr = kv_load(kp + (size_t)jn * 64 * 256, vp + (size_t)jn * 64 * 256, 256, wid, lane);
      tile_step<2>(o, m, l, qr, lds + L_KS + sl, lds + L_VS + sl, wsc, slope2, t, j * 64, 0, ((mymask >> j) & 1u) != 0u, lane);
      if (jn >= 0) kv_store(lds + L_KS + (sl ^ 8192), lds + L_VS + (sl ^ 8192), kr, wid, lane);
      __syncthreads();
      if (jn < 0) break;
      j = jn; sl ^= 8192;
    }
    const float lt = l + __shfl_xor(l, 32), inv = lt > 0.f ? 1.f / lt : 1.f;
    scale_rows(o, inv * gnp[1], wsc, r32, hi);
    oacc_add(lds, o, wid, lane);
  }
  {
    f32x16 o[2]; zero_o(o);
    float m = NEG, l = 0.f;
    const int j0 = qt >= 4 ? qt - 4 : 0, nj = qt - j0 + 1;
    const bf16_t* kp = KVW + tokb * 256 + hkv * 64; const bf16_t* vp = kp + 128;
    KVRegs kr = kv_load(kp + (size_t)j0 * 64 * 256, vp + (size_t)j0 * 64 * 256, 256, wid, lane);
    kv_store(lds + L_KS, lds + L_VS, kr, wid, lane);
    __syncthreads();
    for (int i = 0; i < nj; ++i) {
      const int j = j0 + i, sl = (i & 1) * 8192;
      if (i + 1 < nj) kr = kv_load(kp + (size_t)(j + 1) * 64 * 256, vp + (size_t)(j + 1) * 64 * 256, 256, wid, lane);
      if (j < qt && j > qt - 4) tile_step<0>(o, m, l, qr, lds + L_KS + sl, lds + L_VS + sl, wsc, slope2, t, j * 64, 256, true, lane);
      else tile_step<1>(o, m, l, qr, lds + L_KS + sl, lds + L_VS + sl, wsc, slope2, t, j * 64, 256, true, lane);
      if (i + 1 < nj) kv_store(lds + L_KS + (sl ^ 8192), lds + L_VS + (sl ^ 8192), kr, wid, lane);
      __syncthreads();
    }
    const float lt = l + __shfl_xor(l, 32);
    scale_rows(o, gnp[2] / lt, wsc, r32, hi);
    LAS const float* p = (LAS const float*)(lds + L_OACC) + wid * 2048 + lane;
    bf16_t* op = OAB + (tokb + t0 + 32 * qh) * 1024 + 512 + head * 64 + r32;
#pragma unroll
    for (int r = 0; r < 16; ++r) { const int q = crow(r, hi); op[(size_t)q * 1024] = f2bf(o[0][r] + p[r * 64]); op[(size_t)q * 1024 + 32] = f2bf(o[1][r] + p[1024 + r * 64]); }
  }
  __syncthreads();
}
__device__ __forceinline__ void nsa_phase(LAS unsigned char* lds, const bf16_t* QA, const bf16_t* KC, const bf16_t* VC, const bf16_t* KVS, const bf16_t* KVW, const float* GN, bf16_t* OAB) {
#pragma unroll 1
  for (int pr = blockIdx.x; pr < 256; pr += gridDim.x) {
    const int bh = pr >> 4, s = pr & 15;
#pragma unroll 1
    for (int i = 0; i < 2; ++i) nsa_unit(lds, bh >> 1, bh & 1, i == 0 ? 31 - s : s, QA, KC, VC, KVS, KVW, GN, OAB);
  }
}
}

__device__ __forceinline__ void ph_prep_xn(const float* __restrict__ x, const float* __restrict__ g, bf16_t* __restrict__ xn) {
  const int tid_ = tid_fresh(), lane = tid_ & 63, wave = (blockIdx.x * 512 + tid_) >> 6, nw = (gridDim.x * 512) >> 6;
  for (int r = wave; r < NTOK; r += nw) {
    const float4* xr = (const float4*)(x + (size_t)r * D);
    float4 v[4]; float s = 0.f;
#pragma unroll
    for (int j = 0; j < 4; ++j) { v[j] = xr[lane + 64 * j]; s += v[j].x * v[j].x + v[j].y * v[j].y + v[j].z * v[j].z + v[j].w * v[j].w; }
    s = wave_sum(s);
    const float rstd = rsqrtf(s * (1.f / D) + 1e-6f);
#pragma unroll
    for (int j = 0; j < 4; ++j) {
      const float4 gg = ((const float4*)g)[lane + 64 * j];
      ushort4 o; o.x = f2bf(v[j].x * rstd * gg.x); o.y = f2bf(v[j].y * rstd * gg.y); o.z = f2bf(v[j].z * rstd * gg.z); o.w = f2bf(v[j].w * rstd * gg.w);
      ((ushort4*)(xn + (size_t)r * D))[lane + 64 * j] = o;
    }
  }
}

template <class AL, class BL, class EP>
__device__ __forceinline__ void naive_gemm_phase(unsigned char* lds, const AL al, const BL bl, const EP ep, int K, int ntm, int ntn) {
  const int tid_ = tid_fresh(), half = tid_ >> 8, tid = tid_ & 255, tx = tid & 15, ty = tid >> 4;
  float (*As)[68] = (float (*)[68])(lds + half * 8704);
  float (*Bs)[68] = As + 16;
  const int ntiles = ntm * ntn;
  for (int it0 = blockIdx.x * 2; it0 < ntiles; it0 += 2 * gridDim.x) {
    const int it = it0 + half, tm = it / ntn, tn = it - tm * ntn, m0 = tm * 64, n0 = tn * 64;
    const bool act = it < ntiles && al.active(m0);
    float acc[4][4];
#pragma unroll
    for (int i = 0; i < 4; ++i)
#pragma unroll
      for (int j = 0; j < 4; ++j) acc[i][j] = 0.f;
    for (int k0 = 0; k0 < K; k0 += 16) {
#pragma unroll
      for (int i = 0; i < 4; ++i) { const int e = tid + i * 256, r = e >> 4, kk = e & 15; As[kk][r] = act ? al(m0 + r, k0 + kk) : 0.f; }
#pragma unroll
      for (int i = 0; i < 4; ++i) { const int e = tid + i * 256, kk = e >> 6, c = e & 63; Bs[kk][c] = act ? bl(m0, k0 + kk, n0 + c) : 0.f; }
      __syncthreads();
#pragma unroll
      for (int kk = 0; kk < 16; ++kk) {
        const float4 a = *(const float4*)&As[kk][ty * 4];
        const float4 b = *(const float4*)&Bs[kk][tx * 4];
        const float av[4] = {a.x, a.y, a.z, a.w}, bv[4] = {b.x, b.y, b.z, b.w};
#pragma unroll
        for (int i = 0; i < 4; ++i)
#pragma unroll
          for (int j = 0; j < 4; ++j) acc[i][j] += av[i] * bv[j];
      }
      __syncthreads();
    }
    if (act) {
#pragma unroll
      for (int i = 0; i < 4; ++i)
#pragma unroll
        for (int j = 0; j < 4; ++j) ep(m0 + ty * 4 + i, n0 + tx * 4 + j, acc[i][j]);
    }
  }
}

struct AL_bf16 { const bf16_t* A; int lda, M; __device__ bool active(int) const { return true; } __device__ float operator()(int m, int k) const { return m < M ? bf2f(A[(size_t)m * lda + k]) : 0.f; } };
struct AL_f32 { const float* A; int lda, M; __device__ bool active(int) const { return true; } __device__ float operator()(int m, int k) const { return m < M ? A[(size_t)m * lda + k] : 0.f; } };
struct BL_f32 { const float* B; int ldb, N; __device__ float operator()(int, int k, int n) const { return n < N ? B[(size_t)k * ldb + n] : 0.f; } };
struct EP_proj {
  bf16_t *QA, *QB, *KVC, *KVS, *KVW, *KVB, *GM; float* GN;
  __device__ void operator()(int m, int c, float v) const {
    if (c >= INW) return;
    if (c < 512) QA[(size_t)m * 512 + c] = f2bf(v);
    else if (c < 768) KVC[(size_t)m * 256 + (c - 512)] = f2bf(v);
    else if (c < 1024) KVS[(size_t)m * 256 + (c - 768)] = f2bf(v);
    else if (c < 1280) KVW[(size_t)m * 256 + (c - 1024)] = f2bf(v);
    else if (c < 1304) GN[(size_t)m * 32 + (c - 1280)] = sigmoidf_(v);
    else if (c < 1816) QB[(size_t)m * 512 + (c - 1304)] = f2bf(v);
    else if (c < 2072) KVB[(size_t)m * 256 + (c - 1816)] = f2bf(v);
    else GM[(size_t)m * 2048 + (c - 2072)] = f2bf(sigmoidf_(v));
  }
};
struct AL_cmp { const bf16_t* KVC; const float* pos; int sel; __device__ bool active(int) const { return true; }
  __device__ float operator()(int m, int k) const { if (m >= 2032) return 0.f; const int h = m & 1, bc = m >> 1, b = bc / 127, c = bc % 127, i = k >> 6, d = k & 63;
    return bf2f(KVC[((size_t)b * S + 16 * c + i) * 256 + sel * 128 + h * 64 + d]) + pos[k]; } };
struct EP_silu { float* T; int M, N; __device__ void operator()(int m, int n, float v) const { if (m < M && n < N) T[(size_t)m * N + n] = v / (1.f + __expf(-v)); } };
struct EP_kc { bf16_t* KC; __device__ void operator()(int m, int n, float v) const { if (m >= 2032 || n >= 64) return; const int h = m & 1, bc = m >> 1, b = bc / 127, c = bc % 127; KC[(((size_t)b * 128 + c) * 2 + h) * 64 + n] = f2bf(v); } };
struct EP_mg1 { float* tmp; const bf16_t* GM; __device__ void operator()(int m, int n, float v) const { tmp[(size_t)m * 1024 + n] = bf2f(GM[(size_t)m * 2048 + n]) * v; } };
struct EP_mg2 { const float* tmp; const bf16_t* GM; bf16_t* MG; __device__ void operator()(int m, int n, float v) const { MG[(size_t)m * 1024 + n] = f2bf(tmp[(size_t)m * 1024 + n] + bf2f(GM[(size_t)m * 2048 + 1024 + n]) * v); } };
struct EP_x1 { const float* x; float* out; __device__ void operator()(int m, int n, float v) const { out[(size_t)m * 1024 + n] = x[(size_t)m * 1024 + n] + v; } };
struct AL_moe { const bf16_t* H2; const int* list; const int* cnt; const int* l_off; const int* l_te; __device__ bool active(int m0) const { return l_te[m0 >> 8] >= 0; }
  __device__ float operator()(int m, int k) const { const int e = l_te[m >> 8], r = m - l_off[e]; if (r >= cnt[e]) return 0.f; const int t = list[(size_t)e * NTOK + r]; return bf2f(H2[(size_t)t * 1024 + k]); } };
struct BL_moe { const float* W; const int* l_te; int K, N; __device__ float operator()(int m0, int k, int n) const { const int e = l_te[m0 >> 8]; return W[((size_t)e * K + k) * N + n]; } };
struct EP_g { float* G; __device__ void operator()(int m, int n, float v) const { G[(size_t)m * 256 + n] = v; } };
struct EP_hb { const float* G; bf16_t* HB; __device__ void operator()(int m, int n, float v) const { const float g = G[(size_t)m * 256 + n]; HB[(size_t)m * 256 + n] = f2bf(g / (1.f + __expf(-g)) * v); } };
struct AL_hb { const bf16_t* HB; const int* l_te; __device__ bool active(int m0) const { return l_te[m0 >> 8] >= 0; } __device__ float operator()(int m, int k) const { return bf2f(HB[(size_t)m * 256 + k]); } };
struct EP_ys { bf16_t* YS; __device__ void operator()(int m, int n, float v) const { YS[(size_t)m * 1024 + n] = f2bf(v); } };

__device__ __forceinline__ void moe_tables(const int* cnt, int* l_off, int* l_te) {
  __syncthreads();
  if (threadIdx.x == 0) {
    int off = 0;
    for (int e = 0; e < 32; ++e) { l_off[e] = off; const int c = __hip_atomic_load(cnt + e, __ATOMIC_RELAXED, __HIP_MEMORY_SCOPE_AGENT); const int nt = (c + 255) >> 8; for (int i = 0; i < nt; ++i) l_te[(off >> 8) + i] = e; off += nt << 8; }
    l_off[32] = off;
    for (int i = off >> 8; i < NSLOT / 256; ++i) l_te[i] = -1;
  }
  __syncthreads();
}

__device__ __forceinline__ void naive_nsa_phase(unsigned char* lds, const bf16_t* __restrict__ QA, const bf16_t* __restrict__ KC, const bf16_t* __restrict__ VC, const bf16_t* __restrict__ KVS,
                                                const bf16_t* __restrict__ KVW, const float* __restrict__ GN, bf16_t* __restrict__ OA) {
  const int tid_ = tid_fresh(), half = tid_ >> 8, tid = tid_ & 255, g = tid >> 6, lane = tid & 63;
  unsigned char* base = lds + half * 12288;
  float (*q)[64] = (float (*)[64])base;
  float (*pc)[128] = (float (*)[128])(base + 1024);
  float (*sc)[512] = (float (*)[512])(base + 3072);
  float* sscore = (float*)(base + 11264);
  int* sel_idx = (int*)(base + 11264 + 128);
  int* sel_valid = (int*)(base + 11264 + 160);
  for (int item = blockIdx.x * 2 + half; item < NB * 2 * S; item += 2 * gridDim.x) {
    const int t = item & 2047, hkv = (item >> 11) & 1, b = item >> 12, head = hkv * 4 + g;
    const float slope = exp2f(-0.5f * (float)(9 + head));
    const size_t row = (size_t)b * S + t;
    q[g][lane] = bf2f(QA[row * 512 + head * 64 + lane]) * 0.125f;
    __syncthreads();
    {
      float sv[2]; bool vv[2]; float m = -1e30f;
#pragma unroll
      for (int i = 0; i < 2; ++i) {
        const int c = lane + 64 * i, dist = t - (16 * c + 31); vv[i] = (c < 127) && dist >= 0; float s = 0.f;
        if (vv[i]) { const bf16_t* kr = KC + (((size_t)b * 128 + c) * 2 + hkv) * 64; for (int d = 0; d < 64; ++d) s += q[g][d] * bf2f(kr[d]); s -= slope * (float)dist; m = fmaxf(m, s); }
        sv[i] = s;
      }
      m = wave_max(m);
      float z = 0.f;
#pragma unroll
      for (int i = 0; i < 2; ++i) { sv[i] = vv[i] ? __expf(sv[i] - m) : 0.f; z += sv[i]; }
      z = wave_sum(z);
      const float inv = z > 0.f ? 1.f / z : 1.f;
#pragma unroll
      for (int i = 0; i < 2; ++i) pc[g][lane + 64 * i] = sv[i] * inv;
    }
    __syncthreads();
    float ocmp = 0.f;
    {
      int ncv = (t >= 31) ? (t - 31) / 16 + 1 : 0; if (ncv > 127) ncv = 127;
      for (int c = 0; c < ncv; ++c) ocmp += pc[g][c] * bf2f(VC[(((size_t)b * 128 + c) * 2 + hkv) * 64 + lane]);
    }
    if (tid < 32) {
      const int j = tid;
      float ps[5];
#pragma unroll
      for (int u = 0; u < 5; ++u) { const int c = 4 * j - 1 + u; ps[u] = (c >= 0 && c < 127) ? (pc[0][c] + pc[1][c] + pc[2][c] + pc[3][c]) : 0.f; }
      const float imp = 0.5f * ps[0] + ps[1] + ps[2] + ps[3] + 0.5f * ps[4];
      const int cur = t >> 6; const bool forced = (j == 0) || (j == cur) || (j == cur - 1), valid = j <= cur;
      sscore[j] = forced ? 1e9f : (valid ? imp : -1e30f);
    }
    __syncthreads();
    if (tid < 32) {
      const int j = tid; const float sj = sscore[j]; int rank = 0;
      for (int i = 0; i < 32; ++i) { const float si = sscore[i]; rank += ((si > sj) || (si == sj && i < j)) ? 1 : 0; }
      if (rank < 8) { sel_idx[rank] = j; sel_valid[rank] = sj > -5e29f ? 1 : 0; }
    }
    __syncthreads();
    float oslc = 0.f;
    {
      float s8[8]; float m = -1e30f;
#pragma unroll
      for (int i = 0; i < 8; ++i) {
        const int kpos = sel_idx[i] * 64 + lane; const bool ok = sel_valid[i] && kpos <= t; float s = -1e30f;
        if (ok) { const bf16_t* kr = KVS + ((size_t)b * S + kpos) * 256 + hkv * 64; s = 0.f; for (int d = 0; d < 64; ++d) s += q[g][d] * bf2f(kr[d]); s -= slope * (float)(t - kpos); m = fmaxf(m, s); }
        s8[i] = s;
      }
      m = wave_max(m);
      float z = 0.f;
#pragma unroll
      for (int i = 0; i < 8; ++i) { const float p = s8[i] > -5e29f ? __expf(s8[i] - m) : 0.f; sc[g][i * 64 + lane] = p; z += p; }
      z = wave_sum(z);
      __syncthreads();
      for (int i = 0; i < 8; ++i) {
        if (!sel_valid[i]) continue;
        const int k0 = sel_idx[i] * 64;
        for (int l = 0; l < 64; ++l) { const int kpos = k0 + l; if (kpos > t) break; oslc += sc[g][i * 64 + l] * bf2f(KVS[((size_t)b * S + kpos) * 256 + 128 + hkv * 64 + lane]); }
      }
      oslc *= (z > 0.f ? 1.f / z : 1.f);
      __syncthreads();
    }
    float owin = 0.f;
    {
      float s4[4]; float m = -1e30f;
#pragma unroll
      for (int i = 0; i < 4; ++i) {
        const int dist = lane + 64 * i, kpos = t - dist; float s = -1e30f;
        if (kpos >= 0) { const bf16_t* kr = KVW + ((size_t)b * S + kpos) * 256 + hkv * 64; s = 0.f; for (int d = 0; d < 64; ++d) s += q[g][d] * bf2f(kr[d]); s -= slope * (float)dist; m = fmaxf(m, s); }
        s4[i] = s;
      }
      m = wave_max(m);
      float z = 0.f;
#pragma unroll
      for (int i = 0; i < 4; ++i) { const float p = s4[i] > -5e29f ? __expf(s4[i] - m) : 0.f; sc[g][i * 64 + lane] = p; z += p; }
      z = wave_sum(z);
      __syncthreads();
      for (int dist = 0; dist < 256; ++dist) { const int kpos = t - dist; if (kpos < 0) break; owin += sc[g][dist] * bf2f(KVW[((size_t)b * S + kpos) * 256 + 128 + hkv * 64 + lane]); }
      owin /= z;
    }
    const float* gn = GN + row * 32 + hkv * 12 + g * 3;
    OA[row * 1024 + 512 + head * 64 + lane] = f2bf(gn[0] * ocmp + gn[1] * oslc + gn[2] * owin);
    __syncthreads();
  }
}

__device__ __forceinline__ void naive_swa_phase(unsigned char* lds, const bf16_t* __restrict__ QB, const bf16_t* __restrict__ KVB, const float* __restrict__ sinks, bf16_t* __restrict__ OB) {
  const int tid_ = tid_fresh(), half = tid_ >> 8, tid = tid_ & 255, g = tid >> 6, lane = tid & 63;
  unsigned char* base = lds + half * 4096;
  float (*q)[64] = (float (*)[64])base;
  float (*sc)[128] = (float (*)[128])(base + 1024);
  for (int item = blockIdx.x * 2 + half; item < NB * 2 * S; item += 2 * gridDim.x) {
    const int t = item & 2047, hkv = (item >> 11) & 1, b = item >> 12, head = hkv * 4 + g;
    const float slope = exp2f(-0.5f * (float)(1 + head));
    const float sink = sinks[head];
    const size_t row = (size_t)b * S + t;
    q[g][lane] = bf2f(QB[row * 512 + head * 64 + lane]) * 0.125f;
    __syncthreads();
    float s2[2]; float m = sink;
#pragma unroll
    for (int i = 0; i < 2; ++i) {
      const int dist = lane + 64 * i, kpos = t - dist; float s = -1e30f;
      if (kpos >= 0) { const bf16_t* kr = KVB + ((size_t)b * S + kpos) * 256 + hkv * 64; s = 0.f; for (int d = 0; d < 64; ++d) s += q[g][d] * bf2f(kr[d]); s -= slope * (float)dist; m = fmaxf(m, s); }
      s2[i] = s;
    }
    m = wave_max(m);
    float z = 0.f;
#pragma unroll
    for (int i = 0; i < 2; ++i) { const float p = s2[i] > -5e29f ? __expf(s2[i] - m) : 0.f; sc[g][i * 64 + lane] = p; z += p; }
    z = wave_sum(z) + __expf(sink - m);
    __syncthreads();
    float o = 0.f;
    for (int dist = 0; dist < 128; ++dist) { const int kpos = t - dist; if (kpos < 0) break; o += sc[g][dist] * bf2f(KVB[((size_t)b * S + kpos) * 256 + 128 + hkv * 64 + lane]); }
    OB[row * 1024 + head * 64 + lane] = f2bf(o / z);
    __syncthreads();
  }
}

__device__ __forceinline__ void ph_router(unsigned char* lds, const float* __restrict__ x1, const float* __restrict__ gf, const float* __restrict__ wg, const float* __restrict__ bg, const float* __restrict__ we,
                                          const float* __restrict__ be, bf16_t* __restrict__ H2, bf16_t* __restrict__ H2LO, int* __restrict__ cnt, int* __restrict__ sm, int* __restrict__ list) {
  const int tid_ = tid_fresh(), lane = tid_ & 63, wl = tid_ >> 6, wave = (blockIdx.x * 512 + tid_) >> 6, nw = (gridDim.x * 512) >> 6;
  float* hs = (float*)lds + wl * 1024;
  float* lgs = (float*)(lds + 32768) + wl * 64;
  for (int r = wave; r < NTOK; r += nw) {
    const float4* xr = (const float4*)(x1 + (size_t)r * D);
    float4 v[4]; float s = 0.f;
#pragma unroll
    for (int j = 0; j < 4; ++j) { v[j] = xr[lane + 64 * j]; s += v[j].x * v[j].x + v[j].y * v[j].y + v[j].z * v[j].z + v[j].w * v[j].w; }
    s = wave_sum(s);
    const float rstd = rsqrtf(s * (1.f / D) + 1e-6f);
#pragma unroll
    for (int j = 0; j < 4; ++j) {
      const float4 gg = ((const float4*)gf)[lane + 64 * j];
      float4 h; h.x = v[j].x * rstd * gg.x; h.y = v[j].y * rstd * gg.y; h.z = v[j].z * rstd * gg.z; h.w = v[j].w * rstd * gg.w;
      ushort4 hi, lo;
      hi.x = f2bf(h.x); hi.y = f2bf(h.y); hi.z = f2bf(h.z); hi.w = f2bf(h.w);
      lo.x = f2bf(h.x - bf2f(hi.x)); lo.y = f2bf(h.y - bf2f(hi.y)); lo.z = f2bf(h.z - bf2f(hi.z)); lo.w = f2bf(h.w - bf2f(hi.w));
      ((ushort4*)(H2 + (size_t)r * D))[lane + 64 * j] = hi;
      ((ushort4*)(H2LO + (size_t)r * D))[lane + 64 * j] = lo;
      ((float4*)hs)[lane + 64 * j] = h;
    }
    __builtin_amdgcn_wave_barrier();
    asm volatile("s_waitcnt lgkmcnt(0)" ::: "memory");
    float acc = 0.f;
    if (lane < 36) {
      const float* wp = lane < 4 ? (wg + lane) : (we + (lane - 4));
      const int ld = lane < 4 ? 4 : 32;
      for (int k = 0; k < 1024; ++k) acc += hs[k] * wp[(size_t)k * ld];
      acc += lane < 4 ? bg[lane] : be[lane - 4];
    }
    lgs[lane] = acc;
    asm volatile("s_waitcnt lgkmcnt(0)" ::: "memory");
    __builtin_amdgcn_wave_barrier();
    if (lane == 0) {
      int grp = 0; float gmax = -1e30f;
      for (int j = 0; j < 4; ++j) { const float gl = lgs[j]; if (gl > gmax) { gmax = gl; grp = j; } }
      float zs = 0.f;
      for (int j = 0; j < 4; ++j) zs += __expf(lgs[j] - gmax);
      const float pgrp = 1.f / zs;
      int i1 = 0; float v1 = -1e30f;
      for (int i = 0; i < 8; ++i) { const float e = lgs[4 + grp * 8 + i]; if (e > v1) { v1 = e; i1 = i; } }
      int i2 = 0; float v2 = -1e30f;
      for (int i = 0; i < 8; ++i) { const float e = lgs[4 + grp * 8 + i]; if (i != i1 && e > v2) { v2 = e; i2 = i; } }
      const float e2 = __expf(v2 - v1), w1 = 1.f / (1.f + e2), w2 = e2 * w1;
      const int e_a = grp * 8 + i1, e_b = grp * 8 + i2;
      const int ra = atomicAdd(&cnt[e_a], 1), rb = atomicAdd(&cnt[e_b], 1);
      sm[SM_EID + 2 * r] = e_a; sm[SM_EID + 2 * r + 1] = e_b;
      ((float*)sm)[SM_WT + 2 * r] = pgrp * w1; ((float*)sm)[SM_WT + 2 * r + 1] = pgrp * w2;
      sm[SM_RANK + 2 * r] = ra; sm[SM_RANK + 2 * r + 1] = rb;
      list[(size_t)e_a * NTOK + ra] = r; list[(size_t)e_b * NTOK + rb] = r;
    }
    asm volatile("s_waitcnt lgkmcnt(0)" ::: "memory");
    __builtin_amdgcn_wave_barrier();
  }
}
__device__ __forceinline__ void ph_final(float* __restrict__ out, const bf16_t* __restrict__ YS, const int* __restrict__ sm, const int* l_off, const float* __restrict__ gfin) {
  const int tid_ = tid_fresh(), lane = tid_ & 63, wave = (blockIdx.x * 512 + tid_) >> 6, nw = (gridDim.x * 512) >> 6;
  for (int r = wave; r < NTOK; r += nw) {
    const int s0 = l_off[sm[SM_EID + 2 * r]] + sm[SM_RANK + 2 * r], s1 = l_off[sm[SM_EID + 2 * r + 1]] + sm[SM_RANK + 2 * r + 1];
    const float w0 = ((const float*)sm)[SM_WT + 2 * r], w1 = ((const float*)sm)[SM_WT + 2 * r + 1];
    float4* xr = (float4*)(out + (size_t)r * D);
    float4 v[4]; float s = 0.f;
#pragma unroll
    for (int j = 0; j < 4; ++j) {
      v[j] = xr[lane + 64 * j];
      const ushort4 a = ((const ushort4*)(YS + (size_t)s0 * D))[lane + 64 * j], c = ((const ushort4*)(YS + (size_t)s1 * D))[lane + 64 * j];
      v[j].x += w0 * bf2f(a.x) + w1 * bf2f(c.x); v[j].y += w0 * bf2f(a.y) + w1 * bf2f(c.y); v[j].z += w0 * bf2f(a.z) + w1 * bf2f(c.z); v[j].w += w0 * bf2f(a.w) + w1 * bf2f(c.w);
      s += v[j].x * v[j].x + v[j].y * v[j].y + v[j].z * v[j].z + v[j].w * v[j].w;
    }
    s = wave_sum(s);
    const float rstd = rsqrtf(s * (1.f / D) + 1e-6f);
#pragma unroll
    for (int j = 0; j < 4; ++j) { const float4 gg = ((const float4*)gfin)[lane + 64 * j]; float4 o; o.x = v[j].x * rstd * gg.x; o.y = v[j].y * rstd * gg.y; o.z = v[j].z * rstd * gg.z; o.w = v[j].w * rstd * gg.w; xr[lane + 64 * j] = o; }
  }
}


struct WPtrs { const float *w_in, *w1k, *w2k, *w1v, *w2v, *w_a, *w_b, *w_o, *w_group, *w_expert, *w_gate, *w_up, *w_down;
               bf16_t *WinT, *WgnT, *W1kT, *W1vT, *W2kT, *W2vT, *WabT, *WoT, *WguT, *WdT, *WrtHi, *WrtLo; };
__device__ __forceinline__ void ph_weights(LAS unsigned char* lds, const WPtrs& w) {
  const int tid_ = tid_fresh(), lane = tid_ & 63, wl = __builtin_amdgcn_readfirstlane(tid_ >> 6);
  const int gw = blockIdx.x * 8 + wl, NGW = gridDim.x * 8;
  LAS float* scr = (LAS float*)(lds + wl * 16384);
  constexpr int I_IN = 2048, I_GN = 16, I_W1 = 256, I_W2 = 8, I_AB = 256, I_O = 512, I_GU = 4096, I_D = 4096;
  constexpr int NITEMS = I_IN + I_GN + 2 * I_W1 + 2 * I_W2 + 2 * I_AB + I_O + 2 * I_GU + I_D;
  for (int it = gw; it < NITEMS; it += NGW) {
    int r = it;
    if (r < I_IN) { const int rb = r >> 4, kb = r & 15, n0 = rb * 32; tr_item(w.w_in, INW, n0 + (n0 >= 1280 ? 24 : 0), 32, kb * 64, w.WinT, 1024, n0, 0, scr, lane); continue; } r -= I_IN;
    if (r < I_GN) { tr_item(w.w_in, INW, 1280, 24, r * 64, w.WgnT, 1024, 0, 0, scr, lane); continue; } r -= I_GN;
    if (r < I_W1) { const int rb = r >> 5, kb = r & 31; tr_item(w.w1k, 256, rb * 32, 32, kb * 64, w.W1kT, 2048, rb * 32, 0, scr, lane); continue; } r -= I_W1;
    if (r < I_W1) { const int rb = r >> 5, kb = r & 31; tr_item(w.w1v, 256, rb * 32, 32, kb * 64, w.W1vT, 2048, rb * 32, 0, scr, lane); continue; } r -= I_W1;
    if (r < I_W2) { const int rb = r >> 2, kb = r & 3; tr_item(w.w2k, 64, rb * 32, 32, kb * 64, w.W2kT, 256, rb * 32, 0, scr, lane); continue; } r -= I_W2;
    if (r < I_W2) { const int rb = r >> 2, kb = r & 3; tr_item(w.w2v, 64, rb * 32, 32, kb * 64, w.W2vT, 256, rb * 32, 0, scr, lane); continue; } r -= I_W2;
    if (r < I_AB) { const int rb = r >> 3, kb = r & 7; tr_item(w.w_b, 1024, rb * 32, 32, kb * 64, w.WabT, 1024, rb * 32, 0, scr, lane); continue; } r -= I_AB;
    if (r < I_AB) { const int rb = r >> 3, kb = r & 7; tr_item(w.w_a, 1024, rb * 32, 32, kb * 64, w.WabT, 1024, rb * 32, 512, scr, lane); continue; } r -= I_AB;
    if (r < I_O) { const int rb = r >> 4, kb = r & 15; tr_item(w.w_o, 1024, rb * 32, 32, kb * 64, w.WoT, 1024, rb * 32, 0, scr, lane); continue; } r -= I_O;
    if (r < I_GU) { const int e = r >> 7, q = r & 127, cb = q >> 4, kb = q & 15, c0 = cb * 32; tr_item(w.w_gate + (size_t)e * 1024 * 256, 256, c0, 32, kb * 64, w.WguT + (size_t)e * 512 * 1024, 1024, (c0 >> 7) * 256 + (c0 & 127), 0, scr, lane); continue; } r -= I_GU;
    if (r < I_GU) { const int e = r >> 7, q = r & 127, cb = q >> 4, kb = q & 15, c0 = cb * 32; tr_item(w.w_up + (size_t)e * 1024 * 256, 256, c0, 32, kb * 64, w.WguT + (size_t)e * 512 * 1024, 1024, (c0 >> 7) * 256 + 128 + (c0 & 127), 0, scr, lane); continue; } r -= I_GU;
    { const int e = r >> 7, q = r & 127, cb = q >> 2, kb = q & 3; tr_item(w.w_down + (size_t)e * 256 * 1024, 1024, cb * 32, 32, kb * 64, w.WdT + (size_t)e * 1024 * 256, 256, cb * 32, 0, scr, lane); }
  }
  for (int i = blockIdx.x * 512 + tid_; i < 64 * 1024; i += gridDim.x * 512) {
    const int j = i >> 10, k = i & 1023; const float v = j < 4 ? w.w_group[k * 4 + j] : (j < 36 ? w.w_expert[k * 32 + (j - 4)] : 0.f);
    const bf16_t hi = f2bf(v); w.WrtHi[i] = hi; w.WrtLo[i] = f2bf(v - bf2f(hi));
  }
}
struct BL_gn { const float* W; __device__ float operator()(int, int k, int n) const { return n < 24 ? W[(size_t)k * INW + 1280 + n] : 0.f; } };
struct EP_gn { float* GN; __device__ void operator()(int m, int n, float v) const { if (n < 24) GN[(size_t)m * 32 + n] = sigmoidf_(v); } };

struct Args { const float* in[22]; float* out; unsigned char* ws; };
constexpr int PTAB_OFF = 131072 + 4096;
#define PIN(i) ((const float*)ldptr(ptab, (i)))
#define POUT ((float*)ldptr(ptab, 22))
#define PWS ((unsigned char*)ldptr(ptab, 23))
#define WSB(off) ((bf16_t*)(ws + (off)))
__global__ void __launch_bounds__(512, 2) mega_fwd(Args a) {
  extern __shared__ __attribute__((aligned(16))) unsigned char lds[];
  LAS unsigned char* ldsl = (LAS unsigned char*)lds;
  LAS u64_t* ptab = (LAS u64_t*)(ldsl + PTAB_OFF);
  volatile LAS unsigned* MISC = (volatile LAS unsigned*)(ldsl + MISC_OFF);
  if (threadIdx.x == 0) {
#pragma unroll
    for (int i = 0; i < 22; ++i) ptab[i] = (u64_t)a.in[i];
    ptab[22] = (u64_t)a.out; ptab[23] = (u64_t)a.ws;
  }
  if (threadIdx.x < 32) MISC[threadIdx.x] = 0u;
  __syncthreads();
  XcdBarrier bar = xcd_barrier_post((unsigned*)PWS, MISC + 8);
  int* l_off = (int*)(lds + 131072 + 1024);
  int* l_te = (int*)(lds + 131072 + 1024 + 256);
#define GRID_BAR() do { bar.bar = (unsigned*)PWS; xcd_barrier(bar); } while (0)

  {
    unsigned char* ws = PWS;
    WPtrs w{PIN(2), PIN(4), PIN(5), PIN(7), PIN(8), PIN(10), PIN(11), PIN(12), PIN(14), PIN(16), PIN(18), PIN(19), PIN(20),
            WSB(WS_WINT), WSB(WS_WGNT), WSB(WS_W1KT), WSB(WS_W1VT), WSB(WS_W2KT), WSB(WS_W2VT), WSB(WS_WABT), WSB(WS_WOT), WSB(WS_WGUT), WSB(WS_WDT), WSB(WS_WRT_HI), WSB(WS_WRT_LO)};
    ph_weights(ldsl, w);
    ph_prep_xn(PIN(0), PIN(1), WSB(WS_XN));
  }
  GRID_BAR();
  {
    unsigned char* ws = PWS;
    pg8::SchedDense Sd; Sd.init(ws + WS_XN, 2048, ws + WS_WINT, NTOK, 4096, 1024, gridDim.x, blockIdx.x);
    pg8::EpiProj E{WSB(WS_QA), WSB(WS_QB), WSB(WS_KVC), WSB(WS_KVS), WSB(WS_KVW), WSB(WS_KVB), WSB(WS_GM)};
    pg8::gemm_phase<pg8::EpiProj, pg8::SchedDense, true>(ldsl, 1024, 128, Sd, E);
  }
  {
    unsigned char* ws = PWS;
    naive_gemm_phase(lds, AL_bf16{WSB(WS_XN), 1024, NTOK}, BL_gn{PIN(2)}, EP_gn{(float*)(ws + WS_GN)}, 1024, NTOK / 64, 1);
  }
  GRID_BAR();
  {
    unsigned char* ws = PWS;
    naive_gemm_phase(lds, AL_cmp{WSB(WS_KVC), PIN(3), 0}, BL_f32{PIN(4), 256, 256}, EP_silu{(float*)(ws + WS_T1K), 2032, 256}, 2048, 32, 4);
    naive_gemm_phase(lds, AL_cmp{WSB(WS_KVC), PIN(6), 1}, BL_f32{PIN(7), 256, 256}, EP_silu{(float*)(ws + WS_T1V), 2032, 256}, 2048, 32, 4);
    att::swa_phase(ldsl, WSB(WS_QB), WSB(WS_KVB), PIN(9), WSB(WS_OAB));
  }
  GRID_BAR();
  {
    unsigned char* ws = PWS;
    naive_gemm_phase(lds, AL_f32{(const float*)(ws + WS_T1K), 256, 2032}, BL_f32{PIN(5), 64, 64}, EP_kc{WSB(WS_KC)}, 256, 32, 1);
    naive_gemm_phase(lds, AL_f32{(const float*)(ws + WS_T1V), 256, 2032}, BL_f32{PIN(8), 64, 64}, EP_kc{WSB(WS_VC)}, 256, 32, 1);
  }
  GRID_BAR();
  {
    unsigned char* ws = PWS;
    att::nsa_phase(ldsl, WSB(WS_QA), WSB(WS_KC), WSB(WS_VC), WSB(WS_KVS), WSB(WS_KVW), (const float*)(ws + WS_GN), WSB(WS_OAB));
  }
  GRID_BAR();
  {
    unsigned char* ws = PWS;
    pg8::SchedDense Sd; Sd.init(ws + WS_OAB, 2048, ws + WS_WABT, NTOK, 1024, 1024, gridDim.x, blockIdx.x);
    pg8::EpiMerge E{WSB(WS_GM), WSB(WS_MG)};
    pg8::gemm_phase<pg8::EpiMerge, pg8::SchedDense, true>(ldsl, 1024, 128, Sd, E);
  }
  GRID_BAR();
  {
    unsigned char* ws = PWS;
    pg8::SchedDense Sd; Sd.init(ws + WS_MG, 2048, ws + WS_WOT, NTOK, 1024, 1024, gridDim.x, blockIdx.x);
    pg8::EpiX1 E{PIN(0), POUT};
    pg8::gemm_phase<pg8::EpiX1, pg8::SchedDense, true>(ldsl, 1024, 128, Sd, E);
  }
  GRID_BAR();
  {
    unsigned char* ws = PWS;
    ph_router(lds, POUT, PIN(13), PIN(14), PIN(15), PIN(16), PIN(17), WSB(WS_H2), WSB(WS_H2LO), (int*)(ws + WS_CTL) + CW_CNT, (int*)(ws + WS_SMALL), (int*)(ws + WS_LIST));
  }
  GRID_BAR();
  {
    unsigned char* ws = PWS;
    const int* cnt = (const int*)(ws + WS_CTL) + CW_CNT;
    moe_tables(cnt, l_off, l_te);
    pg8::SchedMoeUp Sm{(const char*)(ws + WS_H2), (const char*)(ws + WS_WGUT), (const int*)(ws + WS_LIST), cnt, l_off, l_te, (int)gridDim.x, (int)blockIdx.x};
    pg8::EpiHB E{WSB(WS_HB)};
    pg8::gemm_phase<pg8::EpiHB, pg8::SchedMoeUp, true>(ldsl, 1024, 128, Sm, E);
  }
  GRID_BAR();
  {
    unsigned char* ws = PWS;
    pg8::SchedMoeDown Sm{(const char*)(ws + WS_HB), (const char*)(ws + WS_WDT), l_off, l_te, (int)gridDim.x, (int)blockIdx.x};
    pg8::EpiYS E{WSB(WS_YS)};
    pg8::gemm_phase<pg8::EpiYS, pg8::SchedMoeDown, true>(ldsl, 256, 128, Sm, E);
  }
  GRID_BAR();
  {
    unsigned char* ws = PWS;
    ph_final(POUT, WSB(WS_YS), (const int*)(ws + WS_SMALL), l_off, PIN(21));
  }
}

extern "C" void kernel_launch(void* const* d_in, const int* in_sizes, int n_in, void* d_out, int out_size, void* d_ws, size_t ws_size, hipStream_t stream) {
  static int grid = 0;
  if (grid == 0) {
    int dev = 0, cus = 0, per_cu = 0;
    if (hipGetDevice(&dev) != hipSuccess || hipDeviceGetAttribute(&cus, hipDeviceAttributeMultiprocessorCount, dev) != hipSuccess) { fprintf(stderr, "kernel_launch: device query failed\n"); grid = -1; return; }
    if (hipFuncSetAttribute((const void*)mega_fwd, hipFuncAttributeMaxDynamicSharedMemorySize, LDS_BYTES) != hipSuccess) { fprintf(stderr, "kernel_launch: hipFuncSetAttribute failed\n"); grid = -1; return; }
    if (hipOccupancyMaxActiveBlocksPerMultiprocessor(&per_cu, (const void*)mega_fwd, 512, LDS_BYTES) != hipSuccess || per_cu < 1) { fprintf(stderr, "kernel_launch: occupancy query says %d blocks/CU\n", per_cu); (void)hipGetLastError(); grid = -1; return; }
    grid = cus;
  }
  if (grid < 0) return;
  (void)hipMemsetAsync((char*)d_ws + WS_CTL, 0, CTL_ZERO_BYTES, stream);
  Args a{};
  for (int i = 0; i < 22; ++i) a.in[i] = (const float*)d_in[i];
  a.out = (float*)d_out; a.ws = (unsigned char*)d_ws;
  hipLaunchKernelGGL(mega_fwd, dim3(grid), dim3(512), LDS_BYTES, stream, a);
}
```

```cpp
#include <hip/hip_runtime.h>
#include <stdint.h>
#include <cstdio>

typedef unsigned short bf16_t;
#define LAS __attribute__((address_space(3)))
#define GAS __attribute__((address_space(1)))
__device__ __forceinline__ float bf2f(bf16_t v) { return __uint_as_float(((unsigned)v) << 16); }
__device__ __forceinline__ bf16_t f2bf(float f) { unsigned u = __float_as_uint(f); return (bf16_t)((u + 0x7fffu + ((u >> 16) & 1u)) >> 16); }
__device__ __forceinline__ float wave_sum(float v) {
#pragma unroll
  for (int o = 1; o < 64; o <<= 1) v += __shfl_xor(v, o);
  return v;
}
__device__ __forceinline__ float wave_max(float v) {
#pragma unroll
  for (int o = 1; o < 64; o <<= 1) v = fmaxf(v, __shfl_xor(v, o));
  return v;
}
__device__ __forceinline__ float sigmoidf_(float v) { return 1.f / (1.f + __expf(-v)); }

__device__ __forceinline__ int tid_fresh() { int t = threadIdx.x; asm volatile("" : "+v"(t)); return t; }
typedef unsigned long long u64_t;
__device__ __forceinline__ const void* ldptr(const LAS u64_t* tab, int i) {
  const u64_t v = tab[i]; const unsigned lo = __builtin_amdgcn_readfirstlane((unsigned)v), hi = __builtin_amdgcn_readfirstlane((unsigned)(v >> 32));
  return (const void*)(((u64_t)hi << 32) | lo);
}

constexpr int NB = 8, S = 2048, D = 1024, NTOK = NB * S;
constexpr int INW = 4120;
constexpr int NSLOT = 40960;
constexpr size_t MiB = 1u << 20;
constexpr size_t WS_CTL = 0;
constexpr int CW_CNT = 4096;
constexpr size_t CTL_ZERO_BYTES = 65536;
constexpr size_t WS_SMALL = 1 * MiB;
constexpr size_t WS_LIST = 233 * MiB;
constexpr size_t WS_W1KT = 2 * MiB, WS_W1VT = 3 * MiB;
constexpr size_t WS_W2KT = 4 * MiB, WS_W2VT = 4 * MiB + 32768;
constexpr size_t WS_WGNT = 4 * MiB + 65536;
constexpr size_t WS_WRT_HI = 4 * MiB + 131072, WS_WRT_LO = 4 * MiB + 262144;
constexpr size_t WS_BIAS1 = 4 * MiB + 393216;
constexpr size_t WS_WABT = 5 * MiB;
constexpr size_t WS_WOT = 7 * MiB;
constexpr size_t WS_WGUT = 10 * MiB;
constexpr size_t WS_WDT = 42 * MiB;
constexpr size_t WS_WINT = 58 * MiB;
constexpr size_t WS_OAB = 66 * MiB;
constexpr size_t WS_XN = 66 * MiB;
constexpr size_t WS_OA = 66 * MiB, WS_OB = 82 * MiB;
constexpr size_t WS_YS = 66 * MiB;
constexpr size_t WS_GM = 98 * MiB;
constexpr size_t WS_H2 = 98 * MiB, WS_H2LO = 130 * MiB;
constexpr size_t WS_QA = 162 * MiB, WS_QB = 178 * MiB, WS_KVC = 194 * MiB, WS_KVS = 202 * MiB, WS_KVW = 210 * MiB, WS_KVB = 218 * MiB;
constexpr size_t WS_MG = 162 * MiB;
constexpr size_t WS_HB = 162 * MiB;
constexpr size_t WS_GTMP = 182 * MiB;
constexpr size_t WS_GN = 226 * MiB;
constexpr size_t WS_KC = 228 * MiB, WS_VC = WS_KC + 256 * 1024, WS_T1K = 229 * MiB, WS_T1V = 231 * MiB;
constexpr int SM_EID = 0, SM_WT = SM_EID + 2 * NTOK, SM_RANK = SM_WT + 2 * NTOK;
static_assert((SM_RANK + 2 * NTOK) * 4 <= (int)MiB, "small");

constexpr int LDS_BYTES = 147456;
constexpr int MISC_OFF = 131072 + 320;

#define XB_TMO      128
#define XB_XCNT(j)  (256  + 64 * (j))
#define XB_XSUB(j)  (1280 + 64 * (j))
#define XB_XGEN(j)  (2304 + 64 * (j))
#define XB_TOP      3328
#define XB_TOPGEN   3392
#define XCD_BAR_WORDS 3456
#define XB_SPIN_CAP (1u << 20)
__device__ __forceinline__ unsigned xb_ld(unsigned* p)              { return __hip_atomic_load(p, __ATOMIC_RELAXED, __HIP_MEMORY_SCOPE_AGENT); }
__device__ __forceinline__ unsigned xb_add(unsigned* p, unsigned v) { return __hip_atomic_fetch_add(p, v, __ATOMIC_RELAXED, __HIP_MEMORY_SCOPE_AGENT); }
__device__ __forceinline__ unsigned xb_xcc_id() { return (unsigned)__builtin_amdgcn_s_getreg((3 << 11) | 20) & 0xFu; }
#define XB_SPIN(cond, bar) do { unsigned _sp = 0; while (cond) { __builtin_amdgcn_s_sleep(1); \
    if ((++_sp & 255u) == 0u) { if (xb_ld(&(bar)[XB_TMO])) break; if (_sp > XB_SPIN_CAP) { atomicAdd(&(bar)[XB_TMO], 1u); break; } } } } while (0)
struct XcdBarrier { unsigned* bar; unsigned x; volatile LAS unsigned* st; };
__device__ __forceinline__ XcdBarrier xcd_barrier_post(unsigned* bar, volatile LAS unsigned* st) {
    XcdBarrier b; b.bar = bar; b.x = xb_xcc_id(); b.st = st;
    if (threadIdx.x == 0) (void)xb_add(&bar[XB_XCNT(b.x)], 1u);
    return b;
}
__device__ __forceinline__ void xcd_barrier_complete(unsigned* bar, unsigned x, unsigned& nloc, unsigned& nx) {
    const unsigned G = gridDim.x * gridDim.y * gridDim.z;
    unsigned sum, cnt, mine, sp = 0u;
    for (;;) {
        sum = 0u; cnt = 0u; mine = 0u;
#pragma unroll
        for (unsigned j = 0; j < 16; ++j) { const unsigned c = xb_ld(&bar[XB_XCNT(j)]); sum += c; cnt += (c > 0u) ? 1u : 0u; mine = (j == x) ? c : mine; }
        if (sum == G) break;
        __builtin_amdgcn_s_sleep(1);
        if ((++sp & 255u) == 0u) { if (xb_ld(&bar[XB_TMO])) break; if (sp > XB_SPIN_CAP) { atomicAdd(&bar[XB_TMO], 1u); break; } }
    }
    nloc = mine > 0u ? mine : 1u; nx = cnt > 0u ? cnt : 1u;
}
__device__ __forceinline__ void xcd_barrier(const XcdBarrier& b) {
    asm volatile("s_waitcnt vmcnt(0)" ::: "memory");
    __syncthreads();
    if (threadIdx.x == 0) {
        unsigned* bar = b.bar;
        __builtin_amdgcn_s_waitcnt(0);
        unsigned nloc = b.st[0], nx = b.st[1];
        if (nloc == 0u) { xcd_barrier_complete(bar, b.x, nloc, nx); b.st[0] = nloc; b.st[1] = nx; }
        const unsigned old = xb_add(&bar[XB_XSUB(b.x)], 1u);
        const unsigned gen = old / nloc;
        if (old + 1u == (gen + 1u) * nloc) {
            __builtin_amdgcn_fence(__ATOMIC_RELEASE, "agent");
            asm volatile("s_waitcnt vmcnt(0)" ::: "memory");
            const unsigned og = xb_add(&bar[XB_TOP], 1u);
            const unsigned tg = og / nx;
            if (og + 1u == (tg + 1u) * nx) xb_add(&bar[XB_TOPGEN], 1u);
            else XB_SPIN(xb_ld(&bar[XB_TOPGEN]) == tg, bar);
            __builtin_amdgcn_fence(__ATOMIC_ACQUIRE, "agent");
            xb_add(&bar[XB_XGEN(b.x)], 1u);
            asm volatile("s_waitcnt vmcnt(0)" ::: "memory");
        } else {
            XB_SPIN(xb_ld(&bar[XB_XGEN(b.x)]) == gen, bar);
            __builtin_amdgcn_fence(__ATOMIC_ACQUIRE, "agent");
            asm volatile("s_waitcnt vmcnt(0)" ::: "memory");
        }
    }
    __syncthreads();
}


namespace pg8 {
typedef short bf16x8 __attribute__((ext_vector_type(8)));
typedef float f32x4 __attribute__((ext_vector_type(4)));
typedef unsigned u32x4 __attribute__((ext_vector_type(4)));
typedef unsigned u32x2 __attribute__((ext_vector_type(2)));
constexpr int BM = 256, BK = 64, HALF = 128, HTB = HALF * BK * 2, STAGE_BYTES = 8 * HTB, NXCD = 8, WGM = 8;
__host__ __device__ __forceinline__ int lds_byte(int r, int c) { const int st = (r >> 4) * 2 + (c >> 5), rr = r & 15, cc = c & 31, ob = rr * 64 + cc * 2; return st * 1024 + (ob ^ (((ob >> 9) & 1) << 5)); }
__host__ __device__ __forceinline__ void stage_rc(int b, int& R, int& C) { const int st = b / 1024, sb = b % 1024, swz = sb ^ (((sb >> 9) & 1) << 5); R = (st >> 1) * 16 + swz / 64; C = (st & 1) * 32 + (swz % 64) / 2; }
__host__ __device__ __forceinline__ int perm32(int rho) { const int n = rho >> 4, i = rho & 15; return 8 * (i >> 2) + 4 * n + (i & 3); }
struct Unit { int pm, pn; const char* A; const char* B; };
__device__ __forceinline__ unsigned cvt_pk_bf16(float lo, float hi) { unsigned r; asm volatile("v_cvt_pk_bf16_f32 %0, %1, %2" : "=v"(r) : "v"(lo), "v"(hi)); return r; }

template <class Epi, class Sched, bool ALIGN_EPI>
__device__ __forceinline__ void gemm_phase(LAS unsigned char* lds, const int K, const int kstepA, const Sched& S, const Epi& E) {
    const int tid = tid_fresh(), wid = __builtin_amdgcn_readfirstlane(tid >> 6), lane = tid & 63, wr = wid >> 2, wc = wid & 3, fr = lane & 15, fq = lane >> 4;
    const int nt = K / BK;
    int Rr[2], Cc[2]; unsigned voffB[2];
#pragma unroll
    for (int i = 0; i < 2; ++i) { stage_rc(tid * 16 + i * 8192, Rr[i], Cc[i]); const int Rb = Epi::PERM ? ((Rr[i] & ~31) + perm32(Rr[i] & 31)) : Rr[i]; voffB[i] = (unsigned)(Rb * K + Cc[i]) * 2u; }
    const size_t kstepB = (size_t)(BK * 2);
    const size_t hstepB = (size_t)HALF * K * 2;
    const unsigned ldsw = (unsigned)wid * 1024u;
    const int aoff = lds_byte(wr * 64 + fr, fq * 8), boff = lds_byte(wc * 32 + fr, fq * 8);
#define PG8_SA(b, h) (((b) * 2 + (h)) * HTB)
#define PG8_SB(b, h) ((4 + (b) * 2 + (h)) * HTB)
#define PG8_STAGEB(bufoff, gbase) do { _Pragma("unroll") for (int _i = 0; _i < 2; ++_i) \
        __builtin_amdgcn_global_load_lds((const unsigned*)((const char*)(gbase) + voffB[_i]), (LAS unsigned*)(lds + (bufoff) + ldsw + _i * 8192), 16, 0, 0); } while (0)
#define PG8_STAGEA(bufoff, gbase, v0, v1) do { \
        __builtin_amdgcn_global_load_lds((const unsigned*)((const char*)(gbase) + (v0)), (LAS unsigned*)(lds + (bufoff) + ldsw), 16, 0, 0); \
        __builtin_amdgcn_global_load_lds((const unsigned*)((const char*)(gbase) + (v1)), (LAS unsigned*)(lds + (bufoff) + ldsw + 8192), 16, 0, 0); } while (0)
#define PG8_LDA(dst, b, h) do { _Pragma("unroll") for (int m = 0; m < 4; ++m) _Pragma("unroll") for (int k = 0; k < 2; ++k) dst[m][k] = *(const LAS bf16x8*)(lds + PG8_SA(b, h) + aoff + m * 2048 + k * 1024); } while (0)
#define PG8_LDB(dst, b, h) do { _Pragma("unroll") for (int n = 0; n < 2; ++n) _Pragma("unroll") for (int k = 0; k < 2; ++k) dst[n][k] = *(const LAS bf16x8*)(lds + PG8_SB(b, h) + boff + n * 2048 + k * 1024); } while (0)
#define PG8_MMA(ai, bj, At, Bt) do { __builtin_amdgcn_s_setprio(1); _Pragma("unroll") for (int m = 0; m < 4; ++m) _Pragma("unroll") for (int n = 0; n < 2; ++n) _Pragma("unroll") for (int k = 0; k < 2; ++k) \
        acc[ai][bj][m][n] = __builtin_amdgcn_mfma_f32_16x16x32_bf16(Bt[n][k], At[m][k], acc[ai][bj][m][n], 0, 0, 0); __builtin_amdgcn_s_setprio(0); } while (0)
#define PG8_WAIT_V(n) asm volatile("s_waitcnt vmcnt(" #n ")" ::: "memory")
#define PG8_WAIT_L(n) asm volatile("s_waitcnt lgkmcnt(" #n ")" ::: "memory")
#define PG8_BAR __builtin_amdgcn_s_barrier()
#define PG8_SCHED __builtin_amdgcn_sched_barrier(0)
    Unit cur, nxt; int ui = 0;
    if (!S.next(0, cur)) return;
    f32x4 acc[2][2][4][2];
#pragma unroll
    for (int a = 0; a < 2; ++a)
#pragma unroll
        for (int b = 0; b < 2; ++b)
#pragma unroll
            for (int m = 0; m < 4; ++m)
#pragma unroll
                for (int n = 0; n < 2; ++n) acc[a][b][m][n] = (f32x4){0.f, 0.f, 0.f, 0.f};
    bf16x8 At[4][2], B0[2][2], B1[2][2];
    unsigned vc00, vc01, vc10, vc11;
    vc00 = S.arow(cur, Rr[0]) + (unsigned)Cc[0] * 2u; vc01 = S.arow(cur, Rr[1]) + (unsigned)Cc[1] * 2u;
    vc10 = S.arow(cur, HALF + Rr[0]) + (unsigned)Cc[0] * 2u; vc11 = S.arow(cur, HALF + Rr[1]) + (unsigned)Cc[1] * 2u;
    const char* cA = cur.A; const char* cB = cur.B;
    PG8_STAGEB(PG8_SB(0, 0), cB); PG8_STAGEB(PG8_SB(0, 1), cB + hstepB); PG8_STAGEA(PG8_SA(0, 0), cA, vc00, vc01); PG8_STAGEA(PG8_SA(0, 1), cA, vc10, vc11);
    if (wr == 1) PG8_BAR;
    PG8_WAIT_V(2); PG8_BAR;
    PG8_STAGEB(PG8_SB(1, 0), cB + kstepB); PG8_STAGEA(PG8_SA(1, 0), cA + kstepA, vc00, vc01); PG8_STAGEB(PG8_SB(1, 1), cB + hstepB + kstepB);
    PG8_WAIT_V(6); PG8_BAR;
    for (;;) {
        const bool has_next = S.next(ui + 1, nxt);
        const char* nA = has_next ? nxt.A : cA; const char* nB = has_next ? nxt.B : cB;
        unsigned vn00 = vc00, vn01 = vc01, vn10 = vc10, vn11 = vc11;
        if (Sched::GATHER && has_next) {
            vn00 = S.arow(nxt, Rr[0]) + (unsigned)Cc[0] * 2u; vn01 = S.arow(nxt, Rr[1]) + (unsigned)Cc[1] * 2u;
            vn10 = S.arow(nxt, HALF + Rr[0]) + (unsigned)Cc[0] * 2u; vn11 = S.arow(nxt, HALF + Rr[1]) + (unsigned)Cc[1] * 2u;
        }
#pragma unroll 1
        for (int t = 0; t < nt; t += 2) {
            const bool last = (t == nt - 2);
            if (Epi::HOOK) { if (t == nt / 2) E.mid(acc, cur, wr, wc, fr, fq); }
            const char* a1 = cA + (size_t)(t + 1) * kstepA;
            const char* a2 = last ? nA : cA + (size_t)(t + 2) * kstepA; const char* b2 = last ? nB : cB + (size_t)(t + 2) * kstepB;
            const char* a3 = a2 + kstepA; const char* b3 = b2 + kstepB;
            const unsigned w00 = last ? vn00 : vc00, w01 = last ? vn01 : vc01, w10 = last ? vn10 : vc10, w11 = last ? vn11 : vc11;
            PG8_LDB(B0, 0, 0); PG8_LDB(B1, 0, 1); PG8_SCHED; PG8_LDA(At, 0, 0); PG8_STAGEA(PG8_SA(1, 1), a1, vc10, vc11);
            PG8_WAIT_V(8); PG8_WAIT_L(0); PG8_BAR; PG8_MMA(0, 0, At, B0); PG8_MMA(0, 1, At, B1); PG8_BAR; PG8_SCHED;
            PG8_LDA(At, 0, 1); PG8_STAGEB(PG8_SB(0, 0), b2); PG8_STAGEB(PG8_SB(0, 1), b2 + hstepB); PG8_STAGEA(PG8_SA(0, 0), a2, w00, w01);
            PG8_WAIT_V(8); PG8_WAIT_L(0); PG8_BAR; PG8_MMA(1, 0, At, B0); PG8_MMA(1, 1, At, B1); PG8_BAR; PG8_SCHED;
            PG8_LDB(B0, 1, 0); PG8_LDB(B1, 1, 1); PG8_SCHED; PG8_LDA(At, 1, 0); PG8_STAGEA(PG8_SA(0, 1), a2, w10, w11);
            PG8_WAIT_V(8); PG8_WAIT_L(0); PG8_BAR; PG8_MMA(0, 0, At, B0); PG8_MMA(0, 1, At, B1); PG8_BAR; PG8_SCHED;
            PG8_LDA(At, 1, 1); PG8_STAGEB(PG8_SB(1, 0), b3); PG8_STAGEB(PG8_SB(1, 1), b3 + hstepB); PG8_STAGEA(PG8_SA(1, 0), a3, w00, w01);
            PG8_WAIT_V(8); PG8_WAIT_L(0); PG8_BAR; PG8_MMA(1, 0, At, B0); PG8_MMA(1, 1, At, B1); PG8_BAR; PG8_SCHED;
        }
        if constexpr (ALIGN_EPI) { if (wr == 0) PG8_BAR; }
        E(acc, cur, wr, wc, fr, fq);
        if (!has_next) break;
#pragma unroll
        for (int a = 0; a < 2; ++a)
#pragma unroll
            for (int b = 0; b < 2; ++b)
#pragma unroll
                for (int m = 0; m < 4; ++m)
#pragma unroll
                    for (int n = 0; n < 2; ++n) acc[a][b][m][n] = (f32x4){0.f, 0.f, 0.f, 0.f};
        cur = nxt; cA = nA; cB = nB; vc00 = vn00; vc01 = vn01; vc10 = vn10; vc11 = vn11; ++ui;
        if constexpr (ALIGN_EPI) { if (wr == 1) PG8_BAR; }
    }
    PG8_WAIT_V(0);
    if constexpr (!ALIGN_EPI) { if (wr == 0) PG8_BAR; }
    PG8_BAR;
#undef PG8_SA
#undef PG8_SB
#undef PG8_STAGEA
#undef PG8_STAGEB
#undef PG8_LDA
#undef PG8_LDB
#undef PG8_MMA
#undef PG8_WAIT_V
#undef PG8_WAIT_L
#undef PG8_BAR
#undef PG8_SCHED
}

struct SchedDense {
    static constexpr bool GATHER = false;
    const char* A; const char* B; int pitchA  ; int K; int nM, nN, nwg, G, c;
    __device__ void init(const void* A_, int pitchA_, const void* B_, int M, int N, int K_, int G_, int c_) { A = (const char*)A_; B = (const char*)B_; pitchA = pitchA_; K = K_; nM = M / BM; nN = N / BM; nwg = nM * nN; G = G_; c = c_; }
    __device__ bool next(int i, Unit& u) const {
        const long L = (long)i * G + c; if (L >= nwg) return false;
        int wgid = (int)L; { const int q = nwg / NXCD, r = nwg % NXCD, xcd = wgid % NXCD, off = wgid / NXCD; wgid = (xcd < r ? xcd * (q + 1) : r * (q + 1) + (xcd - r) * q) + off; }
        const int nig = WGM * nN, gid = wgid / nig, fm = gid * WGM, gsz = (nM - fm) < WGM ? (nM - fm) : WGM;
        u.pm = fm + ((wgid % nig) % gsz); u.pn = (wgid % nig) / gsz;
        u.A = A + (size_t)u.pm * BM * pitchA; u.B = B + (size_t)u.pn * BM * K * 2; return true;
    }
    __device__ unsigned arow(const Unit&, int r) const { return (unsigned)(r * pitchA); }
};
struct SchedMoeUp {
    static constexpr bool GATHER = true;
    const char* H2; const char* W; const int* list; const int* cnt; const int* l_off; const int* l_te; int G, c;
    __device__ bool next(int i, Unit& u) const {
        const int L = i * G + c, tix = L >> 1; if (tix >= (l_off[32] >> 8)) return false;
        u.pm = tix; u.pn = L & 1; const int e = l_te[tix];
        u.A = H2; u.B = W + (size_t)e * (512 * 1024 * 2) + (size_t)u.pn * (256 * 1024 * 2); return true;
    }
    __device__ unsigned arow(const Unit& u, int r) const { const int e = l_te[u.pm]; int ri = u.pm * 256 + r - l_off[e]; if (ri >= cnt[e]) ri = 0; return (unsigned)list[(size_t)e * NTOK + ri] * 2048u; }
};
struct SchedMoeDown {
    static constexpr bool GATHER = false;
    const char* HB; const char* W; const int* l_off; const int* l_te; int G, c;
    __device__ bool next(int i, Unit& u) const {
        const int L = i * G + c, tix = L >> 2; if (tix >= (l_off[32] >> 8)) return false;
        u.pm = tix; u.pn = L & 3; const int e = l_te[tix];
        u.A = HB + (size_t)tix * (256 * 512); u.B = W + (size_t)e * (1024 * 256 * 2) + (size_t)u.pn * (256 * 256 * 2); return true;
    }
    __device__ unsigned arow(const Unit&, int r) const { return (unsigned)(r * 512); }
};

__device__ __forceinline__ float sigm(float v) { return __builtin_amdgcn_rcpf(1.f + __expf(-v)); }
struct EpiProj {
    static constexpr bool PERM = true, HOOK = false;
    bf16_t *QA, *QB, *KVC, *KVS, *KVW, *KVB, *GM;
    __device__ __forceinline__ void mid(f32x4 (&)[2][2][4][2], const Unit&, int, int, int, int) const {}
    __device__ __forceinline__ void operator()(const f32x4 (&acc)[2][2][4][2], const Unit& u, int wr, int wc, int fr, int fq) const {
        const int pn = u.pn; bf16_t* base; int ldc, colt; bool sg = false;
        if (pn < 2) { base = QA; ldc = 512; colt = pn * 256; }
        else if (pn == 2) { base = KVC; ldc = 256; colt = 0; }
        else if (pn == 3) { base = KVS; ldc = 256; colt = 0; }
        else if (pn == 4) { base = KVW; ldc = 256; colt = 0; }
        else if (pn < 7) { base = QB; ldc = 512; colt = (pn - 5) * 256; }
        else if (pn == 7) { base = KVB; ldc = 256; colt = 0; }
        else { base = GM; ldc = 2048; colt = (pn - 8) * 256; sg = true; }
        const int row0 = u.pm * BM + wr * 64 + fr, col0 = colt + wc * 32 + 8 * fq;
#pragma unroll
        for (int ai = 0; ai < 2; ++ai)
#pragma unroll
            for (int m = 0; m < 4; ++m) { bf16_t* rowp = base + (size_t)(row0 + ai * HALF + m * 16) * ldc + col0;
#pragma unroll
                for (int bj = 0; bj < 2; ++bj) { f32x4 v0 = acc[ai][bj][m][0], v1 = acc[ai][bj][m][1];
                    if (sg) { v0 = (f32x4){sigm(v0[0]), sigm(v0[1]), sigm(v0[2]), sigm(v0[3])}; v1 = (f32x4){sigm(v1[0]), sigm(v1[1]), sigm(v1[2]), sigm(v1[3])}; }
                    u32x4 w; w.x = cvt_pk_bf16(v0[0], v0[1]); w.y = cvt_pk_bf16(v0[2], v0[3]); w.z = cvt_pk_bf16(v1[0], v1[1]); w.w = cvt_pk_bf16(v1[2], v1[3]);
                    *(u32x4*)(rowp + bj * HALF) = w; } }
    }
};
struct EpiMerge {
    static constexpr bool PERM = true, HOOK = true;
    const bf16_t* GM; bf16_t* MG;
    __device__ __forceinline__ void mid(f32x4 (&acc)[2][2][4][2], const Unit& u, int wr, int wc, int fr, int fq) const {
        const int row0 = u.pm * BM + wr * 64 + fr, col0 = u.pn * BM + wc * 32 + 8 * fq;
        const GAS char* gm = (const GAS char*)GM + ((size_t)row0 * 2048 + col0) * 2;
#pragma unroll
        for (int ai = 0; ai < 2; ++ai)
#pragma unroll
            for (int m = 0; m < 4; ++m) { unsigned ro = (unsigned)(ai * HALF + m * 16) * 4096u; asm volatile("" : "+v"(ro));
#pragma unroll
                for (int bj = 0; bj < 2; ++bj) { const u32x4 ga = *(const GAS u32x4*)(gm + ro + bj * 256), gb = *(const GAS u32x4*)(gm + ro + 2048 + bj * 256);
                    const unsigned gaw[4] = {ga.x, ga.y, ga.z, ga.w}, gbw[4] = {gb.x, gb.y, gb.z, gb.w};
#pragma unroll
                    for (int q = 0; q < 4; ++q) { const float a0 = __uint_as_float(gaw[q] << 16), a1 = __uint_as_float(gaw[q] & 0xffff0000u), b0 = __uint_as_float(gbw[q] << 16), b1 = __uint_as_float(gbw[q] & 0xffff0000u);
                        acc[ai][bj][m][q >> 1][(q & 1) * 2] *= b0 * __builtin_amdgcn_rcpf(a0); acc[ai][bj][m][q >> 1][(q & 1) * 2 + 1] *= b1 * __builtin_amdgcn_rcpf(a1); } } }
    }
    __device__ __forceinline__ void operator()(const f32x4 (&acc)[2][2][4][2], const Unit& u, int wr, int wc, int fr, int fq) const {
        const int row0 = u.pm * BM + wr * 64 + fr, col0 = u.pn * BM + wc * 32 + 8 * fq;
        const GAS char* gm = (const GAS char*)GM + ((size_t)row0 * 2048 + col0) * 2;
        GAS char* mg = (GAS char*)MG + ((size_t)row0 * 1024 + col0) * 2;
#pragma unroll
        for (int ai = 0; ai < 2; ++ai)
#pragma unroll
            for (int m = 0; m < 4; ++m) { unsigned ro = (unsigned)(ai * HALF + m * 16) * 2048u; asm volatile("" : "+v"(ro));
#pragma unroll
                for (int bj = 0; bj < 2; ++bj) { const u32x4 ga = *(const GAS u32x4*)(gm + 2 * ro + bj * 256); const unsigned gaw[4] = {ga.x, ga.y, ga.z, ga.w}; float o[8];
#pragma unroll
                    for (int q = 0; q < 4; ++q) { o[2 * q] = acc[ai][bj][m][q >> 1][(q & 1) * 2] * __uint_as_float(gaw[q] << 16); o[2 * q + 1] = acc[ai][bj][m][q >> 1][(q & 1) * 2 + 1] * __uint_as_float(gaw[q] & 0xffff0000u); }
                    u32x4 w; w.x = cvt_pk_bf16(o[0], o[1]); w.y = cvt_pk_bf16(o[2], o[3]); w.z = cvt_pk_bf16(o[4], o[5]); w.w = cvt_pk_bf16(o[6], o[7]);
                    *(GAS u32x4*)(mg + ro + bj * 256) = w; } }
    }
};
struct EpiX1 {
    static constexpr bool PERM = false, HOOK = false;
    const float* x; float* out;
    __device__ __forceinline__ void mid(f32x4 (&)[2][2][4][2], const Unit&, int, int, int, int) const {}
    __device__ __forceinline__ void operator()(const f32x4 (&acc)[2][2][4][2], const Unit& u, int wr, int wc, int fr, int fq) const {
        const int row0 = u.pm * BM + wr * 64 + fr, col0 = u.pn * BM + wc * 32 + 4 * fq;
#pragma unroll
        for (int ai = 0; ai < 2; ++ai)
#pragma unroll
            for (int m = 0; m < 4; ++m) { const size_t off = (size_t)(row0 + ai * HALF + m * 16) * 1024 + col0;
#pragma unroll
                for (int bj = 0; bj < 2; ++bj)
#pragma unroll
                    for (int n = 0; n < 2; ++n) { const f32x4 bs = *(const f32x4*)(x + off + bj * HALF + n * 16); *(f32x4*)(out + off + bj * HALF + n * 16) = bs + acc[ai][bj][m][n]; } }
    }
};
struct EpiHB {
    static constexpr bool PERM = true, HOOK = false;
    bf16_t* HB;
    __device__ __forceinline__ void mid(f32x4 (&)[2][2][4][2], const Unit&, int, int, int, int) const {}
    __device__ __forceinline__ void operator()(const f32x4 (&acc)[2][2][4][2], const Unit& u, int wr, int wc, int fr, int fq) const {
        const int row0 = u.pm * BM + wr * 64 + fr, col0 = u.pn * HALF + wc * 32 + 8 * fq;
#pragma unroll
        for (int ai = 0; ai < 2; ++ai)
#pragma unroll
            for (int m = 0; m < 4; ++m) { float o[8];
#pragma unroll
                for (int n = 0; n < 2; ++n)
#pragma unroll
                    for (int j = 0; j < 4; ++j) { const float g = acc[ai][0][m][n][j]; o[n * 4 + j] = g * sigm(g) * acc[ai][1][m][n][j]; }
                u32x4 w; w.x = cvt_pk_bf16(o[0], o[1]); w.y = cvt_pk_bf16(o[2], o[3]); w.z = cvt_pk_bf16(o[4], o[5]); w.w = cvt_pk_bf16(o[6], o[7]);
                *(u32x4*)(HB + (size_t)(row0 + ai * HALF + m * 16) * 256 + col0) = w; }
    }
};
struct EpiYS {
    static constexpr bool PERM = true, HOOK = false;
    bf16_t* YS;
    __device__ __forceinline__ void mid(f32x4 (&)[2][2][4][2], const Unit&, int, int, int, int) const {}
    __device__ __forceinline__ void operator()(const f32x4 (&acc)[2][2][4][2], const Unit& u, int wr, int wc, int fr, int fq) const {
        const int row0 = u.pm * BM + wr * 64 + fr, col0 = u.pn * BM + wc * 32 + 8 * fq;
#pragma unroll
        for (int ai = 0; ai < 2; ++ai)
#pragma unroll
            for (int m = 0; m < 4; ++m) { bf16_t* rowp = YS + (size_t)(row0 + ai * HALF + m * 16) * 1024 + col0;
#pragma unroll
                for (int bj = 0; bj < 2; ++bj) { const f32x4 v0 = acc[ai][bj][m][0], v1 = acc[ai][bj][m][1];
                    u32x4 w; w.x = cvt_pk_bf16(v0[0], v0[1]); w.y = cvt_pk_bf16(v0[2], v0[3]); w.z = cvt_pk_bf16(v1[0], v1[1]); w.w = cvt_pk_bf16(v1[2], v1[3]);
                    *(u32x4*)(rowp + bj * HALF) = w; } }
    }
};
}

__device__ __forceinline__ unsigned pk2(float lo, float hi) { return (unsigned)f2bf(lo) | ((unsigned)f2bf(hi) << 16); }
__device__ __forceinline__ void tr_item(const float* __restrict__ W, int ldw, int c0, int nvalid, int k0, bf16_t* __restrict__ WT, int ldt, int r0, int kd0, LAS float* scr, int lane) {
#pragma unroll 8
  for (int i = 0; i < 32; ++i) { const int kk = 2 * i + (lane >> 5), n = lane & 31; scr[kk * 33 + n] = n < nvalid ? W[(size_t)(k0 + kk) * ldw + c0 + n] : 0.f; }
  asm volatile("s_waitcnt lgkmcnt(0)" ::: "memory");
  const int c = lane & 7;
#pragma unroll
  for (int j = 0; j < 4; ++j) { const int n = (lane >> 3) + 8 * j; const LAS float* s = scr + (8 * c) * 33 + n;
    pg8::u32x4 o; o.x = pk2(s[0 * 33], s[1 * 33]); o.y = pk2(s[2 * 33], s[3 * 33]); o.z = pk2(s[4 * 33], s[5 * 33]); o.w = pk2(s[6 * 33], s[7 * 33]);
    *(pg8::u32x4*)(WT + (size_t)(r0 + n) * ldt + kd0 + k0 + 8 * c) = o; }
  asm volatile("s_waitcnt lgkmcnt(0)" ::: "memory");
}


namespace att {
typedef float f32x16 __attribute__((ext_vector_type(16)));
typedef short bf16x8 __attribute__((ext_vector_type(8)));
typedef short s16x4 __attribute__((ext_vector_type(4)));
typedef unsigned u32x4 __attribute__((ext_vector_type(4)));
constexpr float LOG2E = 1.4426950408889634f, C2 = 0.125f * LOG2E, NEG = -1e30f;
constexpr int L_KS = 0, L_VS = 16384, L_WSC = 32768, L_PS = 36864, L_SCR = 69632, L_MSK = 77824;
__device__ __forceinline__ int crow(int r, int hi) { return (r & 3) + 8 * (r >> 2) + 4 * hi; }
__device__ __forceinline__ unsigned cvtpk(float lo, float hi) { unsigned r; asm volatile("v_cvt_pk_bf16_f32 %0, %1, %2" : "=v"(r) : "v"(lo), "v"(hi)); return r; }
struct KVRegs { u32x4 k, v; };
__device__ __forceinline__ KVRegs kv_load(const bf16_t* kptr, const bf16_t* vptr, int pitch, int wid, int lane) {
  KVRegs r;
  r.k = *(const GAS u32x4*)(kptr + (size_t)lane * pitch + wid * 8);
  r.v = *(const GAS u32x4*)(vptr + (size_t)(16 * (wid & 3) + (lane >> 2)) * pitch + (wid >> 2) * 32 + (lane & 3) * 8);
  return r;
}
__device__ __forceinline__ void kv_store(LAS unsigned char* Ks, LAS unsigned char* Vs, const KVRegs& r, int wid, int lane) {
  *(LAS u32x4*)(Ks + wid * 1024 + lane * 16) = r.k;
  *(LAS u32x4*)(Vs + wid * 1024 + lane * 16) = r.v;
}
__device__ __forceinline__ void qkt(f32x16& p0, f32x16& p1, const LAS unsigned char* Ks, const bf16x8 (&qr)[4], int r32, int hi) {
  const LAS unsigned char* kb = Ks + hi * 1024 + r32 * 16;
  const f32x16 z = {0.f, 0.f, 0.f, 0.f, 0.f, 0.f, 0.f, 0.f, 0.f, 0.f, 0.f, 0.f, 0.f, 0.f, 0.f, 0.f};
  p0 = z; p1 = z;
#pragma unroll
  for (int d0 = 0; d0 < 4; ++d0) {
    const bf16x8 b0 = *(const LAS bf16x8*)(kb + d0 * 2048), b1 = *(const LAS bf16x8*)(kb + d0 * 2048 + 512);
    p0 = __builtin_amdgcn_mfma_f32_32x32x16_bf16(b0, qr[d0], p0, 0, 0, 0);
    p1 = __builtin_amdgcn_mfma_f32_32x32x16_bf16(b1, qr[d0], p1, 0, 0, 0);
  }
}
typedef short v4i16_t __attribute__((ext_vector_type(4)));
__device__ __forceinline__ s16x4 vtr(const LAS unsigned char* p) { return __builtin_bit_cast(s16x4, __builtin_amdgcn_ds_read_tr16_b64_v4i16((LAS v4i16_t*)p)); }
__device__ __forceinline__ void pv(f32x16 (&o)[2], const LAS unsigned char* Vs, const bf16x8 (&pa)[4], int lane) {
  const int hi = lane >> 5;
  const LAS unsigned char* vb = Vs + ((lane >> 4) & 1) * 32 + (lane & 3) * 8 + (4 * hi + ((lane & 15) >> 2)) * 64;
#pragma unroll
  for (int d0 = 0; d0 < 2; ++d0)
#pragma unroll
    for (int ks = 0; ks < 4; ++ks) {
      const s16x4 lo = vtr(vb + d0 * 4096 + ks * 1024), hh = vtr(vb + d0 * 4096 + ks * 1024 + 512);
      const bf16x8 vf = {lo[0], lo[1], lo[2], lo[3], hh[0], hh[1], hh[2], hh[3]};
      o[d0] = __builtin_amdgcn_mfma_f32_32x32x16_bf16(pa[ks], vf, o[d0], 0, 0, 0);
    }
}
__device__ __forceinline__ void pack_p(bf16x8 (&pa)[4], const f32x16& p0, const f32x16& p1) {
  u32x4 w0 = {cvtpk(p0[0], p0[1]), cvtpk(p0[2], p0[3]), cvtpk(p0[4], p0[5]), cvtpk(p0[6], p0[7])};
  u32x4 w1 = {cvtpk(p0[8], p0[9]), cvtpk(p0[10], p0[11]), cvtpk(p0[12], p0[13]), cvtpk(p0[14], p0[15])};
  u32x4 w2 = {cvtpk(p1[0], p1[1]), cvtpk(p1[2], p1[3]), cvtpk(p1[4], p1[5]), cvtpk(p1[6], p1[7])};
  u32x4 w3 = {cvtpk(p1[8], p1[9]), cvtpk(p1[10], p1[11]), cvtpk(p1[12], p1[13]), cvtpk(p1[14], p1[15])};
  pa[0] = __builtin_bit_cast(bf16x8, w0); pa[1] = __builtin_bit_cast(bf16x8, w1); pa[2] = __builtin_bit_cast(bf16x8, w2); pa[3] = __builtin_bit_cast(bf16x8, w3);
}
template <int MODE>
__device__ __forceinline__ float logits(f32x16& p0, f32x16& p1, float slope2, int t, int kbase, int W, bool rowsel, int hi) {
  float mt = NEG;
#pragma unroll
  for (int r = 0; r < 16; ++r) {
    const int key0 = (r & 3) + 8 * (r >> 2) + 4 * hi, key1 = key0 + 32;
    int d0, d1;
    if (MODE == 3) { d0 = t - (16 * (kbase + key0) + 31); d1 = t - (16 * (kbase + key1) + 31); } else { d0 = t - (kbase + key0); d1 = d0 - 32; }
    float s0 = fmaf(p0[r], C2, -slope2 * (float)d0), s1 = fmaf(p1[r], C2, -slope2 * (float)d1);
    if (MODE == 1) { s0 = (d0 >= 0 && d0 < W) ? s0 : NEG; s1 = (d1 >= 0 && d1 < W) ? s1 : NEG; }
    if (MODE == 2) { s0 = (rowsel && d0 >= 0) ? s0 : NEG; s1 = (rowsel && d1 >= 0) ? s1 : NEG; }
    if (MODE == 3) { s0 = (d0 >= 0 && kbase + key0 < 127) ? s0 : NEG; s1 = (d1 >= 0 && kbase + key1 < 127) ? s1 : NEG; }
    p0[r] = s0; p1[r] = s1; mt = fmaxf(mt, fmaxf(s0, s1));
  }
  return fmaxf(mt, __shfl_xor(mt, 32));
}
__device__ __forceinline__ float expo(f32x16& p0, f32x16& p1, float mref) {
  float rs = 0.f;
#pragma unroll
  for (int r = 0; r < 16; ++r) { p0[r] = __builtin_amdgcn_exp2f(p0[r] - mref); p1[r] = __builtin_amdgcn_exp2f(p1[r] - mref); rs += p0[r] + p1[r]; }
  return rs;
}
__device__ __forceinline__ void scale_rows(f32x16 (&o)[2], float f, LAS float* wsc, int r32, int hi) {
  if (hi == 0) wsc[r32] = f;
#pragma unroll
  for (int r = 0; r < 16; ++r) { const float a = wsc[crow(r, hi)]; o[0][r] *= a; o[1][r] *= a; }
}
template <int MODE>
__device__ __forceinline__ void tile_step(f32x16 (&o)[2], float& m, float& l, const bf16x8 (&qr)[4], const LAS unsigned char* Ks, const LAS unsigned char* Vs, LAS float* wsc,
                                          float slope2, int t, int kbase, int W, bool rowsel, int lane) {
  const int r32 = lane & 31, hi = lane >> 5;
  f32x16 p0, p1;
  qkt(p0, p1, Ks, qr, r32, hi);
  const float mt = logits<MODE>(p0, p1, slope2, t, kbase, W, rowsel, hi);
  const float mn = fmaxf(m, mt), alpha = __builtin_amdgcn_exp2f(m - mn), mref = mn < -1e29f ? 0.f : mn;
  m = mn;
  const float rs = expo(p0, p1, mref);
  l = l * alpha + rs;
  scale_rows(o, alpha, wsc, r32, hi);
  bf16x8 pa[4]; pack_p(pa, p0, p1);
  pv(o, Vs, pa, lane);
}
__device__ __forceinline__ void load_q(bf16x8 (&qr)[4], const bf16_t* qrow  , int hi) {
#pragma unroll
  for (int d0 = 0; d0 < 4; ++d0) qr[d0] = *(const GAS bf16x8*)(qrow + d0 * 16 + hi * 8);
}
__device__ __forceinline__ void zero_o(f32x16 (&o)[2]) {
  const f32x16 z = {0.f, 0.f, 0.f, 0.f, 0.f, 0.f, 0.f, 0.f, 0.f, 0.f, 0.f, 0.f, 0.f, 0.f, 0.f, 0.f}; o[0] = z; o[1] = z;
}

__device__ __forceinline__ void swa_unit(LAS unsigned char* lds, int b, int hkv, int qt, const bf16_t* __restrict__ QB, const bf16_t* __restrict__ KVB, const float* __restrict__ sinks, bf16_t* __restrict__ OAB) {
  const int tid = tid_fresh(), lane = tid & 63, wid = __builtin_amdgcn_readfirstlane(tid >> 6), r32 = lane & 31, hi = lane >> 5;
  const int g = wid >> 1, head = hkv * 4 + g, t0 = qt * 64, t = t0 + 32 * (wid & 1) + r32;
  const size_t tokb = (size_t)b * S;
  LAS float* wsc = (LAS float*)(lds + L_WSC) + wid * 64;
  const float slope2 = exp2f(-0.5f * (float)(1 + head)) * LOG2E, sink2 = sinks[head] * LOG2E;
  bf16x8 qr[4]; load_q(qr, QB + (tokb + t) * 512 + head * 64, hi);
  f32x16 o[2]; zero_o(o);
  float m = NEG, l = 0.f;
  const int j0 = qt >= 2 ? qt - 2 : 0, nj = qt - j0 + 1;
  const bf16_t* kp = KVB + tokb * 256 + hkv * 64; const bf16_t* vp = kp + 128;
  KVRegs kr = kv_load(kp + (size_t)j0 * 64 * 256, vp + (size_t)j0 * 64 * 256, 256, wid, lane);
  kv_store(lds + L_KS, lds + L_VS, kr, wid, lane);
  __syncthreads();
  for (int i = 0; i < nj; ++i) {
    const int j = j0 + i, sl = (i & 1) * 8192;
    if (i + 1 < nj) kr = kv_load(kp + (size_t)(j + 1) * 64 * 256, vp + (size_t)(j + 1) * 64 * 256, 256, wid, lane);
    if (j == qt - 1) tile_step<0>(o, m, l, qr, lds + L_KS + sl, lds + L_VS + sl, wsc, slope2, t, j * 64, 128, true, lane);
    else tile_step<1>(o, m, l, qr, lds + L_KS + sl, lds + L_VS + sl, wsc, slope2, t, j * 64, 128, true, lane);
    if (i + 1 < nj) kv_store(lds + L_KS + (sl ^ 8192), lds + L_VS + (sl ^ 8192), kr, wid, lane);
    __syncthreads();
  }
  float lt = l + __shfl_xor(l, 32);
  const float mf = fmaxf(m, sink2), z = lt * __builtin_amdgcn_exp2f(m - mf) + __builtin_amdgcn_exp2f(sink2 - mf);
  scale_rows(o, __builtin_amdgcn_exp2f(m - mf) / z, wsc, r32, hi);
  bf16_t* op = OAB + (tokb + t0 + 32 * (wid & 1)) * 1024 + head * 64 + r32;
#pragma unroll
  for (int r = 0; r < 16; ++r) { const int q = crow(r, hi); op[(size_t)q * 1024] = f2bf(o[0][r]); op[(size_t)q * 1024 + 32] = f2bf(o[1][r]); }
}
__device__ __forceinline__ void swa_phase(LAS unsigned char* lds, const bf16_t* QB, const bf16_t* KVB, const float* sinks, bf16_t* OAB) {
#pragma unroll 1
  for (int u = blockIdx.x; u < NB * 2 * 32; u += gridDim.x) { swa_unit(lds, u >> 6, (u >> 5) & 1, u & 31, QB, KVB, sinks, OAB); }
}

constexpr int L_OACC = 36864;
__device__ __forceinline__ void oacc_store(LAS unsigned char* lds, const f32x16 (&o)[2], int wid, int lane) {
  LAS float* p = (LAS float*)(lds + L_OACC) + wid * 2048 + lane;
#pragma unroll
  for (int r = 0; r < 16; ++r) { p[r * 64] = o[0][r]; p[1024 + r * 64] = o[1][r]; }
}
__device__ __forceinline__ void oacc_add(LAS unsigned char* lds, const f32x16 (&o)[2], int wid, int lane) {
  LAS float* p = (LAS float*)(lds + L_OACC) + wid * 2048 + lane;
#pragma unroll
  for (int r = 0; r < 16; ++r) { p[r * 64] += o[0][r]; p[1024 + r * 64] += o[1][r]; }
}
__device__ __forceinline__ void nsa_unit(LAS unsigned char* lds, int b, int hkv, int qt, const bf16_t* __restrict__ QA, const bf16_t* __restrict__ KC, const bf16_t* __restrict__ VC,
                                         const bf16_t* __restrict__ KVS, const bf16_t* __restrict__ KVW, const float* __restrict__ GN, bf16_t* __restrict__ OAB) {
  const int tid = tid_fresh(), lane = tid & 63, wid = __builtin_amdgcn_readfirstlane(tid >> 6), r32 = lane & 31, hi = lane >> 5;
  const int g = wid >> 1, qh = wid & 1, head = hkv * 4 + g, t0 = qt * 64, ql = 32 * qh + r32, t = t0 + ql;
  const size_t tokb = (size_t)b * S;
  LAS float* wsc = (LAS float*)(lds + L_WSC) + wid * 64;
  LAS float* PS = (LAS float*)(lds + L_PS);
  LAS float* SCR = (LAS float*)(lds + L_SCR);
  LAS unsigned* MSK = (LAS unsigned*)(lds + L_MSK);
  const float slope2 = exp2f(-0.5f * (float)(9 + head)) * LOG2E;
  const float* gnp = GN + (tokb + t) * 32 + hkv * 12 + g * 3;
  bf16x8 qr[4]; load_q(qr, QA + (tokb + t) * 512 + head * 64, hi);
  const int nct = (t0 + 63 >= 31 + 16 * 64) ? 2 : 1;
  f32x16 ocmp[2]; zero_o(ocmp);
  {
    const bf16_t* kp = KC + ((size_t)b * 128 * 2 + hkv) * 64; const bf16_t* vp = VC + ((size_t)b * 128 * 2 + hkv) * 64;
    { KVRegs k0 = kv_load(kp, vp, 128, wid, lane); kv_store(lds + L_KS, lds + L_VS, k0, wid, lane); }
    if (nct == 2) { KVRegs k1 = kv_load(kp + (size_t)64 * 128, vp + (size_t)64 * 128, 128, wid, lane); kv_store(lds + L_KS + 8192, lds + L_VS + 8192, k1, wid, lane); }
    if (tid < 65) MSK[tid] = 0u;
    __syncthreads();
    float m = NEG, l = 0.f;
    for (int ct = 0; ct < nct; ++ct) {
      f32x16 p0, p1;
      qkt(p0, p1, lds + L_KS + ct * 8192, qr, r32, hi);
      const float mt = logits<3>(p0, p1, slope2, t, ct * 64, 0, true, hi);
      const float mn = fmaxf(m, mt), alpha = __builtin_amdgcn_exp2f(m - mn), mref = mn < -1e29f ? 0.f : mn;
      m = mn; l = l * alpha + expo(p0, p1, mref);
    }
    l += __shfl_xor(l, 32);
    const float inv = l > 0.f ? 1.f / l : 1.f, mref = m < -1e29f ? 0.f : m;
    for (int ct = 0; ct < nct; ++ct) {
      f32x16 p0, p1;
      qkt(p0, p1, lds + L_KS + ct * 8192, qr, r32, hi);
      (void)logits<3>(p0, p1, slope2, t, ct * 64, 0, true, hi);
      (void)expo(p0, p1, mref);
#pragma unroll
      for (int r = 0; r < 16; ++r) { p0[r] *= inv; p1[r] *= inv; }
      { bf16x8 pa[4]; pack_p(pa, p0, p1); pv(ocmp, lds + L_VS + ct * 8192, pa, lane); }
      for (int gg = 0; gg < 4; ++gg) {
        if (g == gg) {
#pragma unroll
          for (int r = 0; r < 16; ++r) {
            LAS float* pr = PS + ql * 128 + ct * 64 + crow(r, hi);
            if (gg == 0) { pr[0] = p0[r]; pr[32] = p1[r]; } else { pr[0] += p0[r]; pr[32] += p1[r]; }
          }
        }
        __syncthreads();
      }
    }
    if (nct == 1) {
      if (tid < 64) { LAS float* pr = PS + tid * 128 + 64; pr[0] = 0.f; pr[1] = 0.f; pr[2] = 0.f; pr[3] = 0.f; }
    }
    scale_rows(ocmp, gnp[0], wsc, r32, hi);
    __syncthreads();
  }
  {
    const int cur = qt;
#pragma unroll
    for (int i = 0; i < 4; ++i) {
      const int pi = tid + i * 512, q = pi >> 5, j = pi & 31;
      const LAS float* pr = PS + q * 128;
      float imp = 0.f;
      if (j <= cur) {
        const int c = 4 * j;
        imp = pr[c] + pr[c + 1] + pr[c + 2] + 0.5f * (c + 3 < 127 ? pr[c + 3] : 0.f) + 0.5f * (c > 0 ? pr[c - 1] : 0.f);
      }
      const bool forced = (j == 0) || (j == cur) || (j == cur - 1);
      SCR[pi] = forced ? 1e9f : (j <= cur ? imp : NEG);
    }
    __syncthreads();
#pragma unroll
    for (int i = 0; i < 4; ++i) {
      const int pi = tid + i * 512, q = pi >> 5, j = pi & 31;
      const float sj = SCR[pi]; int rank = 0;
      for (int k = 0; k < 32; ++k) { const float sk = SCR[q * 32 + k]; rank += ((sk > sj) || (sk == sj && k < j)) ? 1 : 0; }
      if (rank < 8 && sj > -5e29f) { __hip_atomic_fetch_or(&MSK[q], 1u << j, __ATOMIC_RELAXED, __HIP_MEMORY_SCOPE_WORKGROUP); __hip_atomic_fetch_or(&MSK[64], 1u << j, __ATOMIC_RELAXED, __HIP_MEMORY_SCOPE_WORKGROUP); }
    }
    __syncthreads();
  }
  const unsigned um = MSK[64], mymask = MSK[ql];
  __syncthreads();
  oacc_store(lds, ocmp, wid, lane);
  {
    f32x16 o[2]; zero_o(o);
    float m = NEG, l = 0.f;
    const bf16_t* kp = KVS + tokb * 256 + hkv * 64; const bf16_t* vp = kp + 128;
    unsigned rem = (unsigned)__builtin_amdgcn_readfirstlane(um);
    int j = __builtin_ctz(rem); rem &= rem - 1;
    KVRegs kr = kv_load(kp + (size_t)j * 64 * 256, vp + (size_t)j * 64 * 256, 256, wid, lane);
    kv_store(lds + L_KS, lds + L_VS, kr, wid, lane);
    __syncthreads();
    int sl = 0;
    for (;;) {
      const int jn = rem ? __builtin_ctz(rem) : -1; if (rem) rem &= rem - 1;
      if (jn >= 0) kr = kv_load(kp + (size_t)jn * 64 * 256, vp + (size_t)jn * 64 * 256, 256, wid, lane);
      tile_step<2>(o, m, l, qr, lds + L_KS + sl, lds + L_VS + sl, wsc, slope2, t, j * 64, 0, ((mymask >> j) & 1u) != 0u, lane);
      if (jn >= 0) kv_store(lds + L_KS + (sl ^ 8192), lds + L_VS + (sl ^ 8192), kr, wid, lane);
      __syncthreads();
      if (jn < 0) break;
      j = jn; sl ^= 8192;
    }
    const float lt = l + __shfl_xor(l, 32), inv = lt > 0.f ? 1.f / lt : 1.f;
    scale_rows(o, inv * gnp[1], wsc, r32, hi);
    oacc_add(lds, o, wid, lane);
  }
  {
    f32x16 o[2]; zero_o(o);
    float m = NEG, l = 0.f;
    const int j0 = qt >= 4 ? qt - 4 : 0, nj = qt - j0 + 1;
    const bf16_t* kp = KVW + tokb * 256 + hkv * 64; const bf16_t* vp = kp + 128;
    KVRegs kr = kv_load(kp + (size_t)j0 * 64 * 256, vp + (size_t)j0 * 64 * 256, 256, wid, lane);
    kv_store(lds + L_KS, lds + L_VS, kr, wid, lane);
    __syncthreads();
    for (int i = 0; i < nj; ++i) {
      const int j = j0 + i, sl = (i & 1) * 8192;
      if (i + 1 < nj) kr = kv_load(kp + (size_t)(j + 1) * 64 * 256, vp + (size_t)(j + 1) * 64 * 256, 256, wid, lane);
      if (j < qt && j > qt - 4) tile_step<0>(o, m, l, qr, lds + L_KS + sl, lds + L_VS + sl, wsc, slope2, t, j * 64, 256, true, lane);
      else tile_step<1>(o, m, l, qr, lds + L_KS + sl, lds + L_VS + sl, wsc, slope2, t, j * 64, 256, true, lane);
      if (i + 1 < nj) kv_store(lds + L_KS + (sl ^ 8192), lds + L_VS + (sl ^ 8192), kr, wid, lane);
      __syncthreads();
    }
    const float lt = l + __shfl_xor(l, 32);
    scale_rows(o, gnp[2] / lt, wsc, r32, hi);
    LAS const float* p = (LAS const float*)(lds + L_OACC) + wid * 2048 + lane;
    bf16_t* op = OAB + (tokb + t0 + 32 * qh) * 1024 + 512 + head * 64 + r32;
#pragma unroll
    for (int r = 0; r < 16; ++r) { const int q = crow(r, hi); op[(size_t)q * 1024] = f2bf(o[0][r] + p[r * 64]); op[(size_t)q * 1024 + 32] = f2bf(o[1][r] + p[1024 + r * 64]); }
  }
  __syncthreads();
}
__device__ __forceinline__ void nsa_phase(LAS unsigned char* lds, const bf16_t* QA, const bf16_t* KC, const bf16_t* VC, const bf16_t* KVS, const bf16_t* KVW, const float* GN, bf16_t* OAB) {
#pragma unroll 1
  for (int pr = blockIdx.x; pr < 256; pr += gridDim.x) {
    const int bh = pr >> 4, s = pr & 15;
#pragma unroll 1
    for (int i = 0; i < 2; ++i) nsa_unit(lds, bh >> 1, bh & 1, i == 0 ? 31 - s : s, QA, KC, VC, KVS, KVW, GN, OAB);
  }
}
}


namespace wg {
using att::f32x16; using att::bf16x8; using att::crow;
typedef short s16x4 __attribute__((ext_vector_type(4)));
template <int NI, int UNR>
__device__ __forceinline__ void wave_gemm(f32x16 (&acc)[NI], const bf16_t* wl, int ldw, const bf16_t* xl, int ksteps) {
  for (int ks = 0; ks < ksteps; ks += UNR) {
    bf16x8 a[UNR][NI], b[UNR];
#pragma unroll
    for (int u = 0; u < UNR; ++u) { b[u] = *(const GAS bf16x8*)(xl + (ks + u) * 16);
#pragma unroll
      for (int i = 0; i < NI; ++i) a[u][i] = *(const GAS bf16x8*)(wl + (size_t)i * 32 * ldw + (ks + u) * 16); }
#pragma unroll
    for (int u = 0; u < UNR; ++u)
#pragma unroll
      for (int i = 0; i < NI; ++i) acc[i] = __builtin_amdgcn_mfma_f32_32x32x16_bf16(a[u][i], b[u], acc[i], 0, 0, 0);
  }
}
constexpr int L_RED = 0;
__device__ __forceinline__ void cmp_unit(LAS unsigned char* lds, int sel, int rt, const bf16_t* __restrict__ KVC, const bf16_t* __restrict__ W1T, const float* __restrict__ bias1,
                                         const bf16_t* __restrict__ W2T, bf16_t* __restrict__ KCout) {
  const int tid = tid_fresh(), lane = tid & 63, wid = __builtin_amdgcn_readfirstlane(tid >> 6), r32 = lane & 31, hi = lane >> 5;
  int m = rt * 32 + r32; if (m > 2031) m = 2031;
  const int hh = m & 1, bc = m >> 1, b = bc / 127, c = bc - b * 127;
  const bf16_t* xl = KVC + ((size_t)b * S + 16 * c) * 256 + sel * 128 + hh * 64 + 8 * hi;
  const bf16_t* wl = W1T + (size_t)(32 * wid + r32) * 2048 + 8 * hi;
  const f32x16 z = {0.f, 0.f, 0.f, 0.f, 0.f, 0.f, 0.f, 0.f, 0.f, 0.f, 0.f, 0.f, 0.f, 0.f, 0.f, 0.f};
  f32x16 acc = z;
#pragma unroll 1
  for (int i = 0; i < 32; i += 2) {
    bf16x8 a[8], bb[8];
#pragma unroll
    for (int u = 0; u < 8; ++u) { bb[u] = *(const GAS bf16x8*)(xl + (size_t)(i + (u >> 2)) * 256 + (u & 3) * 16); a[u] = *(const GAS bf16x8*)(wl + (i + (u >> 2)) * 64 + (u & 3) * 16); }
#pragma unroll
    for (int u = 0; u < 8; ++u) acc = __builtin_amdgcn_mfma_f32_32x32x16_bf16(a[u], bb[u], acc, 0, 0, 0);
  }
  unsigned pw[8];
#pragma unroll
  for (int r = 0; r < 16; r += 2) {
    float v0 = acc[r] + bias1[32 * wid + crow(r, hi)], v1 = acc[r + 1] + bias1[32 * wid + crow(r + 1, hi)];
    v0 = v0 * __builtin_amdgcn_rcpf(1.f + __expf(-v0)); v1 = v1 * __builtin_amdgcn_rcpf(1.f + __expf(-v1));
    pw[r >> 1] = att::cvtpk(v0, v1);
  }
  const att::u32x4 q0 = {pw[0], pw[1], pw[2], pw[3]}, q1 = {pw[4], pw[5], pw[6], pw[7]};
  const bf16x8 pb0 = __builtin_bit_cast(bf16x8, q0), pb1 = __builtin_bit_cast(bf16x8, q1);
  f32x16 y[2]; y[0] = z; y[1] = z;
#pragma unroll
  for (int db = 0; db < 2; ++db)
#pragma unroll
    for (int s = 0; s < 2; ++s) {
      const bf16_t* wp = W2T + (size_t)(32 * db + r32) * 256 + 32 * wid + 16 * s + 4 * hi;
      const s16x4 lo = *(const GAS s16x4*)wp, hh2 = *(const GAS s16x4*)(wp + 8);
      const bf16x8 af = {lo[0], lo[1], lo[2], lo[3], hh2[0], hh2[1], hh2[2], hh2[3]};
      y[db] = __builtin_amdgcn_mfma_f32_32x32x16_bf16(af, s == 0 ? pb0 : pb1, y[db], 0, 0, 0);
    }
  LAS float* red = (LAS float*)(lds + L_RED);
#pragma unroll
  for (int r = 0; r < 16; ++r) { red[wid * 2048 + r * 64 + lane] = y[0][r]; red[wid * 2048 + 1024 + r * 64 + lane] = y[1][r]; }
  __syncthreads();
#pragma unroll
  for (int i = 0; i < 4; ++i) {
    const int e = tid + 512 * i; float sum = 0.f;
#pragma unroll
    for (int w = 0; w < 8; ++w) sum += red[w * 2048 + e];
    const int db = e >> 10, r = (e >> 6) & 15, ln = e & 63, d = 32 * db + crow(r, ln >> 5), mm = rt * 32 + (ln & 31);
    if (mm < 2032) { const int h2 = mm & 1, bc2 = mm >> 1, b2 = bc2 / 127, c2 = bc2 - b2 * 127; KCout[(((size_t)b2 * 128 + c2) * 2 + h2) * 64 + d] = f2bf(sum); }
  }
  __syncthreads();
}
__device__ __forceinline__ void cmp_bias_job(LAS unsigned char* lds, int jb, const float* __restrict__ pos, const float* __restrict__ w1, float* __restrict__ bias1) {
  const int tid = tid_fresh(), n = tid & 63, kp = tid >> 6, nc = jb & 3;
  float s = 0.f;
  for (int k = 256 * kp; k < 256 * kp + 256; ++k) s += pos[k] * w1[(size_t)k * 256 + 64 * nc + n];
  LAS float* part = (LAS float*)lds;
  part[kp * 64 + n] = s;
  __syncthreads();
  if (tid < 64) { float t = 0.f;
#pragma unroll
    for (int q = 0; q < 8; ++q) t += part[q * 64 + tid];
    bias1[64 * nc + tid] = t; }
  __syncthreads();
}
__device__ __forceinline__ void gn_rows(int row0, const bf16_t* __restrict__ XN, const bf16_t* __restrict__ WgnT, float* __restrict__ GN) {
  const int tid = tid_fresh(), lane = tid & 63, wid = __builtin_amdgcn_readfirstlane(tid >> 6), r32 = lane & 31, hi = lane >> 5;
  if (wid < 2) {
    const int row = row0 + 32 * wid + r32;
    f32x16 acc[1]; acc[0] = (f32x16){0.f, 0.f, 0.f, 0.f, 0.f, 0.f, 0.f, 0.f, 0.f, 0.f, 0.f, 0.f, 0.f, 0.f, 0.f, 0.f};
    wave_gemm<1, 8>(acc, WgnT + (size_t)r32 * 1024 + 8 * hi, 1024, XN + (size_t)row * 1024 + 8 * hi, 64);
#pragma unroll
    for (int r = 0; r < 16; ++r) { const int col = crow(r, hi); if (col < 24) GN[(size_t)row * 32 + col] = 1.f / (1.f + __expf(-acc[0][r])); }
  }
}
}

__device__ __forceinline__ void ph_prep_xn(const float* __restrict__ x, const float* __restrict__ g, bf16_t* __restrict__ xn) {
  const int tid_ = tid_fresh(), lane = tid_ & 63, wave = (blockIdx.x * 512 + tid_) >> 6, nw = (gridDim.x * 512) >> 6;
  for (int r = wave; r < NTOK; r += nw) {
    const float4* xr = (const float4*)(x + (size_t)r * D);
    float4 v[4]; float s = 0.f;
#pragma unroll
    for (int j = 0; j < 4; ++j) { v[j] = xr[lane + 64 * j]; s += v[j].x * v[j].x + v[j].y * v[j].y + v[j].z * v[j].z + v[j].w * v[j].w; }
    s = wave_sum(s);
    const float rstd = rsqrtf(s * (1.f / D) + 1e-6f);
#pragma unroll
    for (int j = 0; j < 4; ++j) {
      const float4 gg = ((const float4*)g)[lane + 64 * j];
      ushort4 o; o.x = f2bf(v[j].x * rstd * gg.x); o.y = f2bf(v[j].y * rstd * gg.y); o.z = f2bf(v[j].z * rstd * gg.z); o.w = f2bf(v[j].w * rstd * gg.w);
      ((ushort4*)(xn + (size_t)r * D))[lane + 64 * j] = o;
    }
  }
}

template <class AL, class BL, class EP>
__device__ __forceinline__ void naive_gemm_phase(unsigned char* lds, const AL al, const BL bl, const EP ep, int K, int ntm, int ntn) {
  const int tid_ = tid_fresh(), half = tid_ >> 8, tid = tid_ & 255, tx = tid & 15, ty = tid >> 4;
  float (*As)[68] = (float (*)[68])(lds + half * 8704);
  float (*Bs)[68] = As + 16;
  const int ntiles = ntm * ntn;
  for (int it0 = blockIdx.x * 2; it0 < ntiles; it0 += 2 * gridDim.x) {
    const int it = it0 + half, tm = it / ntn, tn = it - tm * ntn, m0 = tm * 64, n0 = tn * 64;
    const bool act = it < ntiles && al.active(m0);
    float acc[4][4];
#pragma unroll
    for (int i = 0; i < 4; ++i)
#pragma unroll
      for (int j = 0; j < 4; ++j) acc[i][j] = 0.f;
    for (int k0 = 0; k0 < K; k0 += 16) {
#pragma unroll
      for (int i = 0; i < 4; ++i) { const int e = tid + i * 256, r = e >> 4, kk = e & 15; As[kk][r] = act ? al(m0 + r, k0 + kk) : 0.f; }
#pragma unroll
      for (int i = 0; i < 4; ++i) { const int e = tid + i * 256, kk = e >> 6, c = e & 63; Bs[kk][c] = act ? bl(m0, k0 + kk, n0 + c) : 0.f; }
      __syncthreads();
#pragma unroll
      for (int kk = 0; kk < 16; ++kk) {
        const float4 a = *(const float4*)&As[kk][ty * 4];
        const float4 b = *(const float4*)&Bs[kk][tx * 4];
        const float av[4] = {a.x, a.y, a.z, a.w}, bv[4] = {b.x, b.y, b.z, b.w};
#pragma unroll
        for (int i = 0; i < 4; ++i)
#pragma unroll
          for (int j = 0; j < 4; ++j) acc[i][j] += av[i] * bv[j];
      }
      __syncthreads();
    }
    if (act) {
#pragma unroll
      for (int i = 0; i < 4; ++i)
#pragma unroll
        for (int j = 0; j < 4; ++j) ep(m0 + ty * 4 + i, n0 + tx * 4 + j, acc[i][j]);
    }
  }
}

struct AL_bf16 { const bf16_t* A; int lda, M; __device__ bool active(int) const { return true; } __device__ float operator()(int m, int k) const { return m < M ? bf2f(A[(size_t)m * lda + k]) : 0.f; } };
struct AL_f32 { const float* A; int lda, M; __device__ bool active(int) const { return true; } __device__ float operator()(int m, int k) const { return m < M ? A[(size_t)m * lda + k] : 0.f; } };
struct BL_f32 { const float* B; int ldb, N; __device__ float operator()(int, int k, int n) const { return n < N ? B[(size_t)k * ldb + n] : 0.f; } };
struct EP_proj {
  bf16_t *QA, *QB, *KVC, *KVS, *KVW, *KVB, *GM; float* GN;
  __device__ void operator()(int m, int c, float v) const {
    if (c >= INW) return;
    if (c < 512) QA[(size_t)m * 512 + c] = f2bf(v);
    else if (c < 768) KVC[(size_t)m * 256 + (c - 512)] = f2bf(v);
    else if (c < 1024) KVS[(size_t)m * 256 + (c - 768)] = f2bf(v);
    else if (c < 1280) KVW[(size_t)m * 256 + (c - 1024)] = f2bf(v);
    else if (c < 1304) GN[(size_t)m * 32 + (c - 1280)] = sigmoidf_(v);
    else if (c < 1816) QB[(size_t)m * 512 + (c - 1304)] = f2bf(v);
    else if (c < 2072) KVB[(size_t)m * 256 + (c - 1816)] = f2bf(v);
    else GM[(size_t)m * 2048 + (c - 2072)] = f2bf(sigmoidf_(v));
  }
};
struct AL_cmp { const bf16_t* KVC; const float* pos; int sel; __device__ bool active(int) const { return true; }
  __device__ float operator()(int m, int k) const { if (m >= 2032) return 0.f; const int h = m & 1, bc = m >> 1, b = bc / 127, c = bc % 127, i = k >> 6, d = k & 63;
    return bf2f(KVC[((size_t)b * S + 16 * c + i) * 256 + sel * 128 + h * 64 + d]) + pos[k]; } };
struct EP_silu { float* T; int M, N; __device__ void operator()(int m, int n, float v) const { if (m < M && n < N) T[(size_t)m * N + n] = v / (1.f + __expf(-v)); } };
struct EP_kc { bf16_t* KC; __device__ void operator()(int m, int n, float v) const { if (m >= 2032 || n >= 64) return; const int h = m & 1, bc = m >> 1, b = bc / 127, c = bc % 127; KC[(((size_t)b * 128 + c) * 2 + h) * 64 + n] = f2bf(v); } };
struct EP_mg1 { float* tmp; const bf16_t* GM; __device__ void operator()(int m, int n, float v) const { tmp[(size_t)m * 1024 + n] = bf2f(GM[(size_t)m * 2048 + n]) * v; } };
struct EP_mg2 { const float* tmp; const bf16_t* GM; bf16_t* MG; __device__ void operator()(int m, int n, float v) const { MG[(size_t)m * 1024 + n] = f2bf(tmp[(size_t)m * 1024 + n] + bf2f(GM[(size_t)m * 2048 + 1024 + n]) * v); } };
struct EP_x1 { const float* x; float* out; __device__ void operator()(int m, int n, float v) const { out[(size_t)m * 1024 + n] = x[(size_t)m * 1024 + n] + v; } };
struct AL_moe { const bf16_t* H2; const int* list; const int* cnt; const int* l_off; const int* l_te; __device__ bool active(int m0) const { return l_te[m0 >> 8] >= 0; }
  __device__ float operator()(int m, int k) const { const int e = l_te[m >> 8], r = m - l_off[e]; if (r >= cnt[e]) return 0.f; const int t = list[(size_t)e * NTOK + r]; return bf2f(H2[(size_t)t * 1024 + k]); } };
struct BL_moe { const float* W; const int* l_te; int K, N; __device__ float operator()(int m0, int k, int n) const { const int e = l_te[m0 >> 8]; return W[((size_t)e * K + k) * N + n]; } };
struct EP_g { float* G; __device__ void operator()(int m, int n, float v) const { G[(size_t)m * 256 + n] = v; } };
struct EP_hb { const float* G; bf16_t* HB; __device__ void operator()(int m, int n, float v) const { const float g = G[(size_t)m * 256 + n]; HB[(size_t)m * 256 + n] = f2bf(g / (1.f + __expf(-g)) * v); } };
struct AL_hb { const bf16_t* HB; const int* l_te; __device__ bool active(int m0) const { return l_te[m0 >> 8] >= 0; } __device__ float operator()(int m, int k) const { return bf2f(HB[(size_t)m * 256 + k]); } };
struct EP_ys { bf16_t* YS; __device__ void operator()(int m, int n, float v) const { YS[(size_t)m * 1024 + n] = f2bf(v); } };

__device__ __forceinline__ void moe_tables(const int* cnt, int* l_off, int* l_te) {
  __syncthreads();
  if (threadIdx.x == 0) {
    int off = 0;
    for (int e = 0; e < 32; ++e) { l_off[e] = off; const int c = __hip_atomic_load(cnt + e, __ATOMIC_RELAXED, __HIP_MEMORY_SCOPE_AGENT); const int nt = (c + 255) >> 8; for (int i = 0; i < nt; ++i) l_te[(off >> 8) + i] = e; off += nt << 8; }
    l_off[32] = off;
    for (int i = off >> 8; i < NSLOT / 256; ++i) l_te[i] = -1;
  }
  __syncthreads();
}

__device__ __forceinline__ void naive_nsa_phase(unsigned char* lds, const bf16_t* __restrict__ QA, const bf16_t* __restrict__ KC, const bf16_t* __restrict__ VC, const bf16_t* __restrict__ KVS,
                                                const bf16_t* __restrict__ KVW, const float* __restrict__ GN, bf16_t* __restrict__ OA) {
  const int tid_ = tid_fresh(), half = tid_ >> 8, tid = tid_ & 255, g = tid >> 6, lane = tid & 63;
  unsigned char* base = lds + half * 12288;
  float (*q)[64] = (float (*)[64])base;
  float (*pc)[128] = (float (*)[128])(base + 1024);
  float (*sc)[512] = (float (*)[512])(base + 3072);
  float* sscore = (float*)(base + 11264);
  int* sel_idx = (int*)(base + 11264 + 128);
  int* sel_valid = (int*)(base + 11264 + 160);
  for (int item = blockIdx.x * 2 + half; item < NB * 2 * S; item += 2 * gridDim.x) {
    const int t = item & 2047, hkv = (item >> 11) & 1, b = item >> 12, head = hkv * 4 + g;
    const float slope = exp2f(-0.5f * (float)(9 + head));
    const size_t row = (size_t)b * S + t;
    q[g][lane] = bf2f(QA[row * 512 + head * 64 + lane]) * 0.125f;
    __syncthreads();
    {
      float sv[2]; bool vv[2]; float m = -1e30f;
#pragma unroll
      for (int i = 0; i < 2; ++i) {
        const int c = lane + 64 * i, dist = t - (16 * c + 31); vv[i] = (c < 127) && dist >= 0; float s = 0.f;
        if (vv[i]) { const bf16_t* kr = KC + (((size_t)b * 128 + c) * 2 + hkv) * 64; for (int d = 0; d < 64; ++d) s += q[g][d] * bf2f(kr[d]); s -= slope * (float)dist; m = fmaxf(m, s); }
        sv[i] = s;
      }
      m = wave_max(m);
      float z = 0.f;
#pragma unroll
      for (int i = 0; i < 2; ++i) { sv[i] = vv[i] ? __expf(sv[i] - m) : 0.f; z += sv[i]; }
      z = wave_sum(z);
      const float inv = z > 0.f ? 1.f / z : 1.f;
#pragma unroll
      for (int i = 0; i < 2; ++i) pc[g][lane + 64 * i] = sv[i] * inv;
    }
    __syncthreads();
    float ocmp = 0.f;
    {
      int ncv = (t >= 31) ? (t - 31) / 16 + 1 : 0; if (ncv > 127) ncv = 127;
      for (int c = 0; c < ncv; ++c) ocmp += pc[g][c] * bf2f(VC[(((size_t)b * 128 + c) * 2 + hkv) * 64 + lane]);
    }
    if (tid < 32) {
      const int j = tid;
      float ps[5];
#pragma unroll
      for (int u = 0; u < 5; ++u) { const int c = 4 * j - 1 + u; ps[u] = (c >= 0 && c < 127) ? (pc[0][c] + pc[1][c] + pc[2][c] + pc[3][c]) : 0.f; }
      const float imp = 0.5f * ps[0] + ps[1] + ps[2] + ps[3] + 0.5f * ps[4];
      const int cur = t >> 6; const bool forced = (j == 0) || (j == cur) || (j == cur - 1), valid = j <= cur;
      sscore[j] = forced ? 1e9f : (valid ? imp : -1e30f);
    }
    __syncthreads();
    if (tid < 32) {
      const int j = tid; const float sj = sscore[j]; int rank = 0;
      for (int i = 0; i < 32; ++i) { const float si = sscore[i]; rank += ((si > sj) || (si == sj && i < j)) ? 1 : 0; }
      if (rank < 8) { sel_idx[rank] = j; sel_valid[rank] = sj > -5e29f ? 1 : 0; }
    }
    __syncthreads();
    float oslc = 0.f;
    {
      float s8[8]; float m = -1e30f;
#pragma unroll
      for (int i = 0; i < 8; ++i) {
        const int kpos = sel_idx[i] * 64 + lane; const bool ok = sel_valid[i] && kpos <= t; float s = -1e30f;
        if (ok) { const bf16_t* kr = KVS + ((size_t)b * S + kpos) * 256 + hkv * 64; s = 0.f; for (int d = 0; d < 64; ++d) s += q[g][d] * bf2f(kr[d]); s -= slope * (float)(t - kpos); m = fmaxf(m, s); }
        s8[i] = s;
      }
      m = wave_max(m);
      float z = 0.f;
#pragma unroll
      for (int i = 0; i < 8; ++i) { const float p = s8[i] > -5e29f ? __expf(s8[i] - m) : 0.f; sc[g][i * 64 + lane] = p; z += p; }
      z = wave_sum(z);
      __syncthreads();
      for (int i = 0; i < 8; ++i) {
        if (!sel_valid[i]) continue;
        const int k0 = sel_idx[i] * 64;
        for (int l = 0; l < 64; ++l) { const int kpos = k0 + l; if (kpos > t) break; oslc += sc[g][i * 64 + l] * bf2f(KVS[((size_t)b * S + kpos) * 256 + 128 + hkv * 64 + lane]); }
      }
      oslc *= (z > 0.f ? 1.f / z : 1.f);
      __syncthreads();
    }
    float owin = 0.f;
    {
      float s4[4]; float m = -1e30f;
#pragma unroll
      for (int i = 0; i < 4; ++i) {
        const int dist = lane + 64 * i, kpos = t - dist; float s = -1e30f;
        if (kpos >= 0) { const bf16_t* kr = KVW + ((size_t)b * S + kpos) * 256 + hkv * 64; s = 0.f; for (int d = 0; d < 64; ++d) s += q[g][d] * bf2f(kr[d]); s -= slope * (float)dist; m = fmaxf(m, s); }
        s4[i] = s;
      }
      m = wave_max(m);
      float z = 0.f;
#pragma unroll
      for (int i = 0; i < 4; ++i) { const float p = s4[i] > -5e29f ? __expf(s4[i] - m) : 0.f; sc[g][i * 64 + lane] = p; z += p; }
      z = wave_sum(z);
      __syncthreads();
      for (int dist = 0; dist < 256; ++dist) { const int kpos = t - dist; if (kpos < 0) break; owin += sc[g][dist] * bf2f(KVW[((size_t)b * S + kpos) * 256 + 128 + hkv * 64 + lane]); }
      owin /= z;
    }
    const float* gn = GN + row * 32 + hkv * 12 + g * 3;
    OA[row * 1024 + 512 + head * 64 + lane] = f2bf(gn[0] * ocmp + gn[1] * oslc + gn[2] * owin);
    __syncthreads();
  }
}

__device__ __forceinline__ void naive_swa_phase(unsigned char* lds, const bf16_t* __restrict__ QB, const bf16_t* __restrict__ KVB, const float* __restrict__ sinks, bf16_t* __restrict__ OB) {
  const int tid_ = tid_fresh(), half = tid_ >> 8, tid = tid_ & 255, g = tid >> 6, lane = tid & 63;
  unsigned char* base = lds + half * 4096;
  float (*q)[64] = (float (*)[64])base;
  float (*sc)[128] = (float (*)[128])(base + 1024);
  for (int item = blockIdx.x * 2 + half; item < NB * 2 * S; item += 2 * gridDim.x) {
    const int t = item & 2047, hkv = (item >> 11) & 1, b = item >> 12, head = hkv * 4 + g;
    const float slope = exp2f(-0.5f * (float)(1 + head));
    const float sink = sinks[head];
    const size_t row = (size_t)b * S + t;
    q[g][lane] = bf2f(QB[row * 512 + head * 64 + lane]) * 0.125f;
    __syncthreads();
    float s2[2]; float m = sink;
#pragma unroll
    for (int i = 0; i < 2; ++i) {
      const int dist = lane + 64 * i, kpos = t - dist; float s = -1e30f;
      if (kpos >= 0) { const bf16_t* kr = KVB + ((size_t)b * S + kpos) * 256 + hkv * 64; s = 0.f; for (int d = 0; d < 64; ++d) s += q[g][d] * bf2f(kr[d]); s -= slope * (float)dist; m = fmaxf(m, s); }
      s2[i] = s;
    }
    m = wave_max(m);
    float z = 0.f;
#pragma unroll
    for (int i = 0; i < 2; ++i) { const float p = s2[i] > -5e29f ? __expf(s2[i] - m) : 0.f; sc[g][i * 64 + lane] = p; z += p; }
    z = wave_sum(z) + __expf(sink - m);
    __syncthreads();
    float o = 0.f;
    for (int dist = 0; dist < 128; ++dist) { const int kpos = t - dist; if (kpos < 0) break; o += sc[g][dist] * bf2f(KVB[((size_t)b * S + kpos) * 256 + 128 + hkv * 64 + lane]); }
    OB[row * 1024 + head * 64 + lane] = f2bf(o / z);
    __syncthreads();
  }
}

__device__ __forceinline__ void ph_router(unsigned char* lds, const float* __restrict__ x1, const float* __restrict__ gf, const float* __restrict__ wg, const float* __restrict__ bg, const float* __restrict__ we,
                                          const float* __restrict__ be, bf16_t* __restrict__ H2, bf16_t* __restrict__ H2LO, int* __restrict__ cnt, int* __restrict__ sm, int* __restrict__ list) {
  const int tid_ = tid_fresh(), lane = tid_ & 63, wl = tid_ >> 6, wave = (blockIdx.x * 512 + tid_) >> 6, nw = (gridDim.x * 512) >> 6;
  float* hs = (float*)lds + wl * 1024;
  float* lgs = (float*)(lds + 32768) + wl * 64;
  for (int r = wave; r < NTOK; r += nw) {
    const float4* xr = (const float4*)(x1 + (size_t)r * D);
    float4 v[4]; float s = 0.f;
#pragma unroll
    for (int j = 0; j < 4; ++j) { v[j] = xr[lane + 64 * j]; s += v[j].x * v[j].x + v[j].y * v[j].y + v[j].z * v[j].z + v[j].w * v[j].w; }
    s = wave_sum(s);
    const float rstd = rsqrtf(s * (1.f / D) + 1e-6f);
#pragma unroll
    for (int j = 0; j < 4; ++j) {
      const float4 gg = ((const float4*)gf)[lane + 64 * j];
      float4 h; h.x = v[j].x * rstd * gg.x; h.y = v[j].y * rstd * gg.y; h.z = v[j].z * rstd * gg.z; h.w = v[j].w * rstd * gg.w;
      ushort4 hi, lo;
      hi.x = f2bf(h.x); hi.y = f2bf(h.y); hi.z = f2bf(h.z); hi.w = f2bf(h.w);
      lo.x = f2bf(h.x - bf2f(hi.x)); lo.y = f2bf(h.y - bf2f(hi.y)); lo.z = f2bf(h.z - bf2f(hi.z)); lo.w = f2bf(h.w - bf2f(hi.w));
      ((ushort4*)(H2 + (size_t)r * D))[lane + 64 * j] = hi;
      ((ushort4*)(H2LO + (size_t)r * D))[lane + 64 * j] = lo;
      ((float4*)hs)[lane + 64 * j] = h;
    }
    __builtin_amdgcn_wave_barrier();
    asm volatile("s_waitcnt lgkmcnt(0)" ::: "memory");
    float acc = 0.f;
    if (lane < 36) {
      const float* wp = lane < 4 ? (wg + lane) : (we + (lane - 4));
      const int ld = lane < 4 ? 4 : 32;
      for (int k = 0; k < 1024; ++k) acc += hs[k] * wp[(size_t)k * ld];
      acc += lane < 4 ? bg[lane] : be[lane - 4];
    }
    lgs[lane] = acc;
    asm volatile("s_waitcnt lgkmcnt(0)" ::: "memory");
    __builtin_amdgcn_wave_barrier();
    if (lane == 0) {
      int grp = 0; float gmax = -1e30f;
      for (int j = 0; j < 4; ++j) { const float gl = lgs[j]; if (gl > gmax) { gmax = gl; grp = j; } }
      float zs = 0.f;
      for (int j = 0; j < 4; ++j) zs += __expf(lgs[j] - gmax);
      const float pgrp = 1.f / zs;
      int i1 = 0; float v1 = -1e30f;
      for (int i = 0; i < 8; ++i) { const float e = lgs[4 + grp * 8 + i]; if (e > v1) { v1 = e; i1 = i; } }
      int i2 = 0; float v2 = -1e30f;
      for (int i = 0; i < 8; ++i) { const float e = lgs[4 + grp * 8 + i]; if (i != i1 && e > v2) { v2 = e; i2 = i; } }
      const float e2 = __expf(v2 - v1), w1 = 1.f / (1.f + e2), w2 = e2 * w1;
      const int e_a = grp * 8 + i1, e_b = grp * 8 + i2;
      const int ra = atomicAdd(&cnt[e_a], 1), rb = atomicAdd(&cnt[e_b], 1);
      sm[SM_EID + 2 * r] = e_a; sm[SM_EID + 2 * r + 1] = e_b;
      ((float*)sm)[SM_WT + 2 * r] = pgrp * w1; ((float*)sm)[SM_WT + 2 * r + 1] = pgrp * w2;
      sm[SM_RANK + 2 * r] = ra; sm[SM_RANK + 2 * r + 1] = rb;
      list[(size_t)e_a * NTOK + ra] = r; list[(size_t)e_b * NTOK + rb] = r;
    }
    asm volatile("s_waitcnt lgkmcnt(0)" ::: "memory");
    __builtin_amdgcn_wave_barrier();
  }
}
__device__ __forceinline__ void ph_final(float* __restrict__ out, const bf16_t* __restrict__ YS, const int* __restrict__ sm, const int* l_off, const float* __restrict__ gfin) {
  const int tid_ = tid_fresh(), lane = tid_ & 63, wave = (blockIdx.x * 512 + tid_) >> 6, nw = (gridDim.x * 512) >> 6;
  for (int r = wave; r < NTOK; r += nw) {
    const int s0 = l_off[sm[SM_EID + 2 * r]] + sm[SM_RANK + 2 * r], s1 = l_off[sm[SM_EID + 2 * r + 1]] + sm[SM_RANK + 2 * r + 1];
    const float w0 = ((const float*)sm)[SM_WT + 2 * r], w1 = ((const float*)sm)[SM_WT + 2 * r + 1];
    float4* xr = (float4*)(out + (size_t)r * D);
    float4 v[4]; float s = 0.f;
#pragma unroll
    for (int j = 0; j < 4; ++j) {
      v[j] = xr[lane + 64 * j];
      const ushort4 a = ((const ushort4*)(YS + (size_t)s0 * D))[lane + 64 * j], c = ((const ushort4*)(YS + (size_t)s1 * D))[lane + 64 * j];
      v[j].x += w0 * bf2f(a.x) + w1 * bf2f(c.x); v[j].y += w0 * bf2f(a.y) + w1 * bf2f(c.y); v[j].z += w0 * bf2f(a.z) + w1 * bf2f(c.z); v[j].w += w0 * bf2f(a.w) + w1 * bf2f(c.w);
      s += v[j].x * v[j].x + v[j].y * v[j].y + v[j].z * v[j].z + v[j].w * v[j].w;
    }
    s = wave_sum(s);
    const float rstd = rsqrtf(s * (1.f / D) + 1e-6f);
#pragma unroll
    for (int j = 0; j < 4; ++j) { const float4 gg = ((const float4*)gfin)[lane + 64 * j]; float4 o; o.x = v[j].x * rstd * gg.x; o.y = v[j].y * rstd * gg.y; o.z = v[j].z * rstd * gg.z; o.w = v[j].w * rstd * gg.w; xr[lane + 64 * j] = o; }
  }
}


struct WPtrs { const float *w_in, *w1k, *w2k, *w1v, *w2v, *w_a, *w_b, *w_o, *w_group, *w_expert, *w_gate, *w_up, *w_down;
               bf16_t *WinT, *WgnT, *W1kT, *W1vT, *W2kT, *W2vT, *WabT, *WoT, *WguT, *WdT, *WrtHi, *WrtLo; };
__device__ __forceinline__ void ph_weights(LAS unsigned char* lds, const WPtrs& w) {
  const int tid_ = tid_fresh(), lane = tid_ & 63, wl = __builtin_amdgcn_readfirstlane(tid_ >> 6);
  const int gw = blockIdx.x * 8 + wl, NGW = gridDim.x * 8;
  LAS float* scr = (LAS float*)(lds + wl * 16384);
  constexpr int I_IN = 2048, I_GN = 16, I_W1 = 256, I_W2 = 8, I_AB = 256, I_O = 512, I_GU = 4096, I_D = 4096;
  constexpr int NITEMS = I_IN + I_GN + 2 * I_W1 + 2 * I_W2 + 2 * I_AB + I_O + 2 * I_GU + I_D;
  for (int it = gw; it < NITEMS; it += NGW) {
    int r = it;
    if (r < I_IN) { const int rb = r >> 4, kb = r & 15, n0 = rb * 32; tr_item(w.w_in, INW, n0 + (n0 >= 1280 ? 24 : 0), 32, kb * 64, w.WinT, 1024, n0, 0, scr, lane); continue; } r -= I_IN;
    if (r < I_GN) { tr_item(w.w_in, INW, 1280, 24, r * 64, w.WgnT, 1024, 0, 0, scr, lane); continue; } r -= I_GN;
    if (r < I_W1) { const int rb = r >> 5, kb = r & 31; tr_item(w.w1k, 256, rb * 32, 32, kb * 64, w.W1kT, 2048, rb * 32, 0, scr, lane); continue; } r -= I_W1;
    if (r < I_W1) { const int rb = r >> 5, kb = r & 31; tr_item(w.w1v, 256, rb * 32, 32, kb * 64, w.W1vT, 2048, rb * 32, 0, scr, lane); continue; } r -= I_W1;
    if (r < I_W2) { const int rb = r >> 2, kb = r & 3; tr_item(w.w2k, 64, rb * 32, 32, kb * 64, w.W2kT, 256, rb * 32, 0, scr, lane); continue; } r -= I_W2;
    if (r < I_W2) { const int rb = r >> 2, kb = r & 3; tr_item(w.w2v, 64, rb * 32, 32, kb * 64, w.W2vT, 256, rb * 32, 0, scr, lane); continue; } r -= I_W2;
    if (r < I_AB) { const int rb = r >> 3, kb = r & 7; tr_item(w.w_b, 1024, rb * 32, 32, kb * 64, w.WabT, 1024, rb * 32, 0, scr, lane); continue; } r -= I_AB;
    if (r < I_AB) { const int rb = r >> 3, kb = r & 7; tr_item(w.w_a, 1024, rb * 32, 32, kb * 64, w.WabT, 1024, rb * 32, 512, scr, lane); continue; } r -= I_AB;
    if (r < I_O) { const int rb = r >> 4, kb = r & 15; tr_item(w.w_o, 1024, rb * 32, 32, kb * 64, w.WoT, 1024, rb * 32, 0, scr, lane); continue; } r -= I_O;
    if (r < I_GU) { const int e = r >> 7, q = r & 127, cb = q >> 4, kb = q & 15, c0 = cb * 32; tr_item(w.w_gate + (size_t)e * 1024 * 256, 256, c0, 32, kb * 64, w.WguT + (size_t)e * 512 * 1024, 1024, (c0 >> 7) * 256 + (c0 & 127), 0, scr, lane); continue; } r -= I_GU;
    if (r < I_GU) { const int e = r >> 7, q = r & 127, cb = q >> 4, kb = q & 15, c0 = cb * 32; tr_item(w.w_up + (size_t)e * 1024 * 256, 256, c0, 32, kb * 64, w.WguT + (size_t)e * 512 * 1024, 1024, (c0 >> 7) * 256 + 128 + (c0 & 127), 0, scr, lane); continue; } r -= I_GU;
    { const int e = r >> 7, q = r & 127, cb = q >> 2, kb = q & 3; tr_item(w.w_down + (size_t)e * 256 * 1024, 1024, cb * 32, 32, kb * 64, w.WdT + (size_t)e * 1024 * 256, 256, cb * 32, 0, scr, lane); }
  }
  for (int i = blockIdx.x * 512 + tid_; i < 64 * 1024; i += gridDim.x * 512) {
    const int j = i >> 10, k = i & 1023; const float v = j < 4 ? w.w_group[k * 4 + j] : (j < 36 ? w.w_expert[k * 32 + (j - 4)] : 0.f);
    const bf16_t hi = f2bf(v); w.WrtHi[i] = hi; w.WrtLo[i] = f2bf(v - bf2f(hi));
  }
}
struct BL_gn { const float* W; __device__ float operator()(int, int k, int n) const { return n < 24 ? W[(size_t)k * INW + 1280 + n] : 0.f; } };
struct EP_gn { float* GN; __device__ void operator()(int m, int n, float v) const { if (n < 24) GN[(size_t)m * 32 + n] = sigmoidf_(v); } };

struct Args { const float* in[22]; float* out; unsigned char* ws; };
constexpr int PTAB_OFF = 131072 + 4096;
#define PIN(i) ((const float*)ldptr(ptab, (i)))
#define POUT ((float*)ldptr(ptab, 22))
#define PWS ((unsigned char*)ldptr(ptab, 23))
#define WSB(off) ((bf16_t*)(ws + (off)))
__global__ void __launch_bounds__(512, 2) mega_fwd(Args a) {
  extern __shared__ __attribute__((aligned(16))) unsigned char lds[];
  LAS unsigned char* ldsl = (LAS unsigned char*)lds;
  LAS u64_t* ptab = (LAS u64_t*)(ldsl + PTAB_OFF);
  volatile LAS unsigned* MISC = (volatile LAS unsigned*)(ldsl + MISC_OFF);
  if (threadIdx.x == 0) {
#pragma unroll
    for (int i = 0; i < 22; ++i) ptab[i] = (u64_t)a.in[i];
    ptab[22] = (u64_t)a.out; ptab[23] = (u64_t)a.ws;
  }
  if (threadIdx.x < 32) MISC[threadIdx.x] = 0u;
  __syncthreads();
  XcdBarrier bar = xcd_barrier_post((unsigned*)PWS, MISC + 8);
  int* l_off = (int*)(lds + 131072 + 1024);
  int* l_te = (int*)(lds + 131072 + 1024 + 256);
#define GRID_BAR() do { bar.bar = (unsigned*)PWS; xcd_barrier(bar); } while (0)

  {
    unsigned char* ws = PWS;
    WPtrs w{PIN(2), PIN(4), PIN(5), PIN(7), PIN(8), PIN(10), PIN(11), PIN(12), PIN(14), PIN(16), PIN(18), PIN(19), PIN(20),
            WSB(WS_WINT), WSB(WS_WGNT), WSB(WS_W1KT), WSB(WS_W1VT), WSB(WS_W2KT), WSB(WS_W2VT), WSB(WS_WABT), WSB(WS_WOT), WSB(WS_WGUT), WSB(WS_WDT), WSB(WS_WRT_HI), WSB(WS_WRT_LO)};
    if (blockIdx.x < 8) { const int jb = blockIdx.x; wg::cmp_bias_job(ldsl, jb, jb < 4 ? PIN(3) : PIN(6), jb < 4 ? PIN(4) : PIN(7), (float*)(ws + WS_BIAS1) + (jb >> 2) * 256); }
    ph_weights(ldsl, w);
    ph_prep_xn(PIN(0), PIN(1), WSB(WS_XN));
  }
  GRID_BAR();
  {
    unsigned char* ws = PWS;
    pg8::SchedDense Sd; Sd.init(ws + WS_XN, 2048, ws + WS_WINT, NTOK, 4096, 1024, gridDim.x, blockIdx.x);
    pg8::EpiProj E{WSB(WS_QA), WSB(WS_QB), WSB(WS_KVC), WSB(WS_KVS), WSB(WS_KVW), WSB(WS_KVB), WSB(WS_GM)};
    pg8::gemm_phase<pg8::EpiProj, pg8::SchedDense, true>(ldsl, 1024, 128, Sd, E);
  }
  {
    unsigned char* ws = PWS;
    for (int c = blockIdx.x; c < NTOK / 64; c += gridDim.x) wg::gn_rows(64 * c, WSB(WS_XN), WSB(WS_WGNT), (float*)(ws + WS_GN));
  }
  GRID_BAR();
  {
    unsigned char* ws = PWS;
    if (gridDim.x == 256) {
      const int c = blockIdx.x;
      if (c < 128) {
        const int sel = c >> 6, rt = c & 63;
        wg::cmp_unit(ldsl, sel, rt, WSB(WS_KVC), WSB(sel ? WS_W1VT : WS_W1KT), (const float*)(ws + WS_BIAS1) + sel * 256, WSB(sel ? WS_W2VT : WS_W2KT), WSB(sel ? WS_VC : WS_KC));
        att::swa_unit(ldsl, c >> 6, (c >> 5) & 1, c & 31, WSB(WS_QB), WSB(WS_KVB), PIN(9), WSB(WS_OAB));
      } else {
#pragma unroll 1
        for (int i = 0; i < 3; ++i) { const int u = 128 + (c - 128) * 3 + i; att::swa_unit(ldsl, u >> 6, (u >> 5) & 1, u & 31, WSB(WS_QB), WSB(WS_KVB), PIN(9), WSB(WS_OAB)); }
      }
    } else {
#pragma unroll 1
      for (int c = blockIdx.x; c < 128; c += gridDim.x) { const int sel = c >> 6, rt = c & 63;
        wg::cmp_unit(ldsl, sel, rt, WSB(WS_KVC), WSB(sel ? WS_W1VT : WS_W1KT), (const float*)(ws + WS_BIAS1) + sel * 256, WSB(sel ? WS_W2VT : WS_W2KT), WSB(sel ? WS_VC : WS_KC)); }
      att::swa_phase(ldsl, WSB(WS_QB), WSB(WS_KVB), PIN(9), WSB(WS_OAB));
    }
  }
  GRID_BAR();
  {
    unsigned char* ws = PWS;
    att::nsa_phase(ldsl, WSB(WS_QA), WSB(WS_KC), WSB(WS_VC), WSB(WS_KVS), WSB(WS_KVW), (const float*)(ws + WS_GN), WSB(WS_OAB));
  }
  GRID_BAR();
  {
    unsigned char* ws = PWS;
    pg8::SchedDense Sd; Sd.init(ws + WS_OAB, 2048, ws + WS_WABT, NTOK, 1024, 1024, gridDim.x, blockIdx.x);
    pg8::EpiMerge E{WSB(WS_GM), WSB(WS_MG)};
    pg8::gemm_phase<pg8::EpiMerge, pg8::SchedDense, true>(ldsl, 1024, 128, Sd, E);
  }
  GRID_BAR();
  {
    unsigned char* ws = PWS;
    pg8::SchedDense Sd; Sd.init(ws + WS_MG, 2048, ws + WS_WOT, NTOK, 1024, 1024, gridDim.x, blockIdx.x);
    pg8::EpiX1 E{PIN(0), POUT};
    pg8::gemm_phase<pg8::EpiX1, pg8::SchedDense, true>(ldsl, 1024, 128, Sd, E);
  }
  GRID_BAR();
  {
    unsigned char* ws = PWS;
    ph_router(lds, POUT, PIN(13), PIN(14), PIN(15), PIN(16), PIN(17), WSB(WS_H2), WSB(WS_H2LO), (int*)(ws + WS_CTL) + CW_CNT, (int*)(ws + WS_SMALL), (int*)(ws + WS_LIST));
  }
  GRID_BAR();
  {
    unsigned char* ws = PWS;
    const int* cnt = (const int*)(ws + WS_CTL) + CW_CNT;
    moe_tables(cnt, l_off, l_te);
    pg8::SchedMoeUp Sm{(const char*)(ws + WS_H2), (const char*)(ws + WS_WGUT), (const int*)(ws + WS_LIST), cnt, l_off, l_te, (int)gridDim.x, (int)blockIdx.x};
    pg8::EpiHB E{WSB(WS_HB)};
    pg8::gemm_phase<pg8::EpiHB, pg8::SchedMoeUp, true>(ldsl, 1024, 128, Sm, E);
  }
  GRID_BAR();
  {
    unsigned char* ws = PWS;
    pg8::SchedMoeDown Sm{(const char*)(ws + WS_HB), (const char*)(ws + WS_WDT), l_off, l_te, (int)gridDim.x, (int)blockIdx.x};
    pg8::EpiYS E{WSB(WS_YS)};
    pg8::gemm_phase<pg8::EpiYS, pg8::SchedMoeDown, true>(ldsl, 256, 128, Sm, E);
  }
  GRID_BAR();
  {
    unsigned char* ws = PWS;
    ph_final(POUT, WSB(WS_YS), (const int*)(ws + WS_SMALL), l_off, PIN(21));
  }
}

extern "C" void kernel_launch(void* const* d_in, const int* in_sizes, int n_in, void* d_out, int out_size, void* d_ws, size_t ws_size, hipStream_t stream) {
  static int grid = 0;
  if (grid == 0) {
    int dev = 0, cus = 0, per_cu = 0;
    if (hipGetDevice(&dev) != hipSuccess || hipDeviceGetAttribute(&cus, hipDeviceAttributeMultiprocessorCount, dev) != hipSuccess) { fprintf(stderr, "kernel_launch: device query failed\n"); grid = -1; return; }
    if (hipFuncSetAttribute((const void*)mega_fwd, hipFuncAttributeMaxDynamicSharedMemorySize, LDS_BYTES) != hipSuccess) { fprintf(stderr, "kernel_launch: hipFuncSetAttribute failed\n"); grid = -1; return; }
    if (hipOccupancyMaxActiveBlocksPerMultiprocessor(&per_cu, (const void*)mega_fwd, 512, LDS_BYTES) != hipSuccess || per_cu < 1) { fprintf(stderr, "kernel_launch: occupancy query says %d blocks/CU\n", per_cu); (void)hipGetLastError(); grid = -1; return; }
    grid = cus;
  }
  if (grid < 0) return;
  (void)hipMemsetAsync((char*)d_ws + WS_CTL, 0, CTL_ZERO_BYTES, stream);
  Args a{};
  for (int i = 0; i < 22; ++i) a.in[i] = (const float*)d_in[i];
  a.out = (float*)d_out; a.ws = (unsigned char*)d_ws;
  hipLaunchKernelGGL(mega_fwd, dim3(grid), dim3(512), LDS_BYTES, stream, a);
}
```

```cpp
#include <hip/hip_runtime.h>
#include <stdint.h>
#include <cstdio>

typedef unsigned short bf16_t;
#define LAS __attribute__((address_space(3)))
#define GAS __attribute__((address_space(1)))
__device__ __forceinline__ float bf2f(bf16_t v) { return __uint_as_float(((unsigned)v) << 16); }
__device__ __forceinline__ bf16_t f2bf(float f) { unsigned u = __float_as_uint(f); return (bf16_t)((u + 0x7fffu + ((u >> 16) & 1u)) >> 16); }
__device__ __forceinline__ float wave_sum(float v) {
#pragma unroll
  for (int o = 1; o < 64; o <<= 1) v += __shfl_xor(v, o);
  return v;
}
__device__ __forceinline__ float wave_max(float v) {
#pragma unroll
  for (int o = 1; o < 64; o <<= 1) v = fmaxf(v, __shfl_xor(v, o));
  return v;
}
__device__ __forceinline__ float sigmoidf_(float v) { return 1.f / (1.f + __expf(-v)); }

__device__ __forceinline__ int tid_fresh() { int t = threadIdx.x; asm volatile("" : "+v"(t)); return t; }
typedef unsigned long long u64_t;
__device__ __forceinline__ const void* ldptr(const LAS u64_t* tab, int i) {
  const u64_t v = tab[i]; const unsigned lo = __builtin_amdgcn_readfirstlane((unsigned)v), hi = __builtin_amdgcn_readfirstlane((unsigned)(v >> 32));
  return (const void*)(((u64_t)hi << 32) | lo);
}

constexpr int NB = 8, S = 2048, D = 1024, NTOK = NB * S;
constexpr int INW = 4120;
constexpr int NSLOT = 40960;
constexpr size_t MiB = 1u << 20;
constexpr size_t WS_CTL = 0;
constexpr int CW_CNT = 4096;
constexpr size_t CTL_ZERO_BYTES = 65536;
constexpr size_t WS_SMALL = 1 * MiB;
constexpr size_t WS_LIST = 233 * MiB;
constexpr size_t WS_W1KT = 2 * MiB, WS_W1VT = 3 * MiB;
constexpr size_t WS_W2KT = 4 * MiB, WS_W2VT = 4 * MiB + 32768;
constexpr size_t WS_WGNT = 4 * MiB + 65536;
constexpr size_t WS_WRT_HI = 4 * MiB + 131072, WS_WRT_LO = 4 * MiB + 262144;
constexpr size_t WS_BIAS1 = 4 * MiB + 393216;
constexpr size_t WS_WABT = 5 * MiB;
constexpr size_t WS_WOT = 7 * MiB;
constexpr size_t WS_WGUT = 10 * MiB;
constexpr size_t WS_WDT = 42 * MiB;
constexpr size_t WS_WINT = 58 * MiB;
constexpr size_t WS_OAB = 66 * MiB;
constexpr size_t WS_XN = 66 * MiB;
constexpr size_t WS_OA = 66 * MiB, WS_OB = 82 * MiB;
constexpr size_t WS_YS = 66 * MiB;
constexpr size_t WS_GM = 98 * MiB;
constexpr size_t WS_H2 = 98 * MiB, WS_H2LO = 130 * MiB;
constexpr size_t WS_QA = 162 * MiB, WS_QB = 178 * MiB, WS_KVC = 194 * MiB, WS_KVS = 202 * MiB, WS_KVW = 210 * MiB, WS_KVB = 218 * MiB;
constexpr size_t WS_MG = 162 * MiB;
constexpr size_t WS_HB = 162 * MiB;
constexpr size_t WS_GTMP = 182 * MiB;
constexpr size_t WS_GN = 226 * MiB;
constexpr size_t WS_KC = 228 * MiB, WS_VC = WS_KC + 256 * 1024, WS_T1K = 229 * MiB, WS_T1V = 231 * MiB;
constexpr int SM_EID = 0, SM_WT = SM_EID + 2 * NTOK, SM_RANK = SM_WT + 2 * NTOK;
static_assert((SM_RANK + 2 * NTOK) * 4 <= (int)MiB, "small");

constexpr int LDS_BYTES = 147456;
constexpr int MISC_OFF = 131072 + 320;

#define XB_TMO      128
#define XB_XCNT(j)  (256  + 64 * (j))
#define XB_XSUB(j)  (1280 + 64 * (j))
#define XB_XGEN(j)  (2304 + 64 * (j))
#define XB_TOP      3328
#define XB_TOPGEN   3392
#define XCD_BAR_WORDS 3456
#define XB_SPIN_CAP (1u << 20)
__device__ __forceinline__ unsigned xb_ld(unsigned* p)              { return __hip_atomic_load(p, __ATOMIC_RELAXED, __HIP_MEMORY_SCOPE_AGENT); }
__device__ __forceinline__ unsigned xb_add(unsigned* p, unsigned v) { return __hip_atomic_fetch_add(p, v, __ATOMIC_RELAXED, __HIP_MEMORY_SCOPE_AGENT); }
__device__ __forceinline__ unsigned xb_xcc_id() { return (unsigned)__builtin_amdgcn_s_getreg((3 << 11) | 20) & 0xFu; }
#define XB_SPIN(cond, bar) do { unsigned _sp = 0; while (cond) { __builtin_amdgcn_s_sleep(1); \
    if ((++_sp & 255u) == 0u) { if (xb_ld(&(bar)[XB_TMO])) break; if (_sp > XB_SPIN_CAP) { atomicAdd(&(bar)[XB_TMO], 1u); break; } } } } while (0)
struct XcdBarrier { unsigned* bar; unsigned x; volatile LAS unsigned* st; };
__device__ __forceinline__ XcdBarrier xcd_barrier_post(unsigned* bar, volatile LAS unsigned* st) {
    XcdBarrier b; b.bar = bar; b.x = xb_xcc_id(); b.st = st;
    if (threadIdx.x == 0) (void)xb_add(&bar[XB_XCNT(b.x)], 1u);
    return b;
}
__device__ __forceinline__ void xcd_barrier_complete(unsigned* bar, unsigned x, unsigned& nloc, unsigned& nx) {
    const unsigned G = gridDim.x * gridDim.y * gridDim.z;
    unsigned sum, cnt, mine, sp = 0u;
    for (;;) {
        sum = 0u; cnt = 0u; mine = 0u;
#pragma unroll
        for (unsigned j = 0; j < 16; ++j) { const unsigned c = xb_ld(&bar[XB_XCNT(j)]); sum += c; cnt += (c > 0u) ? 1u : 0u; mine = (j == x) ? c : mine; }
        if (sum == G) break;
        __builtin_amdgcn_s_sleep(1);
        if ((++sp & 255u) == 0u) { if (xb_ld(&bar[XB_TMO])) break; if (sp > XB_SPIN_CAP) { atomicAdd(&bar[XB_TMO], 1u); break; } }
    }
    nloc = mine > 0u ? mine : 1u; nx = cnt > 0u ? cnt : 1u;
}
__device__ __forceinline__ void xcd_barrier(const XcdBarrier& b) {
    asm volatile("s_waitcnt vmcnt(0)" ::: "memory");
    __syncthreads();
    if (threadIdx.x == 0) {
        unsigned* bar = b.bar;
        __builtin_amdgcn_s_waitcnt(0);
        unsigned nloc = b.st[0], nx = b.st[1];
        if (nloc == 0u) { xcd_barrier_complete(bar, b.x, nloc, nx); b.st[0] = nloc; b.st[1] = nx; }
        const unsigned old = xb_add(&bar[XB_XSUB(b.x)], 1u);
        const unsigned gen = old / nloc;
        if (old + 1u == (gen + 1u) * nloc) {
            __builtin_amdgcn_fence(__ATOMIC_RELEASE, "agent");
            asm volatile("s_waitcnt vmcnt(0)" ::: "memory");
            const unsigned og = xb_add(&bar[XB_TOP], 1u);
            const unsigned tg = og / nx;
            if (og + 1u == (tg + 1u) * nx) xb_add(&bar[XB_TOPGEN], 1u);
            else XB_SPIN(xb_ld(&bar[XB_TOPGEN]) == tg, bar);
            __builtin_amdgcn_fence(__ATOMIC_ACQUIRE, "agent");
            xb_add(&bar[XB_XGEN(b.x)], 1u);
            asm volatile("s_waitcnt vmcnt(0)" ::: "memory");
        } else {
            XB_SPIN(xb_ld(&bar[XB_XGEN(b.x)]) == gen, bar);
            __builtin_amdgcn_fence(__ATOMIC_ACQUIRE, "agent");
            asm volatile("s_waitcnt vmcnt(0)" ::: "memory");
        }
    }
    __syncthreads();
}


namespace pg8 {
typedef short bf16x8 __attribute__((ext_vector_type(8)));
typedef float f32x4 __attribute__((ext_vector_type(4)));
typedef unsigned u32x4 __attribute__((ext_vector_type(4)));
typedef unsigned u32x2 __attribute__((ext_vector_type(2)));
constexpr int BM = 256, BK = 64, HALF = 128, HTB = HALF * BK * 2, STAGE_BYTES = 8 * HTB, NXCD = 8, WGM = 8;
__host__ __device__ __forceinline__ int lds_byte(int r, int c) { const int st = (r >> 4) * 2 + (c >> 5), rr = r & 15, cc = c & 31, ob = rr * 64 + cc * 2; return st * 1024 + (ob ^ (((ob >> 9) & 1) << 5)); }
__host__ __device__ __forceinline__ void stage_rc(int b, int& R, int& C) { const int st = b / 1024, sb = b % 1024, swz = sb ^ (((sb >> 9) & 1) << 5); R = (st >> 1) * 16 + swz / 64; C = (st & 1) * 32 + (swz % 64) / 2; }
__host__ __device__ __forceinline__ int perm32(int rho) { const int n = rho >> 4, i = rho & 15; return 8 * (i >> 2) + 4 * n + (i & 3); }
struct Unit { int pm, pn; const char* A; const char* B; };
__device__ __forceinline__ unsigned cvt_pk_bf16(float lo, float hi) { unsigned r; asm volatile("v_cvt_pk_bf16_f32 %0, %1, %2" : "=v"(r) : "v"(lo), "v"(hi)); return r; }

template <class Epi, class Sched, bool ALIGN_EPI>
__device__ __forceinline__ void gemm_phase(LAS unsigned char* lds, const int K, const int kstepA, const Sched& S, const Epi& E) {
    const int tid = tid_fresh(), wid = __builtin_amdgcn_readfirstlane(tid >> 6), lane = tid & 63, wr = wid >> 2, wc = wid & 3, fr = lane & 15, fq = lane >> 4;
    const int nt = K / BK;
    int Rr[2], Cc[2]; unsigned voffB[2];
#pragma unroll
    for (int i = 0; i < 2; ++i) { stage_rc(tid * 16 + i * 8192, Rr[i], Cc[i]); const int Rb = Epi::PERM ? ((Rr[i] & ~31) + perm32(Rr[i] & 31)) : Rr[i]; voffB[i] = (unsigned)(Rb * K + Cc[i]) * 2u; }
    const size_t kstepB = (size_t)(BK * 2);
    const size_t hstepB = (size_t)HALF * K * 2;
    const unsigned ldsw = (unsigned)wid * 1024u;
    const int aoff = lds_byte(wr * 64 + fr, fq * 8), boff = lds_byte(wc * 32 + fr, fq * 8);
#define PG8_SA(b, h) (((b) * 2 + (h)) * HTB)
#define PG8_SB(b, h) ((4 + (b) * 2 + (h)) * HTB)
#define PG8_STAGEB(bufoff, gbase) do { _Pragma("unroll") for (int _i = 0; _i < 2; ++_i) \
        __builtin_amdgcn_global_load_lds((const unsigned*)((const char*)(gbase) + voffB[_i]), (LAS unsigned*)(lds + (bufoff) + ldsw + _i * 8192), 16, 0, 0); } while (0)
#define PG8_STAGEA(bufoff, gbase, v0, v1) do { \
        __builtin_amdgcn_global_load_lds((const unsigned*)((const char*)(gbase) + (v0)), (LAS unsigned*)(lds + (bufoff) + ldsw), 16, 0, 0); \
        __builtin_amdgcn_global_load_lds((const unsigned*)((const char*)(gbase) + (v1)), (LAS unsigned*)(lds + (bufoff) + ldsw + 8192), 16, 0, 0); } while (0)
#define PG8_LDA(dst, b, h) do { _Pragma("unroll") for (int m = 0; m < 4; ++m) _Pragma("unroll") for (int k = 0; k < 2; ++k) dst[m][k] = *(const LAS bf16x8*)(lds + PG8_SA(b, h) + aoff + m * 2048 + k * 1024); } while (0)
#define PG8_LDB(dst, b, h) do { _Pragma("unroll") for (int n = 0; n < 2; ++n) _Pragma("unroll") for (int k = 0; k < 2; ++k) dst[n][k] = *(const LAS bf16x8*)(lds + PG8_SB(b, h) + boff + n * 2048 + k * 1024); } while (0)
#define PG8_MMA(ai, bj, At, Bt) do { __builtin_amdgcn_s_setprio(1); _Pragma("unroll") for (int m = 0; m < 4; ++m) _Pragma("unroll") for (int n = 0; n < 2; ++n) _Pragma("unroll") for (int k = 0; k < 2; ++k) \
        acc[ai][bj][m][n] = __builtin_amdgcn_mfma_f32_16x16x32_bf16(Bt[n][k], At[m][k], acc[ai][bj][m][n], 0, 0, 0); __builtin_amdgcn_s_setprio(0); } while (0)
#define PG8_WAIT_V(n) asm volatile("s_waitcnt vmcnt(" #n ")" ::: "memory")
#define PG8_WAIT_L(n) asm volatile("s_waitcnt lgkmcnt(" #n ")" ::: "memory")
#define PG8_BAR __builtin_amdgcn_s_barrier()
#define PG8_SCHED __builtin_amdgcn_sched_barrier(0)
    Unit cur, nxt; int ui = 0;
    if (!S.next(0, cur)) return;
    f32x4 acc[2][2][4][2];
#pragma unroll
    for (int a = 0; a < 2; ++a)
#pragma unroll
        for (int b = 0; b < 2; ++b)
#pragma unroll
            for (int m = 0; m < 4; ++m)
#pragma unroll
                for (int n = 0; n < 2; ++n) acc[a][b][m][n] = (f32x4){0.f, 0.f, 0.f, 0.f};
    bf16x8 At[4][2], B0[2][2], B1[2][2];
    unsigned vc00, vc01, vc10, vc11;
    vc00 = S.arow(cur, Rr[0]) + (unsigned)Cc[0] * 2u; vc01 = S.arow(cur, Rr[1]) + (unsigned)Cc[1] * 2u;
    vc10 = S.arow(cur, HALF + Rr[0]) + (unsigned)Cc[0] * 2u; vc11 = S.arow(cur, HALF + Rr[1]) + (unsigned)Cc[1] * 2u;
    const char* cA = cur.A; const char* cB = cur.B;
    PG8_STAGEB(PG8_SB(0, 0), cB); PG8_STAGEB(PG8_SB(0, 1), cB + hstepB); PG8_STAGEA(PG8_SA(0, 0), cA, vc00, vc01); PG8_STAGEA(PG8_SA(0, 1), cA, vc10, vc11);
    if (wr == 1) PG8_BAR;
    PG8_WAIT_V(2); PG8_BAR;
    PG8_STAGEB(PG8_SB(1, 0), cB + kstepB); PG8_STAGEA(PG8_SA(1, 0), cA + kstepA, vc00, vc01); PG8_STAGEB(PG8_SB(1, 1), cB + hstepB + kstepB);
    PG8_WAIT_V(6); PG8_BAR;
    for (;;) {
        const bool has_next = S.next(ui + 1, nxt);
        const char* nA = has_next ? nxt.A : cA; const char* nB = has_next ? nxt.B : cB;
        unsigned vn00 = vc00, vn01 = vc01, vn10 = vc10, vn11 = vc11;
        if (Sched::GATHER && has_next) {
            vn00 = S.arow(nxt, Rr[0]) + (unsigned)Cc[0] * 2u; vn01 = S.arow(nxt, Rr[1]) + (unsigned)Cc[1] * 2u;
            vn10 = S.arow(nxt, HALF + Rr[0]) + (unsigned)Cc[0] * 2u; vn11 = S.arow(nxt, HALF + Rr[1]) + (unsigned)Cc[1] * 2u;
        }
#pragma unroll 1
        for (int t = 0; t < nt; t += 2) {
            const bool last = (t == nt - 2);
            if (Epi::HOOK) { if (t == nt / 2) E.mid(acc, cur, wr, wc, fr, fq); }
            const char* a1 = cA + (size_t)(t + 1) * kstepA;
            const char* a2 = last ? nA : cA + (size_t)(t + 2) * kstepA; const char* b2 = last ? nB : cB + (size_t)(t + 2) * kstepB;
            const char* a3 = a2 + kstepA; const char* b3 = b2 + kstepB;
            const unsigned w00 = last ? vn00 : vc00, w01 = last ? vn01 : vc01, w10 = last ? vn10 : vc10, w11 = last ? vn11 : vc11;
            PG8_LDB(B0, 0, 0); PG8_LDB(B1, 0, 1); PG8_SCHED; PG8_LDA(At, 0, 0); PG8_STAGEA(PG8_SA(1, 1), a1, vc10, vc11);
            PG8_WAIT_V(8); PG8_WAIT_L(0); PG8_BAR; PG8_MMA(0, 0, At, B0); PG8_MMA(0, 1, At, B1); PG8_BAR; PG8_SCHED;
            PG8_LDA(At, 0, 1); PG8_STAGEB(PG8_SB(0, 0), b2); PG8_STAGEB(PG8_SB(0, 1), b2 + hstepB); PG8_STAGEA(PG8_SA(0, 0), a2, w00, w01);
            PG8_WAIT_V(8); PG8_WAIT_L(0); PG8_BAR; PG8_MMA(1, 0, At, B0); PG8_MMA(1, 1, At, B1); PG8_BAR; PG8_SCHED;
            PG8_LDB(B0, 1, 0); PG8_LDB(B1, 1, 1); PG8_SCHED; PG8_LDA(At, 1, 0); PG8_STAGEA(PG8_SA(0, 1), a2, w10, w11);
            PG8_WAIT_V(8); PG8_WAIT_L(0); PG8_BAR; PG8_MMA(0, 0, At, B0); PG8_MMA(0, 1, At, B1); PG8_BAR; PG8_SCHED;
            PG8_LDA(At, 1, 1); PG8_STAGEB(PG8_SB(1, 0), b3); PG8_STAGEB(PG8_SB(1, 1), b3 + hstepB); PG8_STAGEA(PG8_SA(1, 0), a3, w00, w01);
            PG8_WAIT_V(8); PG8_WAIT_L(0); PG8_BAR; PG8_MMA(1, 0, At, B0); PG8_MMA(1, 1, At, B1); PG8_BAR; PG8_SCHED;
        }
        if constexpr (ALIGN_EPI) { if (wr == 0) PG8_BAR; }
        E(acc, cur, wr, wc, fr, fq);
        if (!has_next) break;
#pragma unroll
        for (int a = 0; a < 2; ++a)
#pragma unroll
            for (int b = 0; b < 2; ++b)
#pragma unroll
                for (int m = 0; m < 4; ++m)
#pragma unroll
                    for (int n = 0; n < 2; ++n) acc[a][b][m][n] = (f32x4){0.f, 0.f, 0.f, 0.f};
        cur = nxt; cA = nA; cB = nB; vc00 = vn00; vc01 = vn01; vc10 = vn10; vc11 = vn11; ++ui;
        if constexpr (ALIGN_EPI) { if (wr == 1) PG8_BAR; }
    }
    PG8_WAIT_V(0);
    if constexpr (!ALIGN_EPI) { if (wr == 0) PG8_BAR; }
    PG8_BAR;
#undef PG8_SA
#undef PG8_SB
#undef PG8_STAGEA
#undef PG8_STAGEB
#undef PG8_LDA
#undef PG8_LDB
#undef PG8_MMA
#undef PG8_WAIT_V
#undef PG8_WAIT_L
#undef PG8_BAR
#undef PG8_SCHED
}

struct SchedDense {
    static constexpr bool GATHER = false;
    const char* A; const char* B; int pitchA  ; int K; int nM, nN, nwg, G, c;
    __device__ void init(const void* A_, int pitchA_, const void* B_, int M, int N, int K_, int G_, int c_) { A = (const char*)A_; B = (const char*)B_; pitchA = pitchA_; K = K_; nM = M / BM; nN = N / BM; nwg = nM * nN; G = G_; c = c_; }
    __device__ bool next(int i, Unit& u) const {
        const long L = (long)i * G + c; if (L >= nwg) return false;
        int wgid = (int)L; { const int q = nwg / NXCD, r = nwg % NXCD, xcd = wgid % NXCD, off = wgid / NXCD; wgid = (xcd < r ? xcd * (q + 1) : r * (q + 1) + (xcd - r) * q) + off; }
        const int nig = WGM * nN, gid = wgid / nig, fm = gid * WGM, gsz = (nM - fm) < WGM ? (nM - fm) : WGM;
        u.pm = fm + ((wgid % nig) % gsz); u.pn = (wgid % nig) / gsz;
        u.A = A + (size_t)u.pm * BM * pitchA; u.B = B + (size_t)u.pn * BM * K * 2; return true;
    }
    __device__ unsigned arow(const Unit&, int r) const { return (unsigned)(r * pitchA); }
};
struct SchedMoeUp {
    static constexpr bool GATHER = true;
    const char* H2; const char* W; const int* list; const int* cnt; const int* l_off; const int* l_te; int G, c;
    __device__ bool next(int i, Unit& u) const {
        const int L = i * G + c, tix = L >> 1; if (tix >= (l_off[32] >> 8)) return false;
        u.pm = tix; u.pn = L & 1; const int e = l_te[tix];
        u.A = H2; u.B = W + (size_t)e * (512 * 1024 * 2) + (size_t)u.pn * (256 * 1024 * 2); return true;
    }
    __device__ unsigned arow(const Unit& u, int r) const { const int e = l_te[u.pm]; int ri = u.pm * 256 + r - l_off[e]; if (ri >= cnt[e]) ri = 0; return (unsigned)list[(size_t)e * NTOK + ri] * 2048u; }
};
struct SchedMoeDown {
    static constexpr bool GATHER = false;
    const char* HB; const char* W; const int* l_off; const int* l_te; int G, c;
    __device__ bool next(int i, Unit& u) const {
        const int L = i * G + c, tix = L >> 2; if (tix >= (l_off[32] >> 8)) return false;
        u.pm = tix; u.pn = L & 3; const int e = l_te[tix];
        u.A = HB + (size_t)tix * (256 * 512); u.B = W + (size_t)e * (1024 * 256 * 2) + (size_t)u.pn * (256 * 256 * 2); return true;
    }
    __device__ unsigned arow(const Unit&, int r) const { return (unsigned)(r * 512); }
};

__device__ __forceinline__ float sigm(float v) { return __builtin_amdgcn_rcpf(1.f + __expf(-v)); }
struct EpiProj {
    static constexpr bool PERM = true, HOOK = false;
    bf16_t *QA, *QB, *KVC, *KVS, *KVW, *KVB, *GM;
    __device__ __forceinline__ void mid(f32x4 (&)[2][2][4][2], const Unit&, int, int, int, int) const {}
    __device__ __forceinline__ void operator()(const f32x4 (&acc)[2][2][4][2], const Unit& u, int wr, int wc, int fr, int fq) const {
        const int pn = u.pn; bf16_t* base; int ldc, colt; bool sg = false;
        if (pn < 2) { base = QA; ldc = 512; colt = pn * 256; }
        else if (pn == 2) { base = KVC; ldc = 256; colt = 0; }
        else if (pn == 3) { base = KVS; ldc = 256; colt = 0; }
        else if (pn == 4) { base = KVW; ldc = 256; colt = 0; }
        else if (pn < 7) { base = QB; ldc = 512; colt = (pn - 5) * 256; }
        else if (pn == 7) { base = KVB; ldc = 256; colt = 0; }
        else { base = GM; ldc = 2048; colt = (pn - 8) * 256; sg = true; }
        const int row0 = u.pm * BM + wr * 64 + fr, col0 = colt + wc * 32 + 8 * fq;
#pragma unroll
        for (int ai = 0; ai < 2; ++ai)
#pragma unroll
            for (int m = 0; m < 4; ++m) { bf16_t* rowp = base + (size_t)(row0 + ai * HALF + m * 16) * ldc + col0;
#pragma unroll
                for (int bj = 0; bj < 2; ++bj) { f32x4 v0 = acc[ai][bj][m][0], v1 = acc[ai][bj][m][1];
                    if (sg) { v0 = (f32x4){sigm(v0[0]), sigm(v0[1]), sigm(v0[2]), sigm(v0[3])}; v1 = (f32x4){sigm(v1[0]), sigm(v1[1]), sigm(v1[2]), sigm(v1[3])}; }
                    u32x4 w; w.x = cvt_pk_bf16(v0[0], v0[1]); w.y = cvt_pk_bf16(v0[2], v0[3]); w.z = cvt_pk_bf16(v1[0], v1[1]); w.w = cvt_pk_bf16(v1[2], v1[3]);
                    *(u32x4*)(rowp + bj * HALF) = w; } }
    }
};
struct EpiMerge {
    static constexpr bool PERM = true, HOOK = true;
    const bf16_t* GM; bf16_t* MG;
    __device__ __forceinline__ void mid(f32x4 (&acc)[2][2][4][2], const Unit& u, int wr, int wc, int fr, int fq) const {
        const int row0 = u.pm * BM + wr * 64 + fr, col0 = u.pn * BM + wc * 32 + 8 * fq;
        const GAS char* gm = (const GAS char*)GM + ((size_t)row0 * 2048 + col0) * 2;
#pragma unroll
        for (int ai = 0; ai < 2; ++ai)
#pragma unroll
            for (int m = 0; m < 4; ++m) { unsigned ro = (unsigned)(ai * HALF + m * 16) * 4096u; asm volatile("" : "+v"(ro));
#pragma unroll
                for (int bj = 0; bj < 2; ++bj) { const u32x4 ga = *(const GAS u32x4*)(gm + ro + bj * 256), gb = *(const GAS u32x4*)(gm + ro + 2048 + bj * 256);
                    const unsigned gaw[4] = {ga.x, ga.y, ga.z, ga.w}, gbw[4] = {gb.x, gb.y, gb.z, gb.w};
#pragma unroll
                    for (int q = 0; q < 4; ++q) { const float a0 = __uint_as_float(gaw[q] << 16), a1 = __uint_as_float(gaw[q] & 0xffff0000u), b0 = __uint_as_float(gbw[q] << 16), b1 = __uint_as_float(gbw[q] & 0xffff0000u);
                        acc[ai][bj][m][q >> 1][(q & 1) * 2] *= b0 * __builtin_amdgcn_rcpf(a0); acc[ai][bj][m][q >> 1][(q & 1) * 2 + 1] *= b1 * __builtin_amdgcn_rcpf(a1); } } }
    }
    __device__ __forceinline__ void operator()(const f32x4 (&acc)[2][2][4][2], const Unit& u, int wr, int wc, int fr, int fq) const {
        const int row0 = u.pm * BM + wr * 64 + fr, col0 = u.pn * BM + wc * 32 + 8 * fq;
        const GAS char* gm = (const GAS char*)GM + ((size_t)row0 * 2048 + col0) * 2;
        GAS char* mg = (GAS char*)MG + ((size_t)row0 * 1024 + col0) * 2;
#pragma unroll
        for (int ai = 0; ai < 2; ++ai)
#pragma unroll
            for (int m = 0; m < 4; ++m) { unsigned ro = (unsigned)(ai * HALF + m * 16) * 2048u; asm volatile("" : "+v"(ro));
#pragma unroll
                for (int bj = 0; bj < 2; ++bj) { const u32x4 ga = *(const GAS u32x4*)(gm + 2 * ro + bj * 256); const unsigned gaw[4] = {ga.x, ga.y, ga.z, ga.w}; float o[8];
#pragma unroll
                    for (int q = 0; q < 4; ++q) { o[2 * q] = acc[ai][bj][m][q >> 1][(q & 1) * 2] * __uint_as_float(gaw[q] << 16); o[2 * q + 1] = acc[ai][bj][m][q >> 1][(q & 1) * 2 + 1] * __uint_as_float(gaw[q] & 0xffff0000u); }
                    u32x4 w; w.x = cvt_pk_bf16(o[0], o[1]); w.y = cvt_pk_bf16(o[2], o[3]); w.z = cvt_pk_bf16(o[4], o[5]); w.w = cvt_pk_bf16(o[6], o[7]);
                    *(GAS u32x4*)(mg + ro + bj * 256) = w; } }
    }
};
struct EpiX1 {
    static constexpr bool PERM = false, HOOK = false;
    const float* x; float* out;
    __device__ __forceinline__ void mid(f32x4 (&)[2][2][4][2], const Unit&, int, int, int, int) const {}
    __device__ __forceinline__ void operator()(const f32x4 (&acc)[2][2][4][2], const Unit& u, int wr, int wc, int fr, int fq) const {
        const int row0 = u.pm * BM + wr * 64 + fr, col0 = u.pn * BM + wc * 32 + 4 * fq;
#pragma unroll
        for (int ai = 0; ai < 2; ++ai)
#pragma unroll
            for (int m = 0; m < 4; ++m) { const size_t off = (size_t)(row0 + ai * HALF + m * 16) * 1024 + col0;
#pragma unroll
                for (int bj = 0; bj < 2; ++bj)
#pragma unroll
                    for (int n = 0; n < 2; ++n) { const f32x4 bs = *(const f32x4*)(x + off + bj * HALF + n * 16); *(f32x4*)(out + off + bj * HALF + n * 16) = bs + acc[ai][bj][m][n]; } }
    }
};
struct EpiHB {
    static constexpr bool PERM = true, HOOK = false;
    bf16_t* HB;
    __device__ __forceinline__ void mid(f32x4 (&)[2][2][4][2], const Unit&, int, int, int, int) const {}
    __device__ __forceinline__ void operator()(const f32x4 (&acc)[2][2][4][2], const Unit& u, int wr, int wc, int fr, int fq) const {
        const int row0 = u.pm * BM + wr * 64 + fr, col0 = u.pn * HALF + wc * 32 + 8 * fq;
#pragma unroll
        for (int ai = 0; ai < 2; ++ai)
#pragma unroll
            for (int m = 0; m < 4; ++m) { float o[8];
#pragma unroll
                for (int n = 0; n < 2; ++n)
#pragma unroll
                    for (int j = 0; j < 4; ++j) { const float g = acc[ai][0][m][n][j]; o[n * 4 + j] = g * sigm(g) * acc[ai][1][m][n][j]; }
                u32x4 w; w.x = cvt_pk_bf16(o[0], o[1]); w.y = cvt_pk_bf16(o[2], o[3]); w.z = cvt_pk_bf16(o[4], o[5]); w.w = cvt_pk_bf16(o[6], o[7]);
                *(u32x4*)(HB + (size_t)(row0 + ai * HALF + m * 16) * 256 + col0) = w; }
    }
};
struct EpiYS {
    static constexpr bool PERM = true, HOOK = false;
    bf16_t* YS;
    __device__ __forceinline__ void mid(f32x4 (&)[2][2][4][2], const Unit&, int, int, int, int) const {}
    __device__ __forceinline__ void operator()(const f32x4 (&acc)[2][2][4][2], const Unit& u, int wr, int wc, int fr, int fq) const {
        const int row0 = u.pm * BM + wr * 64 + fr, col0 = u.pn * BM + wc * 32 + 8 * fq;
#pragma unroll
        for (int ai = 0; ai < 2; ++ai)
#pragma unroll
            for (int m = 0; m < 4; ++m) { bf16_t* rowp = YS + (size_t)(row0 + ai * HALF + m * 16) * 1024 + col0;
#pragma unroll
                for (int bj = 0; bj < 2; ++bj) { const f32x4 v0 = acc[ai][bj][m][0], v1 = acc[ai][bj][m][1];
                    u32x4 w; w.x = cvt_pk_bf16(v0[0], v0[1]); w.y = cvt_pk_bf16(v0[2], v0[3]); w.z = cvt_pk_bf16(v1[0], v1[1]); w.w = cvt_pk_bf16(v1[2], v1[3]);
                    *(u32x4*)(rowp + bj * HALF) = w; } }
    }
};
}

__device__ __forceinline__ unsigned pk2(float lo, float hi) { return (unsigned)f2bf(lo) | ((unsigned)f2bf(hi) << 16); }
__device__ __forceinline__ void tr_item(const float* __restrict__ W, int ldw, int c0, int nvalid, int k0, bf16_t* __restrict__ WT, int ldt, int r0, int kd0, LAS float* scr, int lane) {
#pragma unroll 8
  for (int i = 0; i < 32; ++i) { const int kk = 2 * i + (lane >> 5), n = lane & 31; scr[kk * 33 + n] = n < nvalid ? W[(size_t)(k0 + kk) * ldw + c0 + n] : 0.f; }
  asm volatile("s_waitcnt lgkmcnt(0)" ::: "memory");
  const int c = lane & 7;
#pragma unroll
  for (int j = 0; j < 4; ++j) { const int n = (lane >> 3) + 8 * j; const LAS float* s = scr + (8 * c) * 33 + n;
    pg8::u32x4 o; o.x = pk2(s[0 * 33], s[1 * 33]); o.y = pk2(s[2 * 33], s[3 * 33]); o.z = pk2(s[4 * 33], s[5 * 33]); o.w = pk2(s[6 * 33], s[7 * 33]);
    *(pg8::u32x4*)(WT + (size_t)(r0 + n) * ldt + kd0 + k0 + 8 * c) = o; }
  asm volatile("s_waitcnt lgkmcnt(0)" ::: "memory");
}


namespace att {
typedef float f32x16 __attribute__((ext_vector_type(16)));
typedef short bf16x8 __attribute__((ext_vector_type(8)));
typedef short s16x4 __attribute__((ext_vector_type(4)));
typedef unsigned u32x4 __attribute__((ext_vector_type(4)));
constexpr float LOG2E = 1.4426950408889634f, C2 = 0.125f * LOG2E, NEG = -1e30f;
constexpr int L_KS = 0, L_VS = 16384, L_WSC = 32768, L_PS = 36864, L_SCR = 69632, L_MSK = 77824;
__device__ __forceinline__ int crow(int r, int hi) { return (r & 3) + 8 * (r >> 2) + 4 * hi; }
__device__ __forceinline__ unsigned cvtpk(float lo, float hi) { unsigned r; asm volatile("v_cvt_pk_bf16_f32 %0, %1, %2" : "=v"(r) : "v"(lo), "v"(hi)); return r; }
struct KVRegs { u32x4 k, v; };
__device__ __forceinline__ KVRegs kv_load(const bf16_t* kptr, const bf16_t* vptr, int pitch, int wid, int lane) {
  KVRegs r;
  r.k = *(const GAS u32x4*)(kptr + (size_t)lane * pitch + wid * 8);
  r.v = *(const GAS u32x4*)(vptr + (size_t)(16 * (wid & 3) + (lane >> 2)) * pitch + (wid >> 2) * 32 + (lane & 3) * 8);
  return r;
}
__device__ __forceinline__ void kv_store(LAS unsigned char* Ks, LAS unsigned char* Vs, const KVRegs& r, int wid, int lane) {
  *(LAS u32x4*)(Ks + wid * 1024 + lane * 16) = r.k;
  *(LAS u32x4*)(Vs + wid * 1024 + lane * 16) = r.v;
}
__device__ __forceinline__ void qkt(f32x16& p0, f32x16& p1, const LAS unsigned char* Ks, const bf16x8 (&qr)[4], int r32, int hi) {
  const LAS unsigned char* kb = Ks + hi * 1024 + r32 * 16;
  const f32x16 z = {0.f, 0.f, 0.f, 0.f, 0.f, 0.f, 0.f, 0.f, 0.f, 0.f, 0.f, 0.f, 0.f, 0.f, 0.f, 0.f};
  p0 = z; p1 = z;
#pragma unroll
  for (int d0 = 0; d0 < 4; ++d0) {
    const bf16x8 b0 = *(const LAS bf16x8*)(kb + d0 * 2048), b1 = *(const LAS bf16x8*)(kb + d0 * 2048 + 512);
    p0 = __builtin_amdgcn_mfma_f32_32x32x16_bf16(b0, qr[d0], p0, 0, 0, 0);
    p1 = __builtin_amdgcn_mfma_f32_32x32x16_bf16(b1, qr[d0], p1, 0, 0, 0);
  }
}
typedef short v4i16_t __attribute__((ext_vector_type(4)));
__device__ __forceinline__ s16x4 vtr(const LAS unsigned char* p) { return __builtin_bit_cast(s16x4, __builtin_amdgcn_ds_read_tr16_b64_v4i16((LAS v4i16_t*)p)); }
__device__ __forceinline__ void pv(f32x16 (&o)[2], const LAS unsigned char* Vs, const bf16x8 (&pa)[4], int lane) {
  const int hi = lane >> 5;
  const LAS unsigned char* vb = Vs + ((lane >> 4) & 1) * 32 + (lane & 3) * 8 + (4 * hi + ((lane & 15) >> 2)) * 64;
#pragma unroll
  for (int d0 = 0; d0 < 2; ++d0)
#pragma unroll
    for (int ks = 0; ks < 4; ++ks) {
      const s16x4 lo = vtr(vb + d0 * 4096 + ks * 1024), hh = vtr(vb + d0 * 4096 + ks * 1024 + 512);
      const bf16x8 vf = {lo[0], lo[1], lo[2], lo[3], hh[0], hh[1], hh[2], hh[3]};
      o[d0] = __builtin_amdgcn_mfma_f32_32x32x16_bf16(pa[ks], vf, o[d0], 0, 0, 0);
    }
}
__device__ __forceinline__ void pack_p(bf16x8 (&pa)[4], const f32x16& p0, const f32x16& p1) {
  u32x4 w0 = {cvtpk(p0[0], p0[1]), cvtpk(p0[2], p0[3]), cvtpk(p0[4], p0[5]), cvtpk(p0[6], p0[7])};
  u32x4 w1 = {cvtpk(p0[8], p0[9]), cvtpk(p0[10], p0[11]), cvtpk(p0[12], p0[13]), cvtpk(p0[14], p0[15])};
  u32x4 w2 = {cvtpk(p1[0], p1[1]), cvtpk(p1[2], p1[3]), cvtpk(p1[4], p1[5]), cvtpk(p1[6], p1[7])};
  u32x4 w3 = {cvtpk(p1[8], p1[9]), cvtpk(p1[10], p1[11]), cvtpk(p1[12], p1[13]), cvtpk(p1[14], p1[15])};
  pa[0] = __builtin_bit_cast(bf16x8, w0); pa[1] = __builtin_bit_cast(bf16x8, w1); pa[2] = __builtin_bit_cast(bf16x8, w2); pa[3] = __builtin_bit_cast(bf16x8, w3);
}
template <int MODE>
__device__ __forceinline__ float logits(f32x16& p0, f32x16& p1, float slope2, int t, int kbase, int W, bool rowsel, int hi) {
  float mt = NEG;
#pragma unroll
  for (int r = 0; r < 16; ++r) {
    const int key0 = (r & 3) + 8 * (r >> 2) + 4 * hi, key1 = key0 + 32;
    int d0, d1;
    if (MODE == 3) { d0 = t - (16 * (kbase + key0) + 31); d1 = t - (16 * (kbase + key1) + 31); } else { d0 = t - (kbase + key0); d1 = d0 - 32; }
    float s0 = fmaf(p0[r], C2, -slope2 * (float)d0), s1 = fmaf(p1[r], C2, -slope2 * (float)d1);
    if (MODE == 1) { s0 = (d0 >= 0 && d0 < W) ? s0 : NEG; s1 = (d1 >= 0 && d1 < W) ? s1 : NEG; }
    if (MODE == 2) { s0 = (rowsel && d0 >= 0) ? s0 : NEG; s1 = (rowsel && d1 >= 0) ? s1 : NEG; }
    if (MODE == 3) { s0 = (d0 >= 0 && kbase + key0 < 127) ? s0 : NEG; s1 = (d1 >= 0 && kbase + key1 < 127) ? s1 : NEG; }
    p0[r] = s0; p1[r] = s1; mt = fmaxf(mt, fmaxf(s0, s1));
  }
  return fmaxf(mt, __shfl_xor(mt, 32));
}
__device__ __forceinline__ float expo(f32x16& p0, f32x16& p1, float mref) {
  float rs = 0.f;
#pragma unroll
  for (int r = 0; r < 16; ++r) { p0[r] = __builtin_amdgcn_exp2f(p0[r] - mref); p1[r] = __builtin_amdgcn_exp2f(p1[r] - mref); rs += p0[r] + p1[r]; }
  return rs;
}
__device__ __forceinline__ void scale_rows(f32x16 (&o)[2], float f, LAS float* wsc, int r32, int hi) {
  if (hi == 0) wsc[r32] = f;
#pragma unroll
  for (int r = 0; r < 16; ++r) { const float a = wsc[crow(r, hi)]; o[0][r] *= a; o[1][r] *= a; }
}
template <int MODE>
__device__ __forceinline__ void tile_step(f32x16 (&o)[2], float& m, float& l, const bf16x8 (&qr)[4], const LAS unsigned char* Ks, const LAS unsigned char* Vs, LAS float* wsc,
                                          float slope2, int t, int kbase, int W, bool rowsel, int lane) {
  const int r32 = lane & 31, hi = lane >> 5;
  f32x16 p0, p1;
  qkt(p0, p1, Ks, qr, r32, hi);
  const float mt = logits<MODE>(p0, p1, slope2, t, kbase, W, rowsel, hi);
  const float mn = fmaxf(m, mt), alpha = __builtin_amdgcn_exp2f(m - mn), mref = mn < -1e29f ? 0.f : mn;
  m = mn;
  const float rs = expo(p0, p1, mref);
  l = l * alpha + rs;
  scale_rows(o, alpha, wsc, r32, hi);
  bf16x8 pa[4]; pack_p(pa, p0, p1);
  pv(o, Vs, pa, lane);
}
__device__ __forceinline__ void load_q(bf16x8 (&qr)[4], const bf16_t* qrow  , int hi) {
#pragma unroll
  for (int d0 = 0; d0 < 4; ++d0) qr[d0] = *(const GAS bf16x8*)(qrow + d0 * 16 + hi * 8);
}
__device__ __forceinline__ void zero_o(f32x16 (&o)[2]) {
  const f32x16 z = {0.f, 0.f, 0.f, 0.f, 0.f, 0.f, 0.f, 0.f, 0.f, 0.f, 0.f, 0.f, 0.f, 0.f, 0.f, 0.f}; o[0] = z; o[1] = z;
}

__device__ __forceinline__ void swa_unit(LAS unsigned char* lds, int b, int hkv, int qt, const bf16_t* __restrict__ QB, const bf16_t* __restrict__ KVB, const float* __restrict__ sinks, bf16_t* __restrict__ OAB) {
  const int tid = tid_fresh(), lane = tid & 63, wid = __builtin_amdgcn_readfirstlane(tid >> 6), r32 = lane & 31, hi = lane >> 5;
  const int g = wid >> 1, head = hkv * 4 + g, t0 = qt * 64, t = t0 + 32 * (wid & 1) + r32;
  const size_t tokb = (size_t)b * S;
  LAS float* wsc = (LAS float*)(lds + L_WSC) + wid * 64;
  const float slope2 = exp2f(-0.5f * (float)(1 + head)) * LOG2E, sink2 = sinks[head] * LOG2E;
  bf16x8 qr[4]; load_q(qr, QB + (tokb + t) * 512 + head * 64, hi);
  f32x16 o[2]; zero_o(o);
  float m = NEG, l = 0.f;
  const int j0 = qt >= 2 ? qt - 2 : 0, nj = qt - j0 + 1;
  const bf16_t* kp = KVB + tokb * 256 + hkv * 64; const bf16_t* vp = kp + 128;
  KVRegs kr = kv_load(kp + (size_t)j0 * 64 * 256, vp + (size_t)j0 * 64 * 256, 256, wid, lane);
  kv_store(lds + L_KS, lds + L_VS, kr, wid, lane);
  __syncthreads();
  for (int i = 0; i < nj; ++i) {
    const int j = j0 + i, sl = (i & 1) * 8192;
    if (i + 1 < nj) kr = kv_load(kp + (size_t)(j + 1) * 64 * 256, vp + (size_t)(j + 1) * 64 * 256, 256, wid, lane);
    if (j == qt - 1) tile_step<0>(o, m, l, qr, lds + L_KS + sl, lds + L_VS + sl, wsc, slope2, t, j * 64, 128, true, lane);
    else tile_step<1>(o, m, l, qr, lds + L_KS + sl, lds + L_VS + sl, wsc, slope2, t, j * 64, 128, true, lane);
    if (i + 1 < nj) kv_store(lds + L_KS + (sl ^ 8192), lds + L_VS + (sl ^ 8192), kr, wid, lane);
    __syncthreads();
  }
  float lt = l + __shfl_xor(l, 32);
  const float mf = fmaxf(m, sink2), z = lt * __builtin_amdgcn_exp2f(m - mf) + __builtin_amdgcn_exp2f(sink2 - mf);
  scale_rows(o, __builtin_amdgcn_exp2f(m - mf) / z, wsc, r32, hi);
  bf16_t* op = OAB + (tokb + t0 + 32 * (wid & 1)) * 1024 + head * 64 + r32;
#pragma unroll
  for (int r = 0; r < 16; ++r) { const int q = crow(r, hi); op[(size_t)q * 1024] = f2bf(o[0][r]); op[(size_t)q * 1024 + 32] = f2bf(o[1][r]); }
}
__device__ __forceinline__ void swa_phase(LAS unsigned char* lds, const bf16_t* QB, const bf16_t* KVB, const float* sinks, bf16_t* OAB) {
#pragma unroll 1
  for (int u = blockIdx.x; u < NB * 2 * 32; u += gridDim.x) { swa_unit(lds, u >> 6, (u >> 5) & 1, u & 31, QB, KVB, sinks, OAB); }
}

constexpr int L_OACC = 36864;
__device__ __forceinline__ void oacc_store(LAS unsigned char* lds, const f32x16 (&o)[2], int wid, int lane) {
  LAS float* p = (LAS float*)(lds + L_OACC) + wid * 2048 + lane;
#pragma unroll
  for (int r = 0; r < 16; ++r) { p[r * 64] = o[0][r]; p[1024 + r * 64] = o[1][r]; }
}
__device__ __forceinline__ void oacc_add(LAS unsigned char* lds, const f32x16 (&o)[2], int wid, int lane) {
  LAS float* p = (LAS float*)(lds + L_OACC) + wid * 2048 + lane;
#pragma unroll
  for (int r = 0; r < 16; ++r) { p[r * 64] += o[0][r]; p[1024 + r * 64] += o[1][r]; }
}
__device__ __forceinline__ void nsa_unit(LAS unsigned char* lds, int b, int hkv, int qt, const bf16_t* __restrict__ QA, const bf16_t* __restrict__ KC, const bf16_t* __restrict__ VC,
                                         const bf16_t* __restrict__ KVS, const bf16_t* __restrict__ KVW, const float* __restrict__ GN, bf16_t* __restrict__ OAB) {
  const int tid = tid_fresh(), lane = tid & 63, wid = __builtin_amdgcn_readfirstlane(tid >> 6), r32 = lane & 31, hi = lane >> 5;
  const int g = wid >> 1, qh = wid & 1, head = hkv * 4 + g, t0 = qt * 64, ql = 32 * qh + r32, t = t0 + ql;
  const size_t tokb = (size_t)b * S;
  LAS float* wsc = (LAS float*)(lds + L_WSC) + wid * 64;
  LAS float* PS = (LAS float*)(lds + L_PS);
  LAS float* SCR = (LAS float*)(lds + L_SCR);
  LAS unsigned* MSK = (LAS unsigned*)(lds + L_MSK);
  const float slope2 = exp2f(-0.5f * (float)(9 + head)) * LOG2E;
  const float* gnp = GN + (tokb + t) * 32 + hkv * 12 + g * 3;
  bf16x8 qr[4]; load_q(qr, QA + (tokb + t) * 512 + head * 64, hi);
  const int nct = (t0 + 63 >= 31 + 16 * 64) ? 2 : 1;
  f32x16 ocmp[2]; zero_o(ocmp);
  {
    const bf16_t* kp = KC + ((size_t)b * 128 * 2 + hkv) * 64; const bf16_t* vp = VC + ((size_t)b * 128 * 2 + hkv) * 64;
    { KVRegs k0 = kv_load(kp, vp, 128, wid, lane); kv_store(lds + L_KS, lds + L_VS, k0, wid, lane); }
    if (nct == 2) { KVRegs k1 = kv_load(kp + (size_t)64 * 128, vp + (size_t)64 * 128, 128, wid, lane); kv_store(lds + L_KS + 8192, lds + L_VS + 8192, k1, wid, lane); }
    if (tid < 65) MSK[tid] = 0u;
    __syncthreads();
    float m = NEG, l = 0.f;
    for (int ct = 0; ct < nct; ++ct) {
      f32x16 p0, p1;
      qkt(p0, p1, lds + L_KS + ct * 8192, qr, r32, hi);
      const float mt = logits<3>(p0, p1, slope2, t, ct * 64, 0, true, hi);
      const float mn = fmaxf(m, mt), alpha = __builtin_amdgcn_exp2f(m - mn), mref = mn < -1e29f ? 0.f : mn;
      m = mn; l = l * alpha + expo(p0, p1, mref);
    }
    l += __shfl_xor(l, 32);
    const float inv = l > 0.f ? 1.f / l : 1.f, mref = m < -1e29f ? 0.f : m;
    for (int ct = 0; ct < nct; ++ct) {
      f32x16 p0, p1;
      qkt(p0, p1, lds + L_KS + ct * 8192, qr, r32, hi);
      (void)logits<3>(p0, p1, slope2, t, ct * 64, 0, true, hi);
      (void)expo(p0, p1, mref);
#pragma unroll
      for (int r = 0; r < 16; ++r) { p0[r] *= inv; p1[r] *= inv; }
      { bf16x8 pa[4]; pack_p(pa, p0, p1); pv(ocmp, lds + L_VS + ct * 8192, pa, lane); }
      for (int gg = 0; gg < 4; ++gg) {
        if (g == gg) {
#pragma unroll
          for (int r = 0; r < 16; ++r) {
            LAS float* pr = PS + ql * 128 + ct * 64 + crow(r, hi);
            if (gg == 0) { pr[0] = p0[r]; pr[32] = p1[r]; } else { pr[0] += p0[r]; pr[32] += p1[r]; }
          }
        }
        __syncthreads();
      }
    }
    if (nct == 1) {
      if (tid < 64) { LAS float* pr = PS + tid * 128 + 64; pr[0] = 0.f; pr[1] = 0.f; pr[2] = 0.f; pr[3] = 0.f; }
    }
    scale_rows(ocmp, gnp[0], wsc, r32, hi);
    __syncthreads();
  }
  {
    const int cur = qt;
#pragma unroll
    for (int i = 0; i < 4; ++i) {
      const int pi = tid + i * 512, q = pi >> 5, j = pi & 31;
      const LAS float* pr = PS + q * 128;
      float imp = 0.f;
      if (j <= cur) {
        const int c = 4 * j;
        imp = pr[c] + pr[c + 1] + pr[c + 2] + 0.5f * (c + 3 < 127 ? pr[c + 3] : 0.f) + 0.5f * (c > 0 ? pr[c - 1] : 0.f);
      }
      const bool forced = (j == 0) || (j == cur) || (j == cur - 1);
      SCR[pi] = forced ? 1e9f : (j <= cur ? imp : NEG);
    }
    __syncthreads();
#pragma unroll
    for (int i = 0; i < 4; ++i) {
      const int pi = tid + i * 512, q = pi >> 5, j = pi & 31;
      const float sj = SCR[pi]; int rank = 0;
      for (int k = 0; k < 32; ++k) { const float sk = SCR[q * 32 + k]; rank += ((sk > sj) || (sk == sj && k < j)) ? 1 : 0; }
      if (rank < 8 && sj > -5e29f) { __hip_atomic_fetch_or(&MSK[q], 1u << j, __ATOMIC_RELAXED, __HIP_MEMORY_SCOPE_WORKGROUP); __hip_atomic_fetch_or(&MSK[64], 1u << j, __ATOMIC_RELAXED, __HIP_MEMORY_SCOPE_WORKGROUP); }
    }
    __syncthreads();
  }
  const unsigned um = MSK[64], mymask = MSK[ql];
  __syncthreads();
  oacc_store(lds, ocmp, wid, lane);
  {
    f32x16 o[2]; zero_o(o);
    float m = NEG, l = 0.f;
    const bf16_t* kp = KVS + tokb * 256 + hkv * 64; const bf16_t* vp = kp + 128;
    unsigned rem = (unsigned)__builtin_amdgcn_readfirstlane(um);
    int j = __builtin_ctz(rem); rem &= rem - 1;
    KVRegs kr = kv_load(kp + (size_t)j * 64 * 256, vp + (size_t)j * 64 * 256, 256, wid, lane);
    kv_store(lds + L_KS, lds + L_VS, kr, wid, lane);
    __syncthreads();
    int sl = 0;
    for (;;) {
      const int jn = rem ? __builtin_ctz(rem) : -1; if (rem) rem &= rem - 1;
      if (jn >= 0) kr = kv_load(kp + (size_t)jn * 64 * 256, vp + (size_t)jn * 64 * 256, 256, wid, lane);
      tile_step<2>(o, m, l, qr, lds + L_KS + sl, lds + L_VS + sl, wsc, slope2, t, j * 64, 0, ((mymask >> j) & 1u) != 0u, lane);
      if (jn >= 0) kv_store(lds + L_KS + (sl ^ 8192), lds + L_VS + (sl ^ 8192), kr, wid, lane);
      __syncthreads();
      if (jn < 0) break;
      j = jn; sl ^= 8192;
    }
    const float lt = l + __shfl_xor(l, 32), inv = lt > 0.f ? 1.f / lt : 1.f;
    scale_rows(o, inv * gnp[1], wsc, r32, hi);
    oacc_add(lds, o, wid, lane);
  }
  {
    f32x16 o[2]; zero_o(o);
    float m = NEG, l = 0.f;
    const int j0 = qt >= 4 ? qt - 4 : 0, nj = qt - j0 + 1;
    const bf16_t* kp = KVW + tokb * 256 + hkv * 64; const bf16_t* vp = kp + 128;
    KVRegs kr = kv_load(kp + (size_t)j0 * 64 * 256, vp + (size_t)j0 * 64 * 256, 256, wid, lane);
    kv_store(lds + L_KS, lds + L_VS, kr, wid, lane);
    __syncthreads();
    for (int i = 0; i < nj; ++i) {
      const int j = j0 + i, sl = (i & 1) * 8192;
      if (i + 1 < nj) kr = kv_load(kp + (size_t)(j + 1) * 64 * 256, vp + (size_t)(j + 1) * 64 * 256, 256, wid, lane);
      if (j < qt && j > qt - 4) tile_step<0>(o, m, l, qr, lds + L_KS + sl, lds + L_VS + sl, wsc, slope2, t, j * 64, 256, true, lane);
      else tile_step<1>(o, m, l, qr, lds + L_KS + sl, lds + L_VS + sl, wsc, slope2, t, j * 64, 256, true, lane);
      if (i + 1 < nj) kv_store(lds + L_KS + (sl ^ 8192), lds + L_VS + (sl ^ 8192), kr, wid, lane);
      __syncthreads();
    }
    const float lt = l + __shfl_xor(l, 32);
    scale_rows(o, gnp[2] / lt, wsc, r32, hi);
    LAS const float* p = (LAS const float*)(lds + L_OACC) + wid * 2048 + lane;
    bf16_t* op = OAB + (tokb + t0 + 32 * qh) * 1024 + 512 + head * 64 + r32;
#pragma unroll
    for (int r = 0; r < 16; ++r) { const int q = crow(r, hi); op[(size_t)q * 1024] = f2bf(o[0][r] + p[r * 64]); op[(size_t)q * 1024 + 32] = f2bf(o[1][r] + p[1024 + r * 64]); }
  }
  __syncthreads();
}
__device__ __forceinline__ void nsa_phase(LAS unsigned char* lds, const bf16_t* QA, const bf16_t* KC, const bf16_t* VC, const bf16_t* KVS, const bf16_t* KVW, const float* GN, bf16_t* OAB) {
#pragma unroll 1
  for (int pr = blockIdx.x; pr < 256; pr += gridDim.x) {
    const int bh = pr >> 4, s = pr & 15;
#pragma unroll 1
    for (int i = 0; i < 2; ++i) nsa_unit(lds, bh >> 1, bh & 1, i == 0 ? 31 - s : s, QA, KC, VC, KVS, KVW, GN, OAB);
  }
}
}


namespace wg {
using att::f32x16; using att::bf16x8; using att::crow;
typedef short s16x4 __attribute__((ext_vector_type(4)));
template <int NI, int UNR>
__device__ __forceinline__ void wave_gemm(f32x16 (&acc)[NI], const bf16_t* wl, int ldw, const bf16_t* xl, int ksteps) {
  for (int ks = 0; ks < ksteps; ks += UNR) {
    bf16x8 a[UNR][NI], b[UNR];
#pragma unroll
    for (int u = 0; u < UNR; ++u) { b[u] = *(const GAS bf16x8*)(xl + (ks + u) * 16);
#pragma unroll
      for (int i = 0; i < NI; ++i) a[u][i] = *(const GAS bf16x8*)(wl + (size_t)i * 32 * ldw + (ks + u) * 16); }
#pragma unroll
    for (int u = 0; u < UNR; ++u)
#pragma unroll
      for (int i = 0; i < NI; ++i) acc[i] = __builtin_amdgcn_mfma_f32_32x32x16_bf16(a[u][i], b[u], acc[i], 0, 0, 0);
  }
}
constexpr int L_RED = 0;
__device__ __forceinline__ void cmp_unit(LAS unsigned char* lds, int sel, int rt, const bf16_t* __restrict__ KVC, const bf16_t* __restrict__ W1T, const float* __restrict__ bias1,
                                         const bf16_t* __restrict__ W2T, bf16_t* __restrict__ KCout) {
  const int tid = tid_fresh(), lane = tid & 63, wid = __builtin_amdgcn_readfirstlane(tid >> 6), r32 = lane & 31, hi = lane >> 5;
  int m = rt * 32 + r32; if (m > 2031) m = 2031;
  const int hh = m & 1, bc = m >> 1, b = bc / 127, c = bc - b * 127;
  const bf16_t* xl = KVC + ((size_t)b * S + 16 * c) * 256 + sel * 128 + hh * 64 + 8 * hi;
  const bf16_t* wl = W1T + (size_t)(32 * wid + r32) * 2048 + 8 * hi;
  const f32x16 z = {0.f, 0.f, 0.f, 0.f, 0.f, 0.f, 0.f, 0.f, 0.f, 0.f, 0.f, 0.f, 0.f, 0.f, 0.f, 0.f};
  f32x16 acc = z;
#pragma unroll 1
  for (int i = 0; i < 32; i += 2) {
    bf16x8 a[8], bb[8];
#pragma unroll
    for (int u = 0; u < 8; ++u) { bb[u] = *(const GAS bf16x8*)(xl + (size_t)(i + (u >> 2)) * 256 + (u & 3) * 16); a[u] = *(const GAS bf16x8*)(wl + (i + (u >> 2)) * 64 + (u & 3) * 16); }
#pragma unroll
    for (int u = 0; u < 8; ++u) acc = __builtin_amdgcn_mfma_f32_32x32x16_bf16(a[u], bb[u], acc, 0, 0, 0);
  }
  unsigned pw[8];
#pragma unroll
  for (int r = 0; r < 16; r += 2) {
    float v0 = acc[r] + bias1[32 * wid + crow(r, hi)], v1 = acc[r + 1] + bias1[32 * wid + crow(r + 1, hi)];
    v0 = v0 * __builtin_amdgcn_rcpf(1.f + __expf(-v0)); v1 = v1 * __builtin_amdgcn_rcpf(1.f + __expf(-v1));
    pw[r >> 1] = att::cvtpk(v0, v1);
  }
  const att::u32x4 q0 = {pw[0], pw[1], pw[2], pw[3]}, q1 = {pw[4], pw[5], pw[6], pw[7]};
  const bf16x8 pb0 = __builtin_bit_cast(bf16x8, q0), pb1 = __builtin_bit_cast(bf16x8, q1);
  f32x16 y[2]; y[0] = z; y[1] = z;
#pragma unroll
  for (int db = 0; db < 2; ++db)
#pragma unroll
    for (int s = 0; s < 2; ++s) {
      const bf16_t* wp = W2T + (size_t)(32 * db + r32) * 256 + 32 * wid + 16 * s + 4 * hi;
      const s16x4 lo = *(const GAS s16x4*)wp, hh2 = *(const GAS s16x4*)(wp + 8);
      const bf16x8 af = {lo[0], lo[1], lo[2], lo[3], hh2[0], hh2[1], hh2[2], hh2[3]};
      y[db] = __builtin_amdgcn_mfma_f32_32x32x16_bf16(af, s == 0 ? pb0 : pb1, y[db], 0, 0, 0);
    }
  LAS float* red = (LAS float*)(lds + L_RED);
#pragma unroll
  for (int r = 0; r < 16; ++r) { red[wid * 2048 + r * 64 + lane] = y[0][r]; red[wid * 2048 + 1024 + r * 64 + lane] = y[1][r]; }
  __syncthreads();
#pragma unroll
  for (int i = 0; i < 4; ++i) {
    const int e = tid + 512 * i; float sum = 0.f;
#pragma unroll
    for (int w = 0; w < 8; ++w) sum += red[w * 2048 + e];
    const int db = e >> 10, r = (e >> 6) & 15, ln = e & 63, d = 32 * db + crow(r, ln >> 5), mm = rt * 32 + (ln & 31);
    if (mm < 2032) { const int h2 = mm & 1, bc2 = mm >> 1, b2 = bc2 / 127, c2 = bc2 - b2 * 127; KCout[(((size_t)b2 * 128 + c2) * 2 + h2) * 64 + d] = f2bf(sum); }
  }
  __syncthreads();
}
__device__ __forceinline__ void cmp_bias_job(LAS unsigned char* lds, int jb, const float* __restrict__ pos, const float* __restrict__ w1, float* __restrict__ bias1) {
  const int tid = tid_fresh(), n = tid & 63, kp = tid >> 6, nc = jb & 3;
  float s = 0.f;
  for (int k = 256 * kp; k < 256 * kp + 256; ++k) s += pos[k] * w1[(size_t)k * 256 + 64 * nc + n];
  LAS float* part = (LAS float*)lds;
  part[kp * 64 + n] = s;
  __syncthreads();
  if (tid < 64) { float t = 0.f;
#pragma unroll
    for (int q = 0; q < 8; ++q) t += part[q * 64 + tid];
    bias1[64 * nc + tid] = t; }
  __syncthreads();
}
__device__ __forceinline__ void gn_rows(int row0, const bf16_t* __restrict__ XN, const bf16_t* __restrict__ WgnT, float* __restrict__ GN) {
  const int tid = tid_fresh(), lane = tid & 63, wid = __builtin_amdgcn_readfirstlane(tid >> 6), r32 = lane & 31, hi = lane >> 5;
  if (wid < 2) {
    const int row = row0 + 32 * wid + r32;
    f32x16 acc[1]; acc[0] = (f32x16){0.f, 0.f, 0.f, 0.f, 0.f, 0.f, 0.f, 0.f, 0.f, 0.f, 0.f, 0.f, 0.f, 0.f, 0.f, 0.f};
    wave_gemm<1, 8>(acc, WgnT + (size_t)r32 * 1024 + 8 * hi, 1024, XN + (size_t)row * 1024 + 8 * hi, 64);
#pragma unroll
    for (int r = 0; r < 16; ++r) { const int col = crow(r, hi); if (col < 24) GN[(size_t)row * 32 + col] = 1.f / (1.f + __expf(-acc[0][r])); }
  }
}
}


namespace rt {
using att::f32x16; using att::bf16x8; using att::crow;
constexpr int L_RED = 0, L_LG = 65536;
__device__ __forceinline__ void router_rows(LAS unsigned char* lds, int row0, const float* __restrict__ x1, const float* __restrict__ gf, const float* __restrict__ bg, const float* __restrict__ be,
                                            const bf16_t* __restrict__ WrtHi, const bf16_t* __restrict__ WrtLo, bf16_t* __restrict__ H2, bf16_t* __restrict__ H2LO, int* __restrict__ cnt, int* __restrict__ sm, int* __restrict__ list) {
  const int tid = tid_fresh(), lane = tid & 63, wid = __builtin_amdgcn_readfirstlane(tid >> 6), r32 = lane & 31, hi = lane >> 5;
#pragma unroll 1
  for (int rr = 0; rr < 8; ++rr) {
    const int r = row0 + wid * 8 + rr;
    const float4* xr = (const float4*)(x1 + (size_t)r * D);
    float4 v[4]; float s = 0.f;
#pragma unroll
    for (int j = 0; j < 4; ++j) { v[j] = xr[lane + 64 * j]; s += v[j].x * v[j].x + v[j].y * v[j].y + v[j].z * v[j].z + v[j].w * v[j].w; }
    s = wave_sum(s);
    const float rstd = rsqrtf(s * (1.f / D) + 1e-6f);
#pragma unroll
    for (int j = 0; j < 4; ++j) {
      const float4 gg = ((const float4*)gf)[lane + 64 * j];
      float4 h; h.x = v[j].x * rstd * gg.x; h.y = v[j].y * rstd * gg.y; h.z = v[j].z * rstd * gg.z; h.w = v[j].w * rstd * gg.w;
      ushort4 hh, lo;
      hh.x = f2bf(h.x); hh.y = f2bf(h.y); hh.z = f2bf(h.z); hh.w = f2bf(h.w);
      lo.x = f2bf(h.x - bf2f(hh.x)); lo.y = f2bf(h.y - bf2f(hh.y)); lo.z = f2bf(h.z - bf2f(hh.z)); lo.w = f2bf(h.w - bf2f(hh.w));
      ((ushort4*)(H2 + (size_t)r * D))[lane + 64 * j] = hh;
      ((ushort4*)(H2LO + (size_t)r * D))[lane + 64 * j] = lo;
    }
  }
  __syncthreads();
  {
    const int rb = wid & 1, kq = wid >> 1, row = row0 + 32 * rb + r32;
    const f32x16 z = {0.f, 0.f, 0.f, 0.f, 0.f, 0.f, 0.f, 0.f, 0.f, 0.f, 0.f, 0.f, 0.f, 0.f, 0.f, 0.f};
    f32x16 acc[2]; acc[0] = z; acc[1] = z;
    const bf16_t* xh = H2 + (size_t)row * D + kq * 256 + 8 * hi; const bf16_t* xl = H2LO + (size_t)row * D + kq * 256 + 8 * hi;
    const bf16_t* wh = WrtHi + (size_t)r32 * D + kq * 256 + 8 * hi; const bf16_t* wl = WrtLo + (size_t)r32 * D + kq * 256 + 8 * hi;
#pragma unroll 1
    for (int ks = 0; ks < 16; ks += 4) {
      bf16x8 bh[4], bl[4], ah[4][2], al[4][2];
#pragma unroll
      for (int u = 0; u < 4; ++u) { bh[u] = *(const GAS bf16x8*)(xh + (ks + u) * 16); bl[u] = *(const GAS bf16x8*)(xl + (ks + u) * 16);
#pragma unroll
        for (int cb = 0; cb < 2; ++cb) { ah[u][cb] = *(const GAS bf16x8*)(wh + (size_t)cb * 32 * D + (ks + u) * 16); al[u][cb] = *(const GAS bf16x8*)(wl + (size_t)cb * 32 * D + (ks + u) * 16); } }
#pragma unroll
      for (int u = 0; u < 4; ++u)
#pragma unroll
        for (int cb = 0; cb < 2; ++cb) {
          acc[cb] = __builtin_amdgcn_mfma_f32_32x32x16_bf16(al[u][cb], bh[u], acc[cb], 0, 0, 0);
          acc[cb] = __builtin_amdgcn_mfma_f32_32x32x16_bf16(ah[u][cb], bl[u], acc[cb], 0, 0, 0);
          acc[cb] = __builtin_amdgcn_mfma_f32_32x32x16_bf16(ah[u][cb], bh[u], acc[cb], 0, 0, 0);
        }
    }
    LAS float* red = (LAS float*)(lds + L_RED) + ((kq * 2 + rb) * 2) * 1024 + lane;
#pragma unroll
    for (int r = 0; r < 16; ++r) { red[r * 64] = acc[0][r]; red[1024 + r * 64] = acc[1][r]; }
  }
  __syncthreads();
  {
    LAS const float* red = (LAS const float*)(lds + L_RED);
    LAS float* lg = (LAS float*)(lds + L_LG);
#pragma unroll
    for (int i = 0; i < 8; ++i) {
      const int e = tid + 512 * i;
      const float sum = (red[e] + red[4096 + e]) + (red[8192 + e] + red[12288 + e]);
      const int ln = e & 63, r = (e >> 6) & 15, cb = (e >> 10) & 1, rb = e >> 11;
      lg[(32 * rb + (ln & 31)) * 64 + 32 * cb + crow(r, ln >> 5)] = sum;
    }
  }
  __syncthreads();
  if (tid < 64) {
    const int r = row0 + tid; LAS const float* lgr = (LAS const float*)(lds + L_LG) + tid * 64;
    int grp = 0; float gmax = -1e30f; float gl[4];
#pragma unroll
    for (int j = 0; j < 4; ++j) { gl[j] = lgr[j] + bg[j]; if (gl[j] > gmax) { gmax = gl[j]; grp = j; } }
    float zs = 0.f;
#pragma unroll
    for (int j = 0; j < 4; ++j) zs += __expf(gl[j] - gmax);
    const float pgrp = 1.f / zs;
    int i1 = 0; float v1 = -1e30f;
    for (int i = 0; i < 8; ++i) { const float e = lgr[4 + grp * 8 + i] + be[grp * 8 + i]; if (e > v1) { v1 = e; i1 = i; } }
    int i2 = 0; float v2 = -1e30f;
    for (int i = 0; i < 8; ++i) { const float e = lgr[4 + grp * 8 + i] + be[grp * 8 + i]; if (i != i1 && e > v2) { v2 = e; i2 = i; } }
    const float e2 = __expf(v2 - v1), w1 = 1.f / (1.f + e2), w2 = e2 * w1;
    const int e_a = grp * 8 + i1, e_b = grp * 8 + i2;
    const int ra = atomicAdd(&cnt[e_a], 1), rb = atomicAdd(&cnt[e_b], 1);
    sm[SM_EID + 2 * r] = e_a; sm[SM_EID + 2 * r + 1] = e_b;
    ((float*)sm)[SM_WT + 2 * r] = pgrp * w1; ((float*)sm)[SM_WT + 2 * r + 1] = pgrp * w2;
    sm[SM_RANK + 2 * r] = ra; sm[SM_RANK + 2 * r + 1] = rb;
    list[(size_t)e_a * NTOK + ra] = r; list[(size_t)e_b * NTOK + rb] = r;
  }
  __syncthreads();
}
}

__device__ __forceinline__ void ph_prep_xn(const float* __restrict__ x, const float* __restrict__ g, bf16_t* __restrict__ xn) {
  const int tid_ = tid_fresh(), lane = tid_ & 63, wave = (blockIdx.x * 512 + tid_) >> 6, nw = (gridDim.x * 512) >> 6;
  for (int r = wave; r < NTOK; r += nw) {
    const float4* xr = (const float4*)(x + (size_t)r * D);
    float4 v[4]; float s = 0.f;
#pragma unroll
    for (int j = 0; j < 4; ++j) { v[j] = xr[lane + 64 * j]; s += v[j].x * v[j].x + v[j].y * v[j].y + v[j].z * v[j].z + v[j].w * v[j].w; }
    s = wave_sum(s);
    const float rstd = rsqrtf(s * (1.f / D) + 1e-6f);
#pragma unroll
    for (int j = 0; j < 4; ++j) {
      const float4 gg = ((const float4*)g)[lane + 64 * j];
      ushort4 o; o.x = f2bf(v[j].x * rstd * gg.x); o.y = f2bf(v[j].y * rstd * gg.y); o.z = f2bf(v[j].z * rstd * gg.z); o.w = f2bf(v[j].w * rstd * gg.w);
      ((ushort4*)(xn + (size_t)r * D))[lane + 64 * j] = o;
    }
  }
}

template <class AL, class BL, class EP>
__device__ __forceinline__ void naive_gemm_phase(unsigned char* lds, const AL al, const BL bl, const EP ep, int K, int ntm, int ntn) {
  const int tid_ = tid_fresh(), half = tid_ >> 8, tid = tid_ & 255, tx = tid & 15, ty = tid >> 4;
  float (*As)[68] = (float (*)[68])(lds + half * 8704);
  float (*Bs)[68] = As + 16;
  const int ntiles = ntm * ntn;
  for (int it0 = blockIdx.x * 2; it0 < ntiles; it0 += 2 * gridDim.x) {
    const int it = it0 + half, tm = it / ntn, tn = it - tm * ntn, m0 = tm * 64, n0 = tn * 64;
    const bool act = it < ntiles && al.active(m0);
    float acc[4][4];
#pragma unroll
    for (int i = 0; i < 4; ++i)
#pragma unroll
      for (int j = 0; j < 4; ++j) acc[i][j] = 0.f;
    for (int k0 = 0; k0 < K; k0 += 16) {
#pragma unroll
      for (int i = 0; i < 4; ++i) { const int e = tid + i * 256, r = e >> 4, kk = e & 15; As[kk][r] = act ? al(m0 + r, k0 + kk) : 0.f; }
#pragma unroll
      for (int i = 0; i < 4; ++i) { const int e = tid + i * 256, kk = e >> 6, c = e & 63; Bs[kk][c] = act ? bl(m0, k0 + kk, n0 + c) : 0.f; }
      __syncthreads();
#pragma unroll
      for (int kk = 0; kk < 16; ++kk) {
        const float4 a = *(const float4*)&As[kk][ty * 4];
        const float4 b = *(const float4*)&Bs[kk][tx * 4];
        const float av[4] = {a.x, a.y, a.z, a.w}, bv[4] = {b.x, b.y, b.z, b.w};
#pragma unroll
        for (int i = 0; i < 4; ++i)
#pragma unroll
          for (int j = 0; j < 4; ++j) acc[i][j] += av[i] * bv[j];
      }
      __syncthreads();
    }
    if (act) {
#pragma unroll
      for (int i = 0; i < 4; ++i)
#pragma unroll
        for (int j = 0; j < 4; ++j) ep(m0 + ty * 4 + i, n0 + tx * 4 + j, acc[i][j]);
    }
  }
}

struct AL_bf16 { const bf16_t* A; int lda, M; __device__ bool active(int) const { return true; } __device__ float operator()(int m, int k) const { return m < M ? bf2f(A[(size_t)m * lda + k]) : 0.f; } };
struct AL_f32 { const float* A; int lda, M; __device__ bool active(int) const { return true; } __device__ float operator()(int m, int k) const { return m < M ? A[(size_t)m * lda + k] : 0.f; } };
struct BL_f32 { const float* B; int ldb, N; __device__ float operator()(int, int k, int n) const { return n < N ? B[(size_t)k * ldb + n] : 0.f; } };
struct EP_proj {
  bf16_t *QA, *QB, *KVC, *KVS, *KVW, *KVB, *GM; float* GN;
  __device__ void operator()(int m, int c, float v) const {
    if (c >= INW) return;
    if (c < 512) QA[(size_t)m * 512 + c] = f2bf(v);
    else if (c < 768) KVC[(size_t)m * 256 + (c - 512)] = f2bf(v);
    else if (c < 1024) KVS[(size_t)m * 256 + (c - 768)] = f2bf(v);
    else if (c < 1280) KVW[(size_t)m * 256 + (c - 1024)] = f2bf(v);
    else if (c < 1304) GN[(size_t)m * 32 + (c - 1280)] = sigmoidf_(v);
    else if (c < 1816) QB[(size_t)m * 512 + (c - 1304)] = f2bf(v);
    else if (c < 2072) KVB[(size_t)m * 256 + (c - 1816)] = f2bf(v);
    else GM[(size_t)m * 2048 + (c - 2072)] = f2bf(sigmoidf_(v));
  }
};
struct AL_cmp { const bf16_t* KVC; const float* pos; int sel; __device__ bool active(int) const { return true; }
  __device__ float operator()(int m, int k) const { if (m >= 2032) return 0.f; const int h = m & 1, bc = m >> 1, b = bc / 127, c = bc % 127, i = k >> 6, d = k & 63;
    return bf2f(KVC[((size_t)b * S + 16 * c + i) * 256 + sel * 128 + h * 64 + d]) + pos[k]; } };
struct EP_silu { float* T; int M, N; __device__ void operator()(int m, int n, float v) const { if (m < M && n < N) T[(size_t)m * N + n] = v / (1.f + __expf(-v)); } };
struct EP_kc { bf16_t* KC; __device__ void operator()(int m, int n, float v) const { if (m >= 2032 || n >= 64) return; const int h = m & 1, bc = m >> 1, b = bc / 127, c = bc % 127; KC[(((size_t)b * 128 + c) * 2 + h) * 64 + n] = f2bf(v); } };
struct EP_mg1 { float* tmp; const bf16_t* GM; __device__ void operator()(int m, int n, float v) const { tmp[(size_t)m * 1024 + n] = bf2f(GM[(size_t)m * 2048 + n]) * v; } };
struct EP_mg2 { const float* tmp; const bf16_t* GM; bf16_t* MG; __device__ void operator()(int m, int n, float v) const { MG[(size_t)m * 1024 + n] = f2bf(tmp[(size_t)m * 1024 + n] + bf2f(GM[(size_t)m * 2048 + 1024 + n]) * v); } };
struct EP_x1 { const float* x; float* out; __device__ void operator()(int m, int n, float v) const { out[(size_t)m * 1024 + n] = x[(size_t)m * 1024 + n] + v; } };
struct AL_moe { const bf16_t* H2; const int* list; const int* cnt; const int* l_off; const int* l_te; __device__ bool active(int m0) const { return l_te[m0 >> 8] >= 0; }
  __device__ float operator()(int m, int k) const { const int e = l_te[m >> 8], r = m - l_off[e]; if (r >= cnt[e]) return 0.f; const int t = list[(size_t)e * NTOK + r]; return bf2f(H2[(size_t)t * 1024 + k]); } };
struct BL_moe { const float* W; const int* l_te; int K, N; __device__ float operator()(int m0, int k, int n) const { const int e = l_te[m0 >> 8]; return W[((size_t)e * K + k) * N + n]; } };
struct EP_g { float* G; __device__ void operator()(int m, int n, float v) const { G[(size_t)m * 256 + n] = v; } };
struct EP_hb { const float* G; bf16_t* HB; __device__ void operator()(int m, int n, float v) const { const float g = G[(size_t)m * 256 + n]; HB[(size_t)m * 256 + n] = f2bf(g / (1.f + __expf(-g)) * v); } };
struct AL_hb { const bf16_t* HB; const int* l_te; __device__ bool active(int m0) const { return l_te[m0 >> 8] >= 0; } __device__ float operator()(int m, int k) const { return bf2f(HB[(size_t)m * 256 + k]); } };
struct EP_ys { bf16_t* YS; __device__ void operator()(int m, int n, float v) const { YS[(size_t)m * 1024 + n] = f2bf(v); } };

__device__ __forceinline__ void moe_tables(const int* cnt, int* l_off, int* l_te) {
  __syncthreads();
  if (threadIdx.x == 0) {
    int off = 0;
    for (int e = 0; e < 32; ++e) { l_off[e] = off; const int c = __hip_atomic_load(cnt + e, __ATOMIC_RELAXED, __HIP_MEMORY_SCOPE_AGENT); const int nt = (c + 255) >> 8; for (int i = 0; i < nt; ++i) l_te[(off >> 8) + i] = e; off += nt << 8; }
    l_off[32] = off;
    for (int i = off >> 8; i < NSLOT / 256; ++i) l_te[i] = -1;
  }
  __syncthreads();
}

__device__ __forceinline__ void naive_nsa_phase(unsigned char* lds, const bf16_t* __restrict__ QA, const bf16_t* __restrict__ KC, const bf16_t* __restrict__ VC, const bf16_t* __restrict__ KVS,
                                                const bf16_t* __restrict__ KVW, const float* __restrict__ GN, bf16_t* __restrict__ OA) {
  const int tid_ = tid_fresh(), half = tid_ >> 8, tid = tid_ & 255, g = tid >> 6, lane = tid & 63;
  unsigned char* base = lds + half * 12288;
  float (*q)[64] = (float (*)[64])base;
  float (*pc)[128] = (float (*)[128])(base + 1024);
  float (*sc)[512] = (float (*)[512])(base + 3072);
  float* sscore = (float*)(base + 11264);
  int* sel_idx = (int*)(base + 11264 + 128);
  int* sel_valid = (int*)(base + 11264 + 160);
  for (int item = blockIdx.x * 2 + half; item < NB * 2 * S; item += 2 * gridDim.x) {
    const int t = item & 2047, hkv = (item >> 11) & 1, b = item >> 12, head = hkv * 4 + g;
    const float slope = exp2f(-0.5f * (float)(9 + head));
    const size_t row = (size_t)b * S + t;
    q[g][lane] = bf2f(QA[row * 512 + head * 64 + lane]) * 0.125f;
    __syncthreads();
    {
      float sv[2]; bool vv[2]; float m = -1e30f;
#pragma unroll
      for (int i = 0; i < 2; ++i) {
        const int c = lane + 64 * i, dist = t - (16 * c + 31); vv[i] = (c < 127) && dist >= 0; float s = 0.f;
        if (vv[i]) { const bf16_t* kr = KC + (((size_t)b * 128 + c) * 2 + hkv) * 64; for (int d = 0; d < 64; ++d) s += q[g][d] * bf2f(kr[d]); s -= slope * (float)dist; m = fmaxf(m, s); }
        sv[i] = s;
      }
      m = wave_max(m);
      float z = 0.f;
#pragma unroll
      for (int i = 0; i < 2; ++i) { sv[i] = vv[i] ? __expf(sv[i] - m) : 0.f; z += sv[i]; }
      z = wave_sum(z);
      const float inv = z > 0.f ? 1.f / z : 1.f;
#pragma unroll
      for (int i = 0; i < 2; ++i) pc[g][lane + 64 * i] = sv[i] * inv;
    }
    __syncthreads();
    float ocmp = 0.f;
    {
      int ncv = (t >= 31) ? (t - 31) / 16 + 1 : 0; if (ncv > 127) ncv = 127;
      for (int c = 0; c < ncv; ++c) ocmp += pc[g][c] * bf2f(VC[(((size_t)b * 128 + c) * 2 + hkv) * 64 + lane]);
    }
    if (tid < 32) {
      const int j = tid;
      float ps[5];
#pragma unroll
      for (int u = 0; u < 5; ++u) { const int c = 4 * j - 1 + u; ps[u] = (c >= 0 && c < 127) ? (pc[0][c] + pc[1][c] + pc[2][c] + pc[3][c]) : 0.f; }
      const float imp = 0.5f * ps[0] + ps[1] + ps[2] + ps[3] + 0.5f * ps[4];
      const int cur = t >> 6; const bool forced = (j == 0) || (j == cur) || (j == cur - 1), valid = j <= cur;
      sscore[j] = forced ? 1e9f : (valid ? imp : -1e30f);
    }
    __syncthreads();
    if (tid < 32) {
      const int j = tid; const float sj = sscore[j]; int rank = 0;
      for (int i = 0; i < 32; ++i) { const float si = sscore[i]; rank += ((si > sj) || (si == sj && i < j)) ? 1 : 0; }
      if (rank < 8) { sel_idx[rank] = j; sel_valid[rank] = sj > -5e29f ? 1 : 0; }
    }
    __syncthreads();
    float oslc = 0.f;
    {
      float s8[8]; float m = -1e30f;
#pragma unroll
      for (int i = 0; i < 8; ++i) {
        const int kpos = sel_idx[i] * 64 + lane; const bool ok = sel_valid[i] && kpos <= t; float s = -1e30f;
        if (ok) { const bf16_t* kr = KVS + ((size_t)b * S + kpos) * 256 + hkv * 64; s = 0.f; for (int d = 0; d < 64; ++d) s += q[g][d] * bf2f(kr[d]); s -= slope * (float)(t - kpos); m = fmaxf(m, s); }
        s8[i] = s;
      }
      m = wave_max(m);
      float z = 0.f;
#pragma unroll
      for (int i = 0; i < 8; ++i) { const float p = s8[i] > -5e29f ? __expf(s8[i] - m) : 0.f; sc[g][i * 64 + lane] = p; z += p; }
      z = wave_sum(z);
      __syncthreads();
      for (int i = 0; i < 8; ++i) {
        if (!sel_valid[i]) continue;
        const int k0 = sel_idx[i] * 64;
        for (int l = 0; l < 64; ++l) { const int kpos = k0 + l; if (kpos > t) break; oslc += sc[g][i * 64 + l] * bf2f(KVS[((size_t)b * S + kpos) * 256 + 128 + hkv * 64 + lane]); }
      }
      oslc *= (z > 0.f ? 1.f / z : 1.f);
      __syncthreads();
    }
    float owin = 0.f;
    {
      float s4[4]; float m = -1e30f;
#pragma unroll
      for (int i = 0; i < 4; ++i) {
        const int dist = lane + 64 * i, kpos = t - dist; float s = -1e30f;
        if (kpos >= 0) { const bf16_t* kr = KVW + ((size_t)b * S + kpos) * 256 + hkv * 64; s = 0.f; for (int d = 0; d < 64; ++d) s += q[g][d] * bf2f(kr[d]); s -= slope * (float)dist; m = fmaxf(m, s); }
        s4[i] = s;
      }
      m = wave_max(m);
      float z = 0.f;
#pragma unroll
      for (int i = 0; i < 4; ++i) { const float p = s4[i] > -5e29f ? __expf(s4[i] - m) : 0.f; sc[g][i * 64 + lane] = p; z += p; }
      z = wave_sum(z);
      __syncthreads();
      for (int dist = 0; dist < 256; ++dist) { const int kpos = t - dist; if (kpos < 0) break; owin += sc[g][dist] * bf2f(KVW[((size_t)b * S + kpos) * 256 + 128 + hkv * 64 + lane]); }
      owin /= z;
    }
    const float* gn = GN + row * 32 + hkv * 12 + g * 3;
    OA[row * 1024 + 512 + head * 64 + lane] = f2bf(gn[0] * ocmp + gn[1] * oslc + gn[2] * owin);
    __syncthreads();
  }
}

__device__ __forceinline__ void naive_swa_phase(unsigned char* lds, const bf16_t* __restrict__ QB, const bf16_t* __restrict__ KVB, const float* __restrict__ sinks, bf16_t* __restrict__ OB) {
  const int tid_ = tid_fresh(), half = tid_ >> 8, tid = tid_ & 255, g = tid >> 6, lane = tid & 63;
  unsigned char* base = lds + half * 4096;
  float (*q)[64] = (float (*)[64])base;
  float (*sc)[128] = (float (*)[128])(base + 1024);
  for (int item = blockIdx.x * 2 + half; item < NB * 2 * S; item += 2 * gridDim.x) {
    const int t = item & 2047, hkv = (item >> 11) & 1, b = item >> 12, head = hkv * 4 + g;
    const float slope = exp2f(-0.5f * (float)(1 + head));
    const float sink = sinks[head];
    const size_t row = (size_t)b * S + t;
    q[g][lane] = bf2f(QB[row * 512 + head * 64 + lane]) * 0.125f;
    __syncthreads();
    float s2[2]; float m = sink;
#pragma unroll
    for (int i = 0; i < 2; ++i) {
      const int dist = lane + 64 * i, kpos = t - dist; float s = -1e30f;
      if (kpos >= 0) { const bf16_t* kr = KVB + ((size_t)b * S + kpos) * 256 + hkv * 64; s = 0.f; for (int d = 0; d < 64; ++d) s += q[g][d] * bf2f(kr[d]); s -= slope * (float)dist; m = fmaxf(m, s); }
      s2[i] = s;
    }
    m = wave_max(m);
    float z = 0.f;
#pragma unroll
    for (int i = 0; i < 2; ++i) { const float p = s2[i] > -5e29f ? __expf(s2[i] - m) : 0.f; sc[g][i * 64 + lane] = p; z += p; }
    z = wave_sum(z) + __expf(sink - m);
    __syncthreads();
    float o = 0.f;
    for (int dist = 0; dist < 128; ++dist) { const int kpos = t - dist; if (kpos < 0) break; o += sc[g][dist] * bf2f(KVB[((size_t)b * S + kpos) * 256 + 128 + hkv * 64 + lane]); }
    OB[row * 1024 + head * 64 + lane] = f2bf(o / z);
    __syncthreads();
  }
}

__device__ __forceinline__ void ph_router(unsigned char* lds, const float* __restrict__ x1, const float* __restrict__ gf, const float* __restrict__ wg, const float* __restrict__ bg, const float* __restrict__ we,
                                          const float* __restrict__ be, bf16_t* __restrict__ H2, bf16_t* __restrict__ H2LO, int* __restrict__ cnt, int* __restrict__ sm, int* __restrict__ list) {
  const int tid_ = tid_fresh(), lane = tid_ & 63, wl = tid_ >> 6, wave = (blockIdx.x * 512 + tid_) >> 6, nw = (gridDim.x * 512) >> 6;
  float* hs = (float*)lds + wl * 1024;
  float* lgs = (float*)(lds + 32768) + wl * 64;
  for (int r = wave; r < NTOK; r += nw) {
    const float4* xr = (const float4*)(x1 + (size_t)r * D);
    float4 v[4]; float s = 0.f;
#pragma unroll
    for (int j = 0; j < 4; ++j) { v[j] = xr[lane + 64 * j]; s += v[j].x * v[j].x + v[j].y * v[j].y + v[j].z * v[j].z + v[j].w * v[j].w; }
    s = wave_sum(s);
    const float rstd = rsqrtf(s * (1.f / D) + 1e-6f);
#pragma unroll
    for (int j = 0; j < 4; ++j) {
      const float4 gg = ((const float4*)gf)[lane + 64 * j];
      float4 h; h.x = v[j].x * rstd * gg.x; h.y = v[j].y * rstd * gg.y; h.z = v[j].z * rstd * gg.z; h.w = v[j].w * rstd * gg.w;
      ushort4 hi, lo;
      hi.x = f2bf(h.x); hi.y = f2bf(h.y); hi.z = f2bf(h.z); hi.w = f2bf(h.w);
      lo.x = f2bf(h.x - bf2f(hi.x)); lo.y = f2bf(h.y - bf2f(hi.y)); lo.z = f2bf(h.z - bf2f(hi.z)); lo.w = f2bf(h.w - bf2f(hi.w));
      ((ushort4*)(H2 + (size_t)r * D))[lane + 64 * j] = hi;
      ((ushort4*)(H2LO + (size_t)r * D))[lane + 64 * j] = lo;
      ((float4*)hs)[lane + 64 * j] = h;
    }
    __builtin_amdgcn_wave_barrier();
    asm volatile("s_waitcnt lgkmcnt(0)" ::: "memory");
    float acc = 0.f;
    if (lane < 36) {
      const float* wp = lane < 4 ? (wg + lane) : (we + (lane - 4));
      const int ld = lane < 4 ? 4 : 32;
      for (int k = 0; k < 1024; ++k) acc += hs[k] * wp[(size_t)k * ld];
      acc += lane < 4 ? bg[lane] : be[lane - 4];
    }
    lgs[lane] = acc;
    asm volatile("s_waitcnt lgkmcnt(0)" ::: "memory");
    __builtin_amdgcn_wave_barrier();
    if (lane == 0) {
      int grp = 0; float gmax = -1e30f;
      for (int j = 0; j < 4; ++j) { const float gl = lgs[j]; if (gl > gmax) { gmax = gl; grp = j; } }
      float zs = 0.f;
      for (int j = 0; j < 4; ++j) zs += __expf(lgs[j] - gmax);
      const float pgrp = 1.f / zs;
      int i1 = 0; float v1 = -1e30f;
      for (int i = 0; i < 8; ++i) { const float e = lgs[4 + grp * 8 + i]; if (e > v1) { v1 = e; i1 = i; } }
      int i2 = 0; float v2 = -1e30f;
      for (int i = 0; i < 8; ++i) { const float e = lgs[4 + grp * 8 + i]; if (i != i1 && e > v2) { v2 = e; i2 = i; } }
      const float e2 = __expf(v2 - v1), w1 = 1.f / (1.f + e2), w2 = e2 * w1;
      const int e_a = grp * 8 + i1, e_b = grp * 8 + i2;
      const int ra = atomicAdd(&cnt[e_a], 1), rb = atomicAdd(&cnt[e_b], 1);
      sm[SM_EID + 2 * r] = e_a; sm[SM_EID + 2 * r + 1] = e_b;
      ((float*)sm)[SM_WT + 2 * r] = pgrp * w1; ((float*)sm)[SM_WT + 2 * r + 1] = pgrp * w2;
      sm[SM_RANK + 2 * r] = ra; sm[SM_RANK + 2 * r + 1] = rb;
      list[(size_t)e_a * NTOK + ra] = r; list[(size_t)e_b * NTOK + rb] = r;
    }
    asm volatile("s_waitcnt lgkmcnt(0)" ::: "memory");
    __builtin_amdgcn_wave_barrier();
  }
}
__device__ __forceinline__ void ph_final(float* __restrict__ out, const bf16_t* __restrict__ YS, const int* __restrict__ sm, const int* l_off, const float* __restrict__ gfin) {
  const int tid_ = tid_fresh(), lane = tid_ & 63, wave = (blockIdx.x * 512 + tid_) >> 6, nw = (gridDim.x * 512) >> 6;
  for (int r = wave; r < NTOK; r += nw) {
    const int s0 = l_off[sm[SM_EID + 2 * r]] + sm[SM_RANK + 2 * r], s1 = l_off[sm[SM_EID + 2 * r + 1]] + sm[SM_RANK + 2 * r + 1];
    const float w0 = ((const float*)sm)[SM_WT + 2 * r], w1 = ((const float*)sm)[SM_WT + 2 * r + 1];
    float4* xr = (float4*)(out + (size_t)r * D);
    float4 v[4]; float s = 0.f;
#pragma unroll
    for (int j = 0; j < 4; ++j) {
      v[j] = xr[lane + 64 * j];
      const ushort4 a = ((const ushort4*)(YS + (size_t)s0 * D))[lane + 64 * j], c = ((const ushort4*)(YS + (size_t)s1 * D))[lane + 64 * j];
      v[j].x += w0 * bf2f(a.x) + w1 * bf2f(c.x); v[j].y += w0 * bf2f(a.y) + w1 * bf2f(c.y); v[j].z += w0 * bf2f(a.z) + w1 * bf2f(c.z); v[j].w += w0 * bf2f(a.w) + w1 * bf2f(c.w);
      s += v[j].x * v[j].x + v[j].y * v[j].y + v[j].z * v[j].z + v[j].w * v[j].w;
    }
    s = wave_sum(s);
    const float rstd = rsqrtf(s * (1.f / D) + 1e-6f);
#pragma unroll
    for (int j = 0; j < 4; ++j) { const float4 gg = ((const float4*)gfin)[lane + 64 * j]; float4 o; o.x = v[j].x * rstd * gg.x; o.y = v[j].y * rstd * gg.y; o.z = v[j].z * rstd * gg.z; o.w = v[j].w * rstd * gg.w; xr[lane + 64 * j] = o; }
  }
}


struct WPtrs { const float *w_in, *w1k, *w2k, *w1v, *w2v, *w_a, *w_b, *w_o, *w_group, *w_expert, *w_gate, *w_up, *w_down;
               bf16_t *WinT, *WgnT, *W1kT, *W1vT, *W2kT, *W2vT, *WabT, *WoT, *WguT, *WdT, *WrtHi, *WrtLo; };
__device__ __forceinline__ void ph_weights(LAS unsigned char* lds, const WPtrs& w) {
  const int tid_ = tid_fresh(), lane = tid_ & 63, wl = __builtin_amdgcn_readfirstlane(tid_ >> 6);
  const int gw = blockIdx.x * 8 + wl, NGW = gridDim.x * 8;
  LAS float* scr = (LAS float*)(lds + wl * 16384);
  constexpr int I_IN = 2048, I_GN = 16, I_W1 = 256, I_W2 = 8, I_AB = 256, I_O = 512, I_GU = 4096, I_D = 4096;
  constexpr int NITEMS = I_IN + I_GN + 2 * I_W1 + 2 * I_W2 + 2 * I_AB + I_O + 2 * I_GU + I_D;
  for (int it = gw; it < NITEMS; it += NGW) {
    int r = it;
    if (r < I_IN) { const int rb = r >> 4, kb = r & 15, n0 = rb * 32; tr_item(w.w_in, INW, n0 + (n0 >= 1280 ? 24 : 0), 32, kb * 64, w.WinT, 1024, n0, 0, scr, lane); continue; } r -= I_IN;
    if (r < I_GN) { tr_item(w.w_in, INW, 1280, 24, r * 64, w.WgnT, 1024, 0, 0, scr, lane); continue; } r -= I_GN;
    if (r < I_W1) { const int rb = r >> 5, kb = r & 31; tr_item(w.w1k, 256, rb * 32, 32, kb * 64, w.W1kT, 2048, rb * 32, 0, scr, lane); continue; } r -= I_W1;
    if (r < I_W1) { const int rb = r >> 5, kb = r & 31; tr_item(w.w1v, 256, rb * 32, 32, kb * 64, w.W1vT, 2048, rb * 32, 0, scr, lane); continue; } r -= I_W1;
    if (r < I_W2) { const int rb = r >> 2, kb = r & 3; tr_item(w.w2k, 64, rb * 32, 32, kb * 64, w.W2kT, 256, rb * 32, 0, scr, lane); continue; } r -= I_W2;
    if (r < I_W2) { const int rb = r >> 2, kb = r & 3; tr_item(w.w2v, 64, rb * 32, 32, kb * 64, w.W2vT, 256, rb * 32, 0, scr, lane); continue; } r -= I_W2;
    if (r < I_AB) { const int rb = r >> 3, kb = r & 7; tr_item(w.w_b, 1024, rb * 32, 32, kb * 64, w.WabT, 1024, rb * 32, 0, scr, lane); continue; } r -= I_AB;
    if (r < I_AB) { const int rb = r >> 3, kb = r & 7; tr_item(w.w_a, 1024, rb * 32, 32, kb * 64, w.WabT, 1024, rb * 32, 512, scr, lane); continue; } r -= I_AB;
    if (r < I_O) { const int rb = r >> 4, kb = r & 15; tr_item(w.w_o, 1024, rb * 32, 32, kb * 64, w.WoT, 1024, rb * 32, 0, scr, lane); continue; } r -= I_O;
    if (r < I_GU) { const int e = r >> 7, q = r & 127, cb = q >> 4, kb = q & 15, c0 = cb * 32; tr_item(w.w_gate + (size_t)e * 1024 * 256, 256, c0, 32, kb * 64, w.WguT + (size_t)e * 512 * 1024, 1024, (c0 >> 7) * 256 + (c0 & 127), 0, scr, lane); continue; } r -= I_GU;
    if (r < I_GU) { const int e = r >> 7, q = r & 127, cb = q >> 4, kb = q & 15, c0 = cb * 32; tr_item(w.w_up + (size_t)e * 1024 * 256, 256, c0, 32, kb * 64, w.WguT + (size_t)e * 512 * 1024, 1024, (c0 >> 7) * 256 + 128 + (c0 & 127), 0, scr, lane); continue; } r -= I_GU;
    { const int e = r >> 7, q = r & 127, cb = q >> 2, kb = q & 3; tr_item(w.w_down + (size_t)e * 256 * 1024, 1024, cb * 32, 32, kb * 64, w.WdT + (size_t)e * 1024 * 256, 256, cb * 32, 0, scr, lane); }
  }
  for (int i = blockIdx.x * 512 + tid_; i < 64 * 1024; i += gridDim.x * 512) {
    const int j = i >> 10, k = i & 1023; const float v = j < 4 ? w.w_group[k * 4 + j] : (j < 36 ? w.w_expert[k * 32 + (j - 4)] : 0.f);
    const bf16_t hi = f2bf(v); w.WrtHi[i] = hi; w.WrtLo[i] = f2bf(v - bf2f(hi));
  }
}
struct BL_gn { const float* W; __device__ float operator()(int, int k, int n) const { return n < 24 ? W[(size_t)k * INW + 1280 + n] : 0.f; } };
struct EP_gn { float* GN; __device__ void operator()(int m, int n, float v) const { if (n < 24) GN[(size_t)m * 32 + n] = sigmoidf_(v); } };

struct Args { const float* in[22]; float* out; unsigned char* ws; };
constexpr int PTAB_OFF = 131072 + 4096;
#define PIN(i) ((const float*)ldptr(ptab, (i)))
#define POUT ((float*)ldptr(ptab, 22))
#define PWS ((unsigned char*)ldptr(ptab, 23))
#define WSB(off) ((bf16_t*)(ws + (off)))
__global__ void __launch_bounds__(512, 2) mega_fwd(Args a) {
  extern __shared__ __attribute__((aligned(16))) unsigned char lds[];
  LAS unsigned char* ldsl = (LAS unsigned char*)lds;
  LAS u64_t* ptab = (LAS u64_t*)(ldsl + PTAB_OFF);
  volatile LAS unsigned* MISC = (volatile LAS unsigned*)(ldsl + MISC_OFF);
  if (threadIdx.x == 0) {
#pragma unroll
    for (int i = 0; i < 22; ++i) ptab[i] = (u64_t)a.in[i];
    ptab[22] = (u64_t)a.out; ptab[23] = (u64_t)a.ws;
  }
  if (threadIdx.x < 32) MISC[threadIdx.x] = 0u;
  __syncthreads();
  XcdBarrier bar = xcd_barrier_post((unsigned*)PWS, MISC + 8);
  int* l_off = (int*)(lds + 131072 + 1024);
  int* l_te = (int*)(lds + 131072 + 1024 + 256);
#define GRID_BAR() do { bar.bar = (unsigned*)PWS; xcd_barrier(bar); } while (0)

  {
    unsigned char* ws = PWS;
    WPtrs w{PIN(2), PIN(4), PIN(5), PIN(7), PIN(8), PIN(10), PIN(11), PIN(12), PIN(14), PIN(16), PIN(18), PIN(19), PIN(20),
            WSB(WS_WINT), WSB(WS_WGNT), WSB(WS_W1KT), WSB(WS_W1VT), WSB(WS_W2KT), WSB(WS_W2VT), WSB(WS_WABT), WSB(WS_WOT), WSB(WS_WGUT), WSB(WS_WDT), WSB(WS_WRT_HI), WSB(WS_WRT_LO)};
    if (blockIdx.x < 8) { const int jb = blockIdx.x; wg::cmp_bias_job(ldsl, jb, jb < 4 ? PIN(3) : PIN(6), jb < 4 ? PIN(4) : PIN(7), (float*)(ws + WS_BIAS1) + (jb >> 2) * 256); }
    ph_weights(ldsl, w);
    ph_prep_xn(PIN(0), PIN(1), WSB(WS_XN));
  }
  GRID_BAR();
  {
    unsigned char* ws = PWS;
    pg8::SchedDense Sd; Sd.init(ws + WS_XN, 2048, ws + WS_WINT, NTOK, 4096, 1024, gridDim.x, blockIdx.x);
    pg8::EpiProj E{WSB(WS_QA), WSB(WS_QB), WSB(WS_KVC), WSB(WS_KVS), WSB(WS_KVW), WSB(WS_KVB), WSB(WS_GM)};
    pg8::gemm_phase<pg8::EpiProj, pg8::SchedDense, true>(ldsl, 1024, 128, Sd, E);
  }
  {
    unsigned char* ws = PWS;
    for (int c = blockIdx.x; c < NTOK / 64; c += gridDim.x) wg::gn_rows(64 * c, WSB(WS_XN), WSB(WS_WGNT), (float*)(ws + WS_GN));
  }
  GRID_BAR();
  {
    unsigned char* ws = PWS;
    if (gridDim.x == 256) {
      const int c = blockIdx.x;
      if (c < 128) {
        const int sel = c >> 6, rt = c & 63;
        wg::cmp_unit(ldsl, sel, rt, WSB(WS_KVC), WSB(sel ? WS_W1VT : WS_W1KT), (const float*)(ws + WS_BIAS1) + sel * 256, WSB(sel ? WS_W2VT : WS_W2KT), WSB(sel ? WS_VC : WS_KC));
        att::swa_unit(ldsl, c >> 6, (c >> 5) & 1, c & 31, WSB(WS_QB), WSB(WS_KVB), PIN(9), WSB(WS_OAB));
      } else {
#pragma unroll 1
        for (int i = 0; i < 3; ++i) { const int u = 128 + (c - 128) * 3 + i; att::swa_unit(ldsl, u >> 6, (u >> 5) & 1, u & 31, WSB(WS_QB), WSB(WS_KVB), PIN(9), WSB(WS_OAB)); }
      }
    } else {
#pragma unroll 1
      for (int c = blockIdx.x; c < 128; c += gridDim.x) { const int sel = c >> 6, rt = c & 63;
        wg::cmp_unit(ldsl, sel, rt, WSB(WS_KVC), WSB(sel ? WS_W1VT : WS_W1KT), (const float*)(ws + WS_BIAS1) + sel * 256, WSB(sel ? WS_W2VT : WS_W2KT), WSB(sel ? WS_VC : WS_KC)); }
      att::swa_phase(ldsl, WSB(WS_QB), WSB(WS_KVB), PIN(9), WSB(WS_OAB));
    }
  }
  GRID_BAR();
  {
    unsigned char* ws = PWS;
    att::nsa_phase(ldsl, WSB(WS_QA), WSB(WS_KC), WSB(WS_VC), WSB(WS_KVS), WSB(WS_KVW), (const float*)(ws + WS_GN), WSB(WS_OAB));
  }
  GRID_BAR();
  {
    unsigned char* ws = PWS;
    pg8::SchedDense Sd; Sd.init(ws + WS_OAB, 2048, ws + WS_WABT, NTOK, 1024, 1024, gridDim.x, blockIdx.x);
    pg8::EpiMerge E{WSB(WS_GM), WSB(WS_MG)};
    pg8::gemm_phase<pg8::EpiMerge, pg8::SchedDense, true>(ldsl, 1024, 128, Sd, E);
  }
  GRID_BAR();
  {
    unsigned char* ws = PWS;
    pg8::SchedDense Sd; Sd.init(ws + WS_MG, 2048, ws + WS_WOT, NTOK, 1024, 1024, gridDim.x, blockIdx.x);
    pg8::EpiX1 E{PIN(0), POUT};
    pg8::gemm_phase<pg8::EpiX1, pg8::SchedDense, true>(ldsl, 1024, 128, Sd, E);
  }
  GRID_BAR();
  {
    unsigned char* ws = PWS;
#pragma unroll 1
    for (int c = blockIdx.x; c < NTOK / 64; c += gridDim.x)
      rt::router_rows(ldsl, 64 * c, POUT, PIN(13), PIN(15), PIN(17), WSB(WS_WRT_HI), WSB(WS_WRT_LO), WSB(WS_H2), WSB(WS_H2LO), (int*)(ws + WS_CTL) + CW_CNT, (int*)(ws + WS_SMALL), (int*)(ws + WS_LIST));
  }
  GRID_BAR();
  {
    unsigned char* ws = PWS;
    const int* cnt = (const int*)(ws + WS_CTL) + CW_CNT;
    moe_tables(cnt, l_off, l_te);
    pg8::SchedMoeUp Sm{(const char*)(ws + WS_H2), (const char*)(ws + WS_WGUT), (const int*)(ws + WS_LIST), cnt, l_off, l_te, (int)gridDim.x, (int)blockIdx.x};
    pg8::EpiHB E{WSB(WS_HB)};
    pg8::gemm_phase<pg8::EpiHB, pg8::SchedMoeUp, true>(ldsl, 1024, 128, Sm, E);
  }
  GRID_BAR();
  {
    unsigned char* ws = PWS;
    pg8::SchedMoeDown Sm{(const char*)(ws + WS_HB), (const char*)(ws + WS_WDT), l_off, l_te, (int)gridDim.x, (int)blockIdx.x};
    pg8::EpiYS E{WSB(WS_YS)};
    pg8::gemm_phase<pg8::EpiYS, pg8::SchedMoeDown, true>(ldsl, 256, 128, Sm, E);
  }
  GRID_BAR();
  {
    unsigned char* ws = PWS;
    ph_final(POUT, WSB(WS_YS), (const int*)(ws + WS_SMALL), l_off, PIN(21));
  }
}

extern "C" void kernel_launch(void* const* d_in, const int* in_sizes, int n_in, void* d_out, int out_size, void* d_ws, size_t ws_size, hipStream_t stream) {
  static int grid = 0;
  if (grid == 0) {
    int dev = 0, cus = 0, per_cu = 0;
    if (hipGetDevice(&dev) != hipSuccess || hipDeviceGetAttribute(&cus, hipDeviceAttributeMultiprocessorCount, dev) != hipSuccess) { fprintf(stderr, "kernel_launch: device query failed\n"); grid = -1; return; }
    if (hipFuncSetAttribute((const void*)mega_fwd, hipFuncAttributeMaxDynamicSharedMemorySize, LDS_BYTES) != hipSuccess) { fprintf(stderr, "kernel_launch: hipFuncSetAttribute failed\n"); grid = -1; return; }
    if (hipOccupancyMaxActiveBlocksPerMultiprocessor(&per_cu, (const void*)mega_fwd, 512, LDS_BYTES) != hipSuccess || per_cu < 1) { fprintf(stderr, "kernel_launch: occupancy query says %d blocks/CU\n", per_cu); (void)hipGetLastError(); grid = -1; return; }
    grid = cus;
  }
  if (grid < 0) return;
  (void)hipMemsetAsync((char*)d_ws + WS_CTL, 0, CTL_ZERO_BYTES, stream);
  Args a{};
  for (int i = 0; i < 22; ++i) a.in[i] = (const float*)d_in[i];
  a.out = (float*)d_out; a.ws = (unsigned char*)d_ws;
  hipLaunchKernelGGL(mega_fwd, dim3(grid), dim3(512), LDS_BYTES, stream, a);
}
```

```cpp
#include <hip/hip_runtime.h>
#include <stdint.h>
#include <cstdio>

typedef unsigned short bf16_t;
#define LAS __attribute__((address_space(3)))
#define GAS __attribute__((address_space(1)))
__device__ __forceinline__ float bf2f(bf16_t v) { return __uint_as_float(((unsigned)v) << 16); }
__device__ __forceinline__ bf16_t f2bf(float f) { unsigned u = __float_as_uint(f); return (bf16_t)((u + 0x7fffu + ((u >> 16) & 1u)) >> 16); }
__device__ __forceinline__ float wave_sum(float v) {
#pragma unroll
  for (int o = 1; o < 64; o <<= 1) v += __shfl_xor(v, o);
  return v;
}
__device__ __forceinline__ float wave_max(float v) {
#pragma unroll
  for (int o = 1; o < 64; o <<= 1) v = fmaxf(v, __shfl_xor(v, o));
  return v;
}
__device__ __forceinline__ float sigmoidf_(float v) { return 1.f / (1.f + __expf(-v)); }

__device__ __forceinline__ int tid_fresh() { int t = threadIdx.x; asm volatile("" : "+v"(t)); return t; }
typedef unsigned long long u64_t;
typedef float f32x4v __attribute__((ext_vector_type(4)));
typedef unsigned short u16x4v __attribute__((ext_vector_type(4)));
__device__ __forceinline__ const void* ldptr(const LAS u64_t* tab, int i) {
  const u64_t v = tab[i]; const unsigned lo = __builtin_amdgcn_readfirstlane((unsigned)v), hi = __builtin_amdgcn_readfirstlane((unsigned)(v >> 32));
  return (const void*)(((u64_t)hi << 32) | lo);
}

constexpr int NB = 8, S = 2048, D = 1024, NTOK = NB * S;
constexpr int INW = 4120;
constexpr int NSLOT = 40960;
constexpr size_t MiB = 1u << 20;
constexpr size_t WS_CTL = 0;
constexpr int CW_CNT = 4096;
constexpr size_t CTL_ZERO_BYTES = 65536;
constexpr size_t WS_SMALL = 1 * MiB;
constexpr size_t WS_LIST = 233 * MiB;
constexpr size_t WS_W1KT = 2 * MiB, WS_W1VT = 3 * MiB;
constexpr size_t WS_W2KT = 4 * MiB, WS_W2VT = 4 * MiB + 32768;
constexpr size_t WS_WGNT = 4 * MiB + 65536;
constexpr size_t WS_WRT_HI = 4 * MiB + 131072, WS_WRT_LO = 4 * MiB + 262144;
constexpr size_t WS_BIAS1 = 4 * MiB + 393216;
constexpr size_t WS_PB = 4 * MiB + 524288;
constexpr size_t WS_WABT = 5 * MiB;
constexpr size_t WS_WOT = 7 * MiB;
constexpr size_t WS_WGUT = 10 * MiB;
constexpr size_t WS_WDT = 42 * MiB;
constexpr size_t WS_WINT = 58 * MiB;
constexpr size_t WS_OAB = 66 * MiB;
constexpr size_t WS_XN = 66 * MiB;
constexpr size_t WS_OA = 66 * MiB, WS_OB = 82 * MiB;
constexpr size_t WS_YS = 66 * MiB;
constexpr size_t WS_GM = 98 * MiB;
constexpr size_t WS_H2 = 98 * MiB, WS_H2LO = 130 * MiB;
constexpr size_t WS_QA = 162 * MiB, WS_QB = 178 * MiB, WS_KVC = 194 * MiB, WS_KVS = 202 * MiB, WS_KVW = 210 * MiB, WS_KVB = 218 * MiB;
constexpr size_t WS_MG = 162 * MiB;
constexpr size_t WS_HB = 162 * MiB;
constexpr size_t WS_GTMP = 182 * MiB;
constexpr size_t WS_GN = 226 * MiB;
constexpr size_t WS_KC = 228 * MiB, WS_VC = WS_KC + 256 * 1024, WS_T1K = 229 * MiB, WS_T1V = 231 * MiB;
constexpr int SM_EID = 0, SM_WT = SM_EID + 2 * NTOK, SM_RANK = SM_WT + 2 * NTOK;
static_assert((SM_RANK + 2 * NTOK) * 4 <= (int)MiB, "small");

constexpr int LDS_BYTES = 147456;
constexpr int MISC_OFF = 131072 + 320;

#define XB_TMO      128
#define XB_XCNT(j)  (256  + 64 * (j))
#define XB_XSUB(j)  (1280 + 64 * (j))
#define XB_XGEN(j)  (2304 + 64 * (j))
#define XB_TOP      3328
#define XB_TOPGEN   3392
#define XCD_BAR_WORDS 3456
#define XB_SPIN_CAP (1u << 20)
__device__ __forceinline__ unsigned xb_ld(unsigned* p)              { return __hip_atomic_load(p, __ATOMIC_RELAXED, __HIP_MEMORY_SCOPE_AGENT); }
__device__ __forceinline__ unsigned xb_add(unsigned* p, unsigned v) { return __hip_atomic_fetch_add(p, v, __ATOMIC_RELAXED, __HIP_MEMORY_SCOPE_AGENT); }
__device__ __forceinline__ unsigned xb_xcc_id() { return (unsigned)__builtin_amdgcn_s_getreg((3 << 11) | 20) & 0xFu; }
#define XB_SPIN(cond, bar) do { unsigned _sp = 0; while (cond) { __builtin_amdgcn_s_sleep(1); \
    if ((++_sp & 255u) == 0u) { if (xb_ld(&(bar)[XB_TMO])) break; if (_sp > XB_SPIN_CAP) { atomicAdd(&(bar)[XB_TMO], 1u); break; } } } } while (0)
struct XcdBarrier { unsigned* bar; unsigned x; volatile LAS unsigned* st; };
__device__ __forceinline__ XcdBarrier xcd_barrier_post(unsigned* bar, volatile LAS unsigned* st) {
    XcdBarrier b; b.bar = bar; b.x = xb_xcc_id(); b.st = st;
    if (threadIdx.x == 0) (void)xb_add(&bar[XB_XCNT(b.x)], 1u);
    return b;
}
__device__ __forceinline__ void xcd_barrier_complete(unsigned* bar, unsigned x, unsigned& nloc, unsigned& nx) {
    const unsigned G = gridDim.x * gridDim.y * gridDim.z;
    unsigned sum, cnt, mine, sp = 0u;
    for (;;) {
        sum = 0u; cnt = 0u; mine = 0u;
#pragma unroll
        for (unsigned j = 0; j < 16; ++j) { const unsigned c = xb_ld(&bar[XB_XCNT(j)]); sum += c; cnt += (c > 0u) ? 1u : 0u; mine = (j == x) ? c : mine; }
        if (sum == G) break;
        __builtin_amdgcn_s_sleep(1);
        if ((++sp & 255u) == 0u) { if (xb_ld(&bar[XB_TMO])) break; if (sp > XB_SPIN_CAP) { atomicAdd(&bar[XB_TMO], 1u); break; } }
    }
    nloc = mine > 0u ? mine : 1u; nx = cnt > 0u ? cnt : 1u;
}
__device__ __forceinline__ void xcd_barrier(const XcdBarrier& b) {
    asm volatile("s_waitcnt vmcnt(0)" ::: "memory");
    __syncthreads();
    if (threadIdx.x == 0) {
        unsigned* bar = b.bar;
        __builtin_amdgcn_s_waitcnt(0);
        unsigned nloc = b.st[0], nx = b.st[1];
        if (nloc == 0u) { xcd_barrier_complete(bar, b.x, nloc, nx); b.st[0] = nloc; b.st[1] = nx; }
        const unsigned old = xb_add(&bar[XB_XSUB(b.x)], 1u);
        const unsigned gen = old / nloc;
        if (old + 1u == (gen + 1u) * nloc) {
            __builtin_amdgcn_fence(__ATOMIC_RELEASE, "agent");
            asm volatile("s_waitcnt vmcnt(0)" ::: "memory");
            const unsigned og = xb_add(&bar[XB_TOP], 1u);
            const unsigned tg = og / nx;
            if (og + 1u == (tg + 1u) * nx) xb_add(&bar[XB_TOPGEN], 1u);
            else XB_SPIN(xb_ld(&bar[XB_TOPGEN]) == tg, bar);
            __builtin_amdgcn_fence(__ATOMIC_ACQUIRE, "agent");
            xb_add(&bar[XB_XGEN(b.x)], 1u);
            asm volatile("s_waitcnt vmcnt(0)" ::: "memory");
        } else {
            XB_SPIN(xb_ld(&bar[XB_XGEN(b.x)]) == gen, bar);
            __builtin_amdgcn_fence(__ATOMIC_ACQUIRE, "agent");
            asm volatile("s_waitcnt vmcnt(0)" ::: "memory");
        }
    }
    __syncthreads();
}


namespace pg8 {
typedef short bf16x8 __attribute__((ext_vector_type(8)));
typedef float f32x4 __attribute__((ext_vector_type(4)));
typedef unsigned u32x4 __attribute__((ext_vector_type(4)));
typedef unsigned u32x2 __attribute__((ext_vector_type(2)));
constexpr int BM = 256, BK = 64, HALF = 128, HTB = HALF * BK * 2, STAGE_BYTES = 8 * HTB, NXCD = 8, WGM = 8;
__host__ __device__ __forceinline__ int lds_byte(int r, int c) { const int st = (r >> 4) * 2 + (c >> 5), rr = r & 15, cc = c & 31, ob = rr * 64 + cc * 2; return st * 1024 + (ob ^ (((ob >> 9) & 1) << 5)); }
__host__ __device__ __forceinline__ void stage_rc(int b, int& R, int& C) { const int st = b / 1024, sb = b % 1024, swz = sb ^ (((sb >> 9) & 1) << 5); R = (st >> 1) * 16 + swz / 64; C = (st & 1) * 32 + (swz % 64) / 2; }
__host__ __device__ __forceinline__ int perm32(int rho) { const int n = rho >> 4, i = rho & 15; return 8 * (i >> 2) + 4 * n + (i & 3); }
struct Unit { int pm, pn; const char* A; const char* B; };
__device__ __forceinline__ unsigned cvt_pk_bf16(float lo, float hi) { unsigned r; asm volatile("v_cvt_pk_bf16_f32 %0, %1, %2" : "=v"(r) : "v"(lo), "v"(hi)); return r; }

template <class Epi, class Sched, bool ALIGN_EPI>
__device__ __forceinline__ void gemm_phase(LAS unsigned char* lds, const int K, const int kstepA, const Sched& S, const Epi& E) {
    const int tid = tid_fresh(), wid = __builtin_amdgcn_readfirstlane(tid >> 6), lane = tid & 63, wr = wid >> 2, wc = wid & 3, fr = lane & 15, fq = lane >> 4;
    const int nt = K / BK;
    int Rr[2], Cc[2]; unsigned voffB[2];
#pragma unroll
    for (int i = 0; i < 2; ++i) { stage_rc(tid * 16 + i * 8192, Rr[i], Cc[i]); const int Rb = Epi::PERM ? ((Rr[i] & ~31) + perm32(Rr[i] & 31)) : Rr[i]; voffB[i] = (unsigned)(Rb * K + Cc[i]) * 2u; }
    const size_t kstepB = (size_t)(BK * 2);
    const size_t hstepB = (size_t)HALF * K * 2;
    const unsigned ldsw = (unsigned)wid * 1024u;
    const int aoff = lds_byte(wr * 64 + fr, fq * 8), boff = lds_byte(wc * 32 + fr, fq * 8);
#define PG8_SA(b, h) (((b) * 2 + (h)) * HTB)
#define PG8_SB(b, h) ((4 + (b) * 2 + (h)) * HTB)
#define PG8_STAGEB(bufoff, gbase) do { _Pragma("unroll") for (int _i = 0; _i < 2; ++_i) \
        __builtin_amdgcn_global_load_lds((const unsigned*)((const char*)(gbase) + voffB[_i]), (LAS unsigned*)(lds + (bufoff) + ldsw + _i * 8192), 16, 0, 0); } while (0)
#define PG8_STAGEA(bufoff, gbase, v0, v1) do { \
        __builtin_amdgcn_global_load_lds((const unsigned*)((const char*)(gbase) + (v0)), (LAS unsigned*)(lds + (bufoff) + ldsw), 16, 0, 0); \
        __builtin_amdgcn_global_load_lds((const unsigned*)((const char*)(gbase) + (v1)), (LAS unsigned*)(lds + (bufoff) + ldsw + 8192), 16, 0, 0); } while (0)
#define PG8_LDA(dst, b, h) do { _Pragma("unroll") for (int m = 0; m < 4; ++m) _Pragma("unroll") for (int k = 0; k < 2; ++k) dst[m][k] = *(const LAS bf16x8*)(lds + PG8_SA(b, h) + aoff + m * 2048 + k * 1024); } while (0)
#define PG8_LDB(dst, b, h) do { _Pragma("unroll") for (int n = 0; n < 2; ++n) _Pragma("unroll") for (int k = 0; k < 2; ++k) dst[n][k] = *(const LAS bf16x8*)(lds + PG8_SB(b, h) + boff + n * 2048 + k * 1024); } while (0)
#define PG8_MMA(ai, bj, At, Bt) do { __builtin_amdgcn_s_setprio(1); _Pragma("unroll") for (int m = 0; m < 4; ++m) _Pragma("unroll") for (int n = 0; n < 2; ++n) _Pragma("unroll") for (int k = 0; k < 2; ++k) \
        acc[ai][bj][m][n] = __builtin_amdgcn_mfma_f32_16x16x32_bf16(Bt[n][k], At[m][k], acc[ai][bj][m][n], 0, 0, 0); __builtin_amdgcn_s_setprio(0); } while (0)
#define PG8_WAIT_V(n) asm volatile("s_waitcnt vmcnt(" #n ")" ::: "memory")
#define PG8_WAIT_L(n) asm volatile("s_waitcnt lgkmcnt(" #n ")" ::: "memory")
#define PG8_BAR __builtin_amdgcn_s_barrier()
#define PG8_SCHED __builtin_amdgcn_sched_barrier(0)
    Unit cur, nxt; int ui = 0;
    if (!S.next(0, cur)) return;
    f32x4 acc[2][2][4][2];
#pragma unroll
    for (int a = 0; a < 2; ++a)
#pragma unroll
        for (int b = 0; b < 2; ++b)
#pragma unroll
            for (int m = 0; m < 4; ++m)
#pragma unroll
                for (int n = 0; n < 2; ++n) acc[a][b][m][n] = (f32x4){0.f, 0.f, 0.f, 0.f};
    bf16x8 At[4][2], B0[2][2], B1[2][2];
    unsigned vc00, vc01, vc10, vc11;
    vc00 = S.arow(cur, Rr[0]) + (unsigned)Cc[0] * 2u; vc01 = S.arow(cur, Rr[1]) + (unsigned)Cc[1] * 2u;
    vc10 = S.arow(cur, HALF + Rr[0]) + (unsigned)Cc[0] * 2u; vc11 = S.arow(cur, HALF + Rr[1]) + (unsigned)Cc[1] * 2u;
    const char* cA = cur.A; const char* cB = cur.B;
    PG8_STAGEB(PG8_SB(0, 0), cB); PG8_STAGEB(PG8_SB(0, 1), cB + hstepB); PG8_STAGEA(PG8_SA(0, 0), cA, vc00, vc01); PG8_STAGEA(PG8_SA(0, 1), cA, vc10, vc11);
    if (wr == 1) PG8_BAR;
    PG8_WAIT_V(2); PG8_BAR;
    PG8_STAGEB(PG8_SB(1, 0), cB + kstepB); PG8_STAGEA(PG8_SA(1, 0), cA + kstepA, vc00, vc01); PG8_STAGEB(PG8_SB(1, 1), cB + hstepB + kstepB);
    PG8_WAIT_V(6); PG8_BAR;
    for (;;) {
        const bool has_next = S.next(ui + 1, nxt);
        const char* nA = has_next ? nxt.A : cA; const char* nB = has_next ? nxt.B : cB;
        unsigned vn00 = vc00, vn01 = vc01, vn10 = vc10, vn11 = vc11;
        if (Sched::GATHER && has_next) {
            vn00 = S.arow(nxt, Rr[0]) + (unsigned)Cc[0] * 2u; vn01 = S.arow(nxt, Rr[1]) + (unsigned)Cc[1] * 2u;
            vn10 = S.arow(nxt, HALF + Rr[0]) + (unsigned)Cc[0] * 2u; vn11 = S.arow(nxt, HALF + Rr[1]) + (unsigned)Cc[1] * 2u;
        }
#pragma unroll 1
        for (int t = 0; t < nt; t += 2) {
            const bool last = (t == nt - 2);
            if (Epi::HOOK) { if (t == nt / 2) E.mid(acc, cur, wr, wc, fr, fq); }
            const char* a1 = cA + (size_t)(t + 1) * kstepA;
            const char* a2 = last ? nA : cA + (size_t)(t + 2) * kstepA; const char* b2 = last ? nB : cB + (size_t)(t + 2) * kstepB;
            const char* a3 = a2 + kstepA; const char* b3 = b2 + kstepB;
            const unsigned w00 = last ? vn00 : vc00, w01 = last ? vn01 : vc01, w10 = last ? vn10 : vc10, w11 = last ? vn11 : vc11;
            PG8_LDB(B0, 0, 0); PG8_LDB(B1, 0, 1); PG8_SCHED; PG8_LDA(At, 0, 0); PG8_STAGEA(PG8_SA(1, 1), a1, vc10, vc11);
            PG8_WAIT_V(8); PG8_WAIT_L(0); PG8_BAR; PG8_MMA(0, 0, At, B0); PG8_MMA(0, 1, At, B1); PG8_BAR; PG8_SCHED;
            PG8_LDA(At, 0, 1); PG8_STAGEB(PG8_SB(0, 0), b2); PG8_STAGEB(PG8_SB(0, 1), b2 + hstepB); PG8_STAGEA(PG8_SA(0, 0), a2, w00, w01);
            PG8_WAIT_V(8); PG8_WAIT_L(0); PG8_BAR; PG8_MMA(1, 0, At, B0); PG8_MMA(1, 1, At, B1); PG8_BAR; PG8_SCHED;
            PG8_LDB(B0, 1, 0); PG8_LDB(B1, 1, 1); PG8_SCHED; PG8_LDA(At, 1, 0); PG8_STAGEA(PG8_SA(0, 1), a2, w10, w11);
            PG8_WAIT_V(8); PG8_WAIT_L(0); PG8_BAR; PG8_MMA(0, 0, At, B0); PG8_MMA(0, 1, At, B1); PG8_BAR; PG8_SCHED;
            PG8_LDA(At, 1, 1); PG8_STAGEB(PG8_SB(1, 0), b3); PG8_STAGEB(PG8_SB(1, 1), b3 + hstepB); PG8_STAGEA(PG8_SA(1, 0), a3, w00, w01);
            PG8_WAIT_V(8); PG8_WAIT_L(0); PG8_BAR; PG8_MMA(1, 0, At, B0); PG8_MMA(1, 1, At, B1); PG8_BAR; PG8_SCHED;
        }
        if constexpr (ALIGN_EPI) { if (wr == 0) PG8_BAR; }
        E(acc, cur, wr, wc, fr, fq);
        if (!has_next) break;
#pragma unroll
        for (int a = 0; a < 2; ++a)
#pragma unroll
            for (int b = 0; b < 2; ++b)
#pragma unroll
                for (int m = 0; m < 4; ++m)
#pragma unroll
                    for (int n = 0; n < 2; ++n) acc[a][b][m][n] = (f32x4){0.f, 0.f, 0.f, 0.f};
        cur = nxt; cA = nA; cB = nB; vc00 = vn00; vc01 = vn01; vc10 = vn10; vc11 = vn11; ++ui;
        if constexpr (ALIGN_EPI) { if (wr == 1) PG8_BAR; }
    }
    PG8_WAIT_V(0);
    if constexpr (!ALIGN_EPI) { if (wr == 0) PG8_BAR; }
    PG8_BAR;
#undef PG8_SA
#undef PG8_SB
#undef PG8_STAGEA
#undef PG8_STAGEB
#undef PG8_LDA
#undef PG8_LDB
#undef PG8_MMA
#undef PG8_WAIT_V
#undef PG8_WAIT_L
#undef PG8_BAR
#undef PG8_SCHED
}

struct SchedDense {
    static constexpr bool GATHER = false;
    const char* A; const char* B; int pitchA  ; int K; int nM, nN, nwg, G, c;
    __device__ void init(const void* A_, int pitchA_, const void* B_, int M, int N, int K_, int G_, int c_) { A = (const char*)A_; B = (const char*)B_; pitchA = pitchA_; K = K_; nM = M / BM; nN = N / BM; nwg = nM * nN; G = G_; c = c_; }
    __device__ bool next(int i, Unit& u) const {
        const long L = (long)i * G + c; if (L >= nwg) return false;
        int wgid = (int)L; { const int q = nwg / NXCD, r = nwg % NXCD, xcd = wgid % NXCD, off = wgid / NXCD; wgid = (xcd < r ? xcd * (q + 1) : r * (q + 1) + (xcd - r) * q) + off; }
        const int nig = WGM * nN, gid = wgid / nig, fm = gid * WGM, gsz = (nM - fm) < WGM ? (nM - fm) : WGM;
        u.pm = fm + ((wgid % nig) % gsz); u.pn = (wgid % nig) / gsz;
        u.A = A + (size_t)u.pm * BM * pitchA; u.B = B + (size_t)u.pn * BM * K * 2; return true;
    }
    __device__ unsigned arow(const Unit&, int r) const { return (unsigned)(r * pitchA); }
};
struct SchedMoeUp {
    static constexpr bool GATHER = true;
    const char* H2; const char* W; const int* list; const int* cnt; const int* l_off; const int* l_te; int G, c;
    __device__ bool next(int i, Unit& u) const {
        const int L = i * G + c, tix = L >> 1; if (tix >= (l_off[32] >> 8)) return false;
        u.pm = tix; u.pn = L & 1; const int e = l_te[tix];
        u.A = H2; u.B = W + (size_t)e * (512 * 1024 * 2) + (size_t)u.pn * (256 * 1024 * 2); return true;
    }
    __device__ unsigned arow(const Unit& u, int r) const { const int e = l_te[u.pm]; int ri = u.pm * 256 + r - l_off[e]; if (ri >= cnt[e]) ri = 0; return (unsigned)list[(size_t)e * NTOK + ri] * 2048u; }
};
struct SchedMoeDown {
    static constexpr bool GATHER = false;
    const char* HB; const char* W; const int* l_off; const int* l_te; int G, c;
    __device__ bool next(int i, Unit& u) const {
        const int L = i * G + c, tix = L >> 2; if (tix >= (l_off[32] >> 8)) return false;
        u.pm = tix; u.pn = L & 3; const int e = l_te[tix];
        u.A = HB + (size_t)tix * (256 * 512); u.B = W + (size_t)e * (1024 * 256 * 2) + (size_t)u.pn * (256 * 256 * 2); return true;
    }
    __device__ unsigned arow(const Unit&, int r) const { return (unsigned)(r * 512); }
};

__device__ __forceinline__ float sigm(float v) { return __builtin_amdgcn_rcpf(1.f + __expf(-v)); }
struct EpiProj {
    static constexpr bool PERM = true, HOOK = false;
    bf16_t *QA, *QB, *KVC, *KVS, *KVW, *KVB, *GM;
    __device__ __forceinline__ void mid(f32x4 (&)[2][2][4][2], const Unit&, int, int, int, int) const {}
    __device__ __forceinline__ void operator()(const f32x4 (&acc)[2][2][4][2], const Unit& u, int wr, int wc, int fr, int fq) const {
        const int pn = u.pn; bf16_t* base; int ldc, colt; bool sg = false;
        if (pn < 2) { base = QA; ldc = 512; colt = pn * 256; }
        else if (pn == 2) { base = KVC; ldc = 256; colt = 0; }
        else if (pn == 3) { base = KVS; ldc = 256; colt = 0; }
        else if (pn == 4) { base = KVW; ldc = 256; colt = 0; }
        else if (pn < 7) { base = QB; ldc = 512; colt = (pn - 5) * 256; }
        else if (pn == 7) { base = KVB; ldc = 256; colt = 0; }
        else { base = GM; ldc = 2048; colt = (pn - 8) * 256; sg = true; }
        const int row0 = u.pm * BM + wr * 64 + fr, col0 = colt + wc * 32 + 8 * fq;
#pragma unroll
        for (int ai = 0; ai < 2; ++ai)
#pragma unroll
            for (int m = 0; m < 4; ++m) { bf16_t* rowp = base + (size_t)(row0 + ai * HALF + m * 16) * ldc + col0;
#pragma unroll
                for (int bj = 0; bj < 2; ++bj) { f32x4 v0 = acc[ai][bj][m][0], v1 = acc[ai][bj][m][1];
                    if (sg) { v0 = (f32x4){sigm(v0[0]), sigm(v0[1]), sigm(v0[2]), sigm(v0[3])}; v1 = (f32x4){sigm(v1[0]), sigm(v1[1]), sigm(v1[2]), sigm(v1[3])}; }
                    u32x4 w; w.x = cvt_pk_bf16(v0[0], v0[1]); w.y = cvt_pk_bf16(v0[2], v0[3]); w.z = cvt_pk_bf16(v1[0], v1[1]); w.w = cvt_pk_bf16(v1[2], v1[3]);
                    *(u32x4*)(rowp + bj * HALF) = w; } }
    }
};
struct EpiMerge {
    static constexpr bool PERM = true, HOOK = true;
    const bf16_t* GM; bf16_t* MG;
    __device__ __forceinline__ void mid(f32x4 (&acc)[2][2][4][2], const Unit& u, int wr, int wc, int fr, int fq) const {
        const int row0 = u.pm * BM + wr * 64 + fr, col0 = u.pn * BM + wc * 32 + 8 * fq;
        const GAS char* gm = (const GAS char*)GM + ((size_t)row0 * 2048 + col0) * 2;
#pragma unroll
        for (int ai = 0; ai < 2; ++ai)
#pragma unroll
            for (int m = 0; m < 4; ++m) { unsigned ro = (unsigned)(ai * HALF + m * 16) * 4096u; asm volatile("" : "+v"(ro));
#pragma unroll
                for (int bj = 0; bj < 2; ++bj) { const u32x4 ga = *(const GAS u32x4*)(gm + ro + bj * 256), gb = *(const GAS u32x4*)(gm + ro + 2048 + bj * 256);
                    const unsigned gaw[4] = {ga.x, ga.y, ga.z, ga.w}, gbw[4] = {gb.x, gb.y, gb.z, gb.w};
#pragma unroll
                    for (int q = 0; q < 4; ++q) { const float a0 = __uint_as_float(gaw[q] << 16), a1 = __uint_as_float(gaw[q] & 0xffff0000u), b0 = __uint_as_float(gbw[q] << 16), b1 = __uint_as_float(gbw[q] & 0xffff0000u);
                        acc[ai][bj][m][q >> 1][(q & 1) * 2] *= b0 * __builtin_amdgcn_rcpf(a0); acc[ai][bj][m][q >> 1][(q & 1) * 2 + 1] *= b1 * __builtin_amdgcn_rcpf(a1); } } }
    }
    __device__ __forceinline__ void operator()(const f32x4 (&acc)[2][2][4][2], const Unit& u, int wr, int wc, int fr, int fq) const {
        const int row0 = u.pm * BM + wr * 64 + fr, col0 = u.pn * BM + wc * 32 + 8 * fq;
        const GAS char* gm = (const GAS char*)GM + ((size_t)row0 * 2048 + col0) * 2;
        GAS char* mg = (GAS char*)MG + ((size_t)row0 * 1024 + col0) * 2;
#pragma unroll
        for (int ai = 0; ai < 2; ++ai)
#pragma unroll
            for (int m = 0; m < 4; ++m) { unsigned ro = (unsigned)(ai * HALF + m * 16) * 2048u; asm volatile("" : "+v"(ro));
#pragma unroll
                for (int bj = 0; bj < 2; ++bj) { const u32x4 ga = *(const GAS u32x4*)(gm + 2 * ro + bj * 256); const unsigned gaw[4] = {ga.x, ga.y, ga.z, ga.w}; float o[8];
#pragma unroll
                    for (int q = 0; q < 4; ++q) { o[2 * q] = acc[ai][bj][m][q >> 1][(q & 1) * 2] * __uint_as_float(gaw[q] << 16); o[2 * q + 1] = acc[ai][bj][m][q >> 1][(q & 1) * 2 + 1] * __uint_as_float(gaw[q] & 0xffff0000u); }
                    u32x4 w; w.x = cvt_pk_bf16(o[0], o[1]); w.y = cvt_pk_bf16(o[2], o[3]); w.z = cvt_pk_bf16(o[4], o[5]); w.w = cvt_pk_bf16(o[6], o[7]);
                    *(GAS u32x4*)(mg + ro + bj * 256) = w; } }
    }
};
struct EpiX1 {
    static constexpr bool PERM = false, HOOK = false;
    const float* x; float* out;
    __device__ __forceinline__ void mid(f32x4 (&)[2][2][4][2], const Unit&, int, int, int, int) const {}
    __device__ __forceinline__ void operator()(const f32x4 (&acc)[2][2][4][2], const Unit& u, int wr, int wc, int fr, int fq) const {
        const int row0 = u.pm * BM + wr * 64 + fr, col0 = u.pn * BM + wc * 32 + 4 * fq;
#pragma unroll
        for (int ai = 0; ai < 2; ++ai)
#pragma unroll
            for (int m = 0; m < 4; ++m) { const size_t off = (size_t)(row0 + ai * HALF + m * 16) * 1024 + col0;
#pragma unroll
                for (int bj = 0; bj < 2; ++bj)
#pragma unroll
                    for (int n = 0; n < 2; ++n) { const f32x4 bs = *(const f32x4*)(x + off + bj * HALF + n * 16); *(f32x4*)(out + off + bj * HALF + n * 16) = bs + acc[ai][bj][m][n]; } }
    }
};
struct EpiHB {
    static constexpr bool PERM = true, HOOK = false;
    bf16_t* HB;
    __device__ __forceinline__ void mid(f32x4 (&)[2][2][4][2], const Unit&, int, int, int, int) const {}
    __device__ __forceinline__ void operator()(const f32x4 (&acc)[2][2][4][2], const Unit& u, int wr, int wc, int fr, int fq) const {
        const int row0 = u.pm * BM + wr * 64 + fr, col0 = u.pn * HALF + wc * 32 + 8 * fq;
#pragma unroll
        for (int ai = 0; ai < 2; ++ai)
#pragma unroll
            for (int m = 0; m < 4; ++m) { float o[8];
#pragma unroll
                for (int n = 0; n < 2; ++n)
#pragma unroll
                    for (int j = 0; j < 4; ++j) { const float g = acc[ai][0][m][n][j]; o[n * 4 + j] = g * sigm(g) * acc[ai][1][m][n][j]; }
                u32x4 w; w.x = cvt_pk_bf16(o[0], o[1]); w.y = cvt_pk_bf16(o[2], o[3]); w.z = cvt_pk_bf16(o[4], o[5]); w.w = cvt_pk_bf16(o[6], o[7]);
                *(u32x4*)(HB + (size_t)(row0 + ai * HALF + m * 16) * 256 + col0) = w; }
    }
};
struct EpiYS {
    static constexpr bool PERM = true, HOOK = false;
    bf16_t* YS;
    __device__ __forceinline__ void mid(f32x4 (&)[2][2][4][2], const Unit&, int, int, int, int) const {}
    __device__ __forceinline__ void operator()(const f32x4 (&acc)[2][2][4][2], const Unit& u, int wr, int wc, int fr, int fq) const {
        const int row0 = u.pm * BM + wr * 64 + fr, col0 = u.pn * BM + wc * 32 + 8 * fq;
#pragma unroll
        for (int ai = 0; ai < 2; ++ai)
#pragma unroll
            for (int m = 0; m < 4; ++m) { bf16_t* rowp = YS + (size_t)(row0 + ai * HALF + m * 16) * 1024 + col0;
#pragma unroll
                for (int bj = 0; bj < 2; ++bj) { const f32x4 v0 = acc[ai][bj][m][0], v1 = acc[ai][bj][m][1];
                    u32x4 w; w.x = cvt_pk_bf16(v0[0], v0[1]); w.y = cvt_pk_bf16(v0[2], v0[3]); w.z = cvt_pk_bf16(v1[0], v1[1]); w.w = cvt_pk_bf16(v1[2], v1[3]);
                    *(u32x4*)(rowp + bj * HALF) = w; } }
    }
};
}

__device__ __forceinline__ unsigned pk2(float lo, float hi) { return (unsigned)f2bf(lo) | ((unsigned)f2bf(hi) << 16); }
struct TrItem { const float* src; bf16_t* dst; int ldw, ldt, nvalid; };
struct TrRegs { f32x4v v[8]; };
__device__ __forceinline__ void tr_load(TrRegs& t, const TrItem& it, int lane) {
  const int n4 = 4 * (lane & 7), kr = lane >> 3;
#pragma unroll
  for (int i = 0; i < 8; ++i) { if (n4 < it.nvalid) t.v[i] = *(const GAS f32x4v*)(it.src + (size_t)(kr + 8 * i) * it.ldw + n4); else t.v[i] = (f32x4v){0.f, 0.f, 0.f, 0.f}; }
}
__device__ __forceinline__ void tr_store(const TrRegs& t, const TrItem& it, LAS float* scr, int lane) {
  const int n4 = 4 * (lane & 7), kr = lane >> 3;
#pragma unroll
  for (int i = 0; i < 8; ++i) { LAS float* p = scr + (kr + 8 * i) * 33 + n4; p[0] = t.v[i].x; p[1] = t.v[i].y; p[2] = t.v[i].z; p[3] = t.v[i].w; }
  asm volatile("s_waitcnt lgkmcnt(0)" ::: "memory");
  const int c = lane & 7;
#pragma unroll
  for (int j = 0; j < 4; ++j) { const int n = (lane >> 3) + 8 * j; const LAS float* s = scr + (8 * c) * 33 + n;
    pg8::u32x4 o; o.x = pk2(s[0 * 33], s[1 * 33]); o.y = pk2(s[2 * 33], s[3 * 33]); o.z = pk2(s[4 * 33], s[5 * 33]); o.w = pk2(s[6 * 33], s[7 * 33]);
    *(GAS pg8::u32x4*)(it.dst + (size_t)n * it.ldt + 8 * c) = o; }
  asm volatile("s_waitcnt lgkmcnt(0)" ::: "memory");
}

namespace att {
typedef float f32x16 __attribute__((ext_vector_type(16)));
typedef short bf16x8 __attribute__((ext_vector_type(8)));
typedef short s16x4 __attribute__((ext_vector_type(4)));
typedef unsigned u32x4 __attribute__((ext_vector_type(4)));
constexpr float LOG2E = 1.4426950408889634f, C2 = 0.125f * LOG2E, NEG = -1e30f;
constexpr int L_KS = 0, L_VS = 16384, L_WSC = 32768, L_PS = 36864, L_SCR = 69632, L_MSK = 77824;
__device__ __forceinline__ int crow(int r, int hi) { return (r & 3) + 8 * (r >> 2) + 4 * hi; }
__device__ __forceinline__ unsigned cvtpk(float lo, float hi) { unsigned r; asm volatile("v_cvt_pk_bf16_f32 %0, %1, %2" : "=v"(r) : "v"(lo), "v"(hi)); return r; }
struct KVRegs { u32x4 k, v; };
__device__ __forceinline__ KVRegs kv_load(const bf16_t* kptr, const bf16_t* vptr, int pitch, int wid, int lane) {
  KVRegs r;
  r.k = *(const GAS u32x4*)(kptr + (size_t)lane * pitch + wid * 8);
  r.v = *(const GAS u32x4*)(vptr + (size_t)(16 * (wid & 3) + (lane >> 2)) * pitch + (wid >> 2) * 32 + (lane & 3) * 8);
  return r;
}
__device__ __forceinline__ void kv_store(LAS unsigned char* Ks, LAS unsigned char* Vs, const KVRegs& r, int wid, int lane) {
  *(LAS u32x4*)(Ks + wid * 1024 + lane * 16) = r.k;
  *(LAS u32x4*)(Vs + wid * 1024 + lane * 16) = r.v;
}
__device__ __forceinline__ void qkt(f32x16& p0, f32x16& p1, const LAS unsigned char* Ks, const bf16x8 (&qr)[4], int r32, int hi) {
  const LAS unsigned char* kb = Ks + hi * 1024 + r32 * 16;
  const f32x16 z = {0.f, 0.f, 0.f, 0.f, 0.f, 0.f, 0.f, 0.f, 0.f, 0.f, 0.f, 0.f, 0.f, 0.f, 0.f, 0.f};
  p0 = z; p1 = z;
#pragma unroll
  for (int d0 = 0; d0 < 4; ++d0) {
    const bf16x8 b0 = *(const LAS bf16x8*)(kb + d0 * 2048), b1 = *(const LAS bf16x8*)(kb + d0 * 2048 + 512);
    p0 = __builtin_amdgcn_mfma_f32_32x32x16_bf16(b0, qr[d0], p0, 0, 0, 0);
    p1 = __builtin_amdgcn_mfma_f32_32x32x16_bf16(b1, qr[d0], p1, 0, 0, 0);
  }
}
typedef short v4i16_t __attribute__((ext_vector_type(4)));
__device__ __forceinline__ s16x4 vtr(const LAS unsigned char* p) { return __builtin_bit_cast(s16x4, __builtin_amdgcn_ds_read_tr16_b64_v4i16((LAS v4i16_t*)p)); }
__device__ __forceinline__ void pv(f32x16 (&o)[2], const LAS unsigned char* Vs, const bf16x8 (&pa)[4], int lane) {
  const int hi = lane >> 5;
  const LAS unsigned char* vb = Vs + ((lane >> 4) & 1) * 32 + (lane & 3) * 8 + (4 * hi + ((lane & 15) >> 2)) * 64;
#pragma unroll
  for (int d0 = 0; d0 < 2; ++d0)
#pragma unroll
    for (int ks = 0; ks < 4; ++ks) {
      const s16x4 lo = vtr(vb + d0 * 4096 + ks * 1024), hh = vtr(vb + d0 * 4096 + ks * 1024 + 512);
      const bf16x8 vf = {lo[0], lo[1], lo[2], lo[3], hh[0], hh[1], hh[2], hh[3]};
      o[d0] = __builtin_amdgcn_mfma_f32_32x32x16_bf16(pa[ks], vf, o[d0], 0, 0, 0);
    }
}
__device__ __forceinline__ void pack_p(bf16x8 (&pa)[4], const f32x16& p0, const f32x16& p1) {
  u32x4 w0 = {cvtpk(p0[0], p0[1]), cvtpk(p0[2], p0[3]), cvtpk(p0[4], p0[5]), cvtpk(p0[6], p0[7])};
  u32x4 w1 = {cvtpk(p0[8], p0[9]), cvtpk(p0[10], p0[11]), cvtpk(p0[12], p0[13]), cvtpk(p0[14], p0[15])};
  u32x4 w2 = {cvtpk(p1[0], p1[1]), cvtpk(p1[2], p1[3]), cvtpk(p1[4], p1[5]), cvtpk(p1[6], p1[7])};
  u32x4 w3 = {cvtpk(p1[8], p1[9]), cvtpk(p1[10], p1[11]), cvtpk(p1[12], p1[13]), cvtpk(p1[14], p1[15])};
  pa[0] = __builtin_bit_cast(bf16x8, w0); pa[1] = __builtin_bit_cast(bf16x8, w1); pa[2] = __builtin_bit_cast(bf16x8, w2); pa[3] = __builtin_bit_cast(bf16x8, w3);
}
template <int MODE>
__device__ __forceinline__ float logits(f32x16& p0, f32x16& p1, float slope2, int t, int kbase, int W, bool rowsel, int hi) {
  float mt = NEG;
#pragma unroll
  for (int r = 0; r < 16; ++r) {
    const int key0 = (r & 3) + 8 * (r >> 2) + 4 * hi, key1 = key0 + 32;
    int d0, d1;
    if (MODE == 3) { d0 = t - (16 * (kbase + key0) + 31); d1 = t - (16 * (kbase + key1) + 31); } else { d0 = t - (kbase + key0); d1 = d0 - 32; }
    float s0 = fmaf(p0[r], C2, -slope2 * (float)d0), s1 = fmaf(p1[r], C2, -slope2 * (float)d1);
    if (MODE == 1) { s0 = (d0 >= 0 && d0 < W) ? s0 : NEG; s1 = (d1 >= 0 && d1 < W) ? s1 : NEG; }
    if (MODE == 2) { s0 = (rowsel && d0 >= 0) ? s0 : NEG; s1 = (rowsel && d1 >= 0) ? s1 : NEG; }
    if (MODE == 3) { s0 = (d0 >= 0 && kbase + key0 < 127) ? s0 : NEG; s1 = (d1 >= 0 && kbase + key1 < 127) ? s1 : NEG; }
    p0[r] = s0; p1[r] = s1; mt = fmaxf(mt, fmaxf(s0, s1));
  }
  return fmaxf(mt, __shfl_xor(mt, 32));
}
__device__ __forceinline__ float expo(f32x16& p0, f32x16& p1, float mref) {
  float rs = 0.f;
#pragma unroll
  for (int r = 0; r < 16; ++r) { p0[r] = __builtin_amdgcn_exp2f(p0[r] - mref); p1[r] = __builtin_amdgcn_exp2f(p1[r] - mref); rs += p0[r] + p1[r]; }
  return rs;
}
__device__ __forceinline__ void scale_rows(f32x16 (&o)[2], float f, LAS float* wsc, int r32, int hi) {
  if (hi == 0) wsc[r32] = f;
#pragma unroll
  for (int r = 0; r < 16; ++r) { const float a = wsc[crow(r, hi)]; o[0][r] *= a; o[1][r] *= a; }
}
template <int MODE>
__device__ __forceinline__ void tile_step(f32x16 (&o)[2], float& m, float& l, const bf16x8 (&qr)[4], const LAS unsigned char* Ks, const LAS unsigned char* Vs, LAS float* wsc,
                                          float slope2, int t, int kbase, int W, bool rowsel, int lane) {
  const int r32 = lane & 31, hi = lane >> 5;
  f32x16 p0, p1;
  qkt(p0, p1, Ks, qr, r32, hi);
  const float mt = logits<MODE>(p0, p1, slope2, t, kbase, W, rowsel, hi);
  const float mn = fmaxf(m, mt), alpha = __builtin_amdgcn_exp2f(m - mn), mref = mn < -1e29f ? 0.f : mn;
  m = mn;
  const float rs = expo(p0, p1, mref);
  l = l * alpha + rs;
  scale_rows(o, alpha, wsc, r32, hi);
  bf16x8 pa[4]; pack_p(pa, p0, p1);
  pv(o, Vs, pa, lane);
}
__device__ __forceinline__ void load_q(bf16x8 (&qr)[4], const bf16_t* qrow  , int hi) {
#pragma unroll
  for (int d0 = 0; d0 < 4; ++d0) qr[d0] = *(const GAS bf16x8*)(qrow + d0 * 16 + hi * 8);
}
__device__ __forceinline__ void zero_o(f32x16 (&o)[2]) {
  const f32x16 z = {0.f, 0.f, 0.f, 0.f, 0.f, 0.f, 0.f, 0.f, 0.f, 0.f, 0.f, 0.f, 0.f, 0.f, 0.f, 0.f}; o[0] = z; o[1] = z;
}

__device__ __forceinline__ void swa_unit(LAS unsigned char* lds, int b, int hkv, int qt, const bf16_t* __restrict__ QB, const bf16_t* __restrict__ KVB, const float* __restrict__ sinks, bf16_t* __restrict__ OAB) {
  const int tid = tid_fresh(), lane = tid & 63, wid = __builtin_amdgcn_readfirstlane(tid >> 6), r32 = lane & 31, hi = lane >> 5;
  const int g = wid >> 1, head = hkv * 4 + g, t0 = qt * 64, t = t0 + 32 * (wid & 1) + r32;
  const size_t tokb = (size_t)b * S;
  LAS float* wsc = (LAS float*)(lds + L_WSC) + wid * 64;
  const float slope2 = exp2f(-0.5f * (float)(1 + head)) * LOG2E, sink2 = sinks[head] * LOG2E;
  bf16x8 qr[4]; load_q(qr, QB + (tokb + t) * 512 + head * 64, hi);
  f32x16 o[2]; zero_o(o);
  float m = NEG, l = 0.f;
  const int j0 = qt >= 2 ? qt - 2 : 0, nj = qt - j0 + 1;
  const bf16_t* kp = KVB + tokb * 256 + hkv * 64; const bf16_t* vp = kp + 128;
  KVRegs kr = kv_load(kp + (size_t)j0 * 64 * 256, vp + (size_t)j0 * 64 * 256, 256, wid, lane);
  kv_store(lds + L_KS, lds + L_VS, kr, wid, lane);
  __syncthreads();
  for (int i = 0; i < nj; ++i) {
    const int j = j0 + i, sl = (i & 1) * 8192;
    if (i + 1 < nj) kr = kv_load(kp + (size_t)(j + 1) * 64 * 256, vp + (size_t)(j + 1) * 64 * 256, 256, wid, lane);
    if (j == qt - 1) tile_step<0>(o, m, l, qr, lds + L_KS + sl, lds + L_VS + sl, wsc, slope2, t, j * 64, 128, true, lane);
    else tile_step<1>(o, m, l, qr, lds + L_KS + sl, lds + L_VS + sl, wsc, slope2, t, j * 64, 128, true, lane);
    if (i + 1 < nj) kv_store(lds + L_KS + (sl ^ 8192), lds + L_VS + (sl ^ 8192), kr, wid, lane);
    __syncthreads();
  }
  float lt = l + __shfl_xor(l, 32);
  const float mf = fmaxf(m, sink2), z = lt * __builtin_amdgcn_exp2f(m - mf) + __builtin_amdgcn_exp2f(sink2 - mf);
  scale_rows(o, __builtin_amdgcn_exp2f(m - mf) / z, wsc, r32, hi);
  bf16_t* op = OAB + (tokb + t0 + 32 * (wid & 1)) * 1024 + head * 64 + r32;
#pragma unroll
  for (int r = 0; r < 16; ++r) { const int q = crow(r, hi); op[(size_t)q * 1024] = f2bf(o[0][r]); op[(size_t)q * 1024 + 32] = f2bf(o[1][r]); }
}
__device__ __forceinline__ void swa_phase(LAS unsigned char* lds, const bf16_t* QB, const bf16_t* KVB, const float* sinks, bf16_t* OAB) {
#pragma unroll 1
  for (int u = blockIdx.x; u < NB * 2 * 32; u += gridDim.x) { swa_unit(lds, u >> 6, (u >> 5) & 1, u & 31, QB, KVB, sinks, OAB); }
}

constexpr int L_OACC = 36864;
__device__ __forceinline__ void oacc_store(LAS unsigned char* lds, const f32x16 (&o)[2], int wid, int lane) {
  LAS float* p = (LAS float*)(lds + L_OACC) + wid * 2048 + lane;
#pragma unroll
  for (int r = 0; r < 16; ++r) { p[r * 64] = o[0][r]; p[1024 + r * 64] = o[1][r]; }
}
__device__ __forceinline__ void oacc_add(LAS unsigned char* lds, const f32x16 (&o)[2], int wid, int lane) {
  LAS float* p = (LAS float*)(lds + L_OACC) + wid * 2048 + lane;
#pragma unroll
  for (int r = 0; r < 16; ++r) { p[r * 64] += o[0][r]; p[1024 + r * 64] += o[1][r]; }
}
__device__ __forceinline__ void nsa_unit(LAS unsigned char* lds, int b, int hkv, int qt, const bf16_t* __restrict__ QA, const bf16_t* __restrict__ KC, const bf16_t* __restrict__ VC,
                                         const bf16_t* __restrict__ KVS, const bf16_t* __restrict__ KVW, const float* __restrict__ GN, bf16_t* __restrict__ OAB) {
  const int tid = tid_fresh(), lane = tid & 63, wid = __builtin_amdgcn_readfirstlane(tid >> 6), r32 = lane & 31, hi = lane >> 5;
  const int g = wid >> 1, qh = wid & 1, head = hkv * 4 + g, t0 = qt * 64, ql = 32 * qh + r32, t = t0 + ql;
  const size_t tokb = (size_t)b * S;
  LAS float* wsc = (LAS float*)(lds + L_WSC) + wid * 64;
  LAS float* PS = (LAS float*)(lds + L_PS);
  LAS float* SCR = (LAS float*)(lds + L_SCR);
  LAS unsigned* MSK = (LAS unsigned*)(lds + L_MSK);
  const float slope2 = exp2f(-0.5f * (float)(9 + head)) * LOG2E;
  const float* gnp = GN + (tokb + t) * 32 + hkv * 12 + g * 3;
  bf16x8 qr[4]; load_q(qr, QA + (tokb + t) * 512 + head * 64, hi);
  const int nct = (t0 + 63 >= 31 + 16 * 64) ? 2 : 1;
  f32x16 ocmp[2]; zero_o(ocmp);
  {
    const bf16_t* kp = KC + ((size_t)b * 128 * 2 + hkv) * 64; const bf16_t* vp = VC + ((size_t)b * 128 * 2 + hkv) * 64;
    { KVRegs k0 = kv_load(kp, vp, 128, wid, lane); kv_store(lds + L_KS, lds + L_VS, k0, wid, lane); }
    if (nct == 2) { KVRegs k1 = kv_load(kp + (size_t)64 * 128, vp + (size_t)64 * 128, 128, wid, lane); kv_store(lds + L_KS + 8192, lds + L_VS + 8192, k1, wid, lane); }
    if (tid < 65) MSK[tid] = 0u;
    __syncthreads();
    float m = NEG, l = 0.f;
    for (int ct = 0; ct < nct; ++ct) {
      f32x16 p0, p1;
      qkt(p0, p1, lds + L_KS + ct * 8192, qr, r32, hi);
      const float mt = logits<3>(p0, p1, slope2, t, ct * 64, 0, true, hi);
      const float mn = fmaxf(m, mt), alpha = __builtin_amdgcn_exp2f(m - mn), mref = mn < -1e29f ? 0.f : mn;
      m = mn; l = l * alpha + expo(p0, p1, mref);
    }
    l += __shfl_xor(l, 32);
    const float inv = l > 0.f ? 1.f / l : 1.f, mref = m < -1e29f ? 0.f : m;
    for (int ct = 0; ct < nct; ++ct) {
      f32x16 p0, p1;
      qkt(p0, p1, lds + L_KS + ct * 8192, qr, r32, hi);
      (void)logits<3>(p0, p1, slope2, t, ct * 64, 0, true, hi);
      (void)expo(p0, p1, mref);
#pragma unroll
      for (int r = 0; r < 16; ++r) { p0[r] *= inv; p1[r] *= inv; }
      { bf16x8 pa[4]; pack_p(pa, p0, p1); pv(ocmp, lds + L_VS + ct * 8192, pa, lane); }
      for (int gg = 0; gg < 4; ++gg) {
        if (g == gg) {
#pragma unroll
          for (int r = 0; r < 16; ++r) {
            LAS float* pr = PS + ql * 128 + ct * 64 + crow(r, hi);
            if (gg == 0) { pr[0] = p0[r]; pr[32] = p1[r]; } else { pr[0] += p0[r]; pr[32] += p1[r]; }
          }
        }
        __syncthreads();
      }
    }
    if (nct == 1) {
      if (tid < 64) { LAS float* pr = PS + tid * 128 + 64; pr[0] = 0.f; pr[1] = 0.f; pr[2] = 0.f; pr[3] = 0.f; }
    }
    scale_rows(ocmp, gnp[0], wsc, r32, hi);
    __syncthreads();
  }
  {
    const int cur = qt;
#pragma unroll
    for (int i = 0; i < 4; ++i) {
      const int pi = tid + i * 512, q = pi >> 5, j = pi & 31;
      const LAS float* pr = PS + q * 128;
      float imp = 0.f;
      if (j <= cur) {
        const int c = 4 * j;
        imp = pr[c] + pr[c + 1] + pr[c + 2] + 0.5f * (c + 3 < 127 ? pr[c + 3] : 0.f) + 0.5f * (c > 0 ? pr[c - 1] : 0.f);
      }
      const bool forced = (j == 0) || (j == cur) || (j == cur - 1);
      SCR[pi] = forced ? 1e9f : (j <= cur ? imp : NEG);
    }
    __syncthreads();
#pragma unroll
    for (int i = 0; i < 4; ++i) {
      const int pi = tid + i * 512, q = pi >> 5, j = pi & 31;
      const float sj = SCR[pi]; int rank = 0;
      for (int k = 0; k < 32; ++k) { const float sk = SCR[q * 32 + k]; rank += ((sk > sj) || (sk == sj && k < j)) ? 1 : 0; }
      if (rank < 8 && sj > -5e29f) { __hip_atomic_fetch_or(&MSK[q], 1u << j, __ATOMIC_RELAXED, __HIP_MEMORY_SCOPE_WORKGROUP); __hip_atomic_fetch_or(&MSK[64], 1u << j, __ATOMIC_RELAXED, __HIP_MEMORY_SCOPE_WORKGROUP); }
    }
    __syncthreads();
  }
  const unsigned um = MSK[64], mymask = MSK[ql];
  __syncthreads();
  oacc_store(lds, ocmp, wid, lane);
  {
    f32x16 o[2]; zero_o(o);
    float m = NEG, l = 0.f;
    const bf16_t* kp = KVS + tokb * 256 + hkv * 64; const bf16_t* vp = kp + 128;
    unsigned rem = (unsigned)__builtin_amdgcn_readfirstlane(um);
    int j = __builtin_ctz(rem); rem &= rem - 1;
    KVRegs kr = kv_load(kp + (size_t)j * 64 * 256, vp + (size_t)j * 64 * 256, 256, wid, lane);
    kv_store(lds + L_KS, lds + L_VS, kr, wid, lane);
    __syncthreads();
    int sl = 0;
    for (;;) {
      const int jn = rem ? __builtin_ctz(rem) : -1; if (rem) rem &= rem - 1;
      if (jn >= 0) kr = kv_load(kp + (size_t)jn * 64 * 256, vp + (size_t)jn * 64 * 256, 256, wid, lane);
      tile_step<2>(o, m, l, qr, lds + L_KS + sl, lds + L_VS + sl, wsc, slope2, t, j * 64, 0, ((mymask >> j) & 1u) != 0u, lane);
      if (jn >= 0) kv_store(lds + L_KS + (sl ^ 8192), lds + L_VS + (sl ^ 8192), kr, wid, lane);
      __syncthreads();
      if (jn < 0) break;
      j = jn; sl ^= 8192;
    }
    const float lt = l + __shfl_xor(l, 32), inv = lt > 0.f ? 1.f / lt : 1.f;
    scale_rows(o, inv * gnp[1], wsc, r32, hi);
    oacc_add(lds, o, wid, lane);
  }
  {
    f32x16 o[2]; zero_o(o);
    float m = NEG, l = 0.f;
    const int j0 = qt >= 4 ? qt - 4 : 0, nj = qt - j0 + 1;
    const bf16_t* kp = KVW + tokb * 256 + hkv * 64; const bf16_t* vp = kp + 128;
    KVRegs kr = kv_load(kp + (size_t)j0 * 64 * 256, vp + (size_t)j0 * 64 * 256, 256, wid, lane);
    kv_store(lds + L_KS, lds + L_VS, kr, wid, lane);
    __syncthreads();
    for (int i = 0; i < nj; ++i) {
      const int j = j0 + i, sl = (i & 1) * 8192;
      if (i + 1 < nj) kr = kv_load(kp + (size_t)(j + 1) * 64 * 256, vp + (size_t)(j + 1) * 64 * 256, 256, wid, lane);
      if (j < qt && j > qt - 4) tile_step<0>(o, m, l, qr, lds + L_KS + sl, lds + L_VS + sl, wsc, slope2, t, j * 64, 256, true, lane);
      else tile_step<1>(o, m, l, qr, lds + L_KS + sl, lds + L_VS + sl, wsc, slope2, t, j * 64, 256, true, lane);
      if (i + 1 < nj) kv_store(lds + L_KS + (sl ^ 8192), lds + L_VS + (sl ^ 8192), kr, wid, lane);
      __syncthreads();
    }
    const float lt = l + __shfl_xor(l, 32);
    scale_rows(o, gnp[2] / lt, wsc, r32, hi);
    LAS const float* p = (LAS const float*)(lds + L_OACC) + wid * 2048 + lane;
    bf16_t* op = OAB + (tokb + t0 + 32 * qh) * 1024 + 512 + head * 64 + r32;
#pragma unroll
    for (int r = 0; r < 16; ++r) { const int q = crow(r, hi); op[(size_t)q * 1024] = f2bf(o[0][r] + p[r * 64]); op[(size_t)q * 1024 + 32] = f2bf(o[1][r] + p[1024 + r * 64]); }
  }
  __syncthreads();
}
__device__ __forceinline__ void nsa_phase(LAS unsigned char* lds, const bf16_t* QA, const bf16_t* KC, const bf16_t* VC, const bf16_t* KVS, const bf16_t* KVW, const float* GN, bf16_t* OAB) {
#pragma unroll 1
  for (int pr = blockIdx.x; pr < 256; pr += gridDim.x) {
    const int bh = pr >> 4, s = pr & 15;
#pragma unroll 1
    for (int i = 0; i < 2; ++i) nsa_unit(lds, bh >> 1, bh & 1, i == 0 ? 31 - s : s, QA, KC, VC, KVS, KVW, GN, OAB);
  }
}
}


namespace wg {
using att::f32x16; using att::bf16x8; using att::crow;
typedef short s16x4 __attribute__((ext_vector_type(4)));
template <int NI, int UNR>
__device__ __forceinline__ void wave_gemm(f32x16 (&acc)[NI], const bf16_t* wl, int ldw, const bf16_t* xl, int ksteps) {
  for (int ks = 0; ks < ksteps; ks += UNR) {
    bf16x8 a[UNR][NI], b[UNR];
#pragma unroll
    for (int u = 0; u < UNR; ++u) { b[u] = *(const GAS bf16x8*)(xl + (ks + u) * 16);
#pragma unroll
      for (int i = 0; i < NI; ++i) a[u][i] = *(const GAS bf16x8*)(wl + (size_t)i * 32 * ldw + (ks + u) * 16); }
#pragma unroll
    for (int u = 0; u < UNR; ++u)
#pragma unroll
      for (int i = 0; i < NI; ++i) acc[i] = __builtin_amdgcn_mfma_f32_32x32x16_bf16(a[u][i], b[u], acc[i], 0, 0, 0);
  }
}
constexpr int L_RED = 0;
__device__ __forceinline__ void cmp_unit(LAS unsigned char* lds, int sel, int rt, const bf16_t* __restrict__ KVC, const bf16_t* __restrict__ W1T, const float* __restrict__ bias1,
                                         const bf16_t* __restrict__ W2T, bf16_t* __restrict__ KCout) {
  const int tid = tid_fresh(), lane = tid & 63, wid = __builtin_amdgcn_readfirstlane(tid >> 6), r32 = lane & 31, hi = lane >> 5;
  int m = rt * 32 + r32; if (m > 2031) m = 2031;
  const int hh = m & 1, bc = m >> 1, b = bc / 127, c = bc - b * 127;
  const bf16_t* xl = KVC + ((size_t)b * S + 16 * c) * 256 + sel * 128 + hh * 64 + 8 * hi;
  const bf16_t* wl = W1T + (size_t)(32 * wid + r32) * 2048 + 8 * hi;
  const f32x16 z = {0.f, 0.f, 0.f, 0.f, 0.f, 0.f, 0.f, 0.f, 0.f, 0.f, 0.f, 0.f, 0.f, 0.f, 0.f, 0.f};
  f32x16 acc = z;
#pragma unroll 1
  for (int i = 0; i < 32; i += 2) {
    bf16x8 a[8], bb[8];
#pragma unroll
    for (int u = 0; u < 8; ++u) { bb[u] = *(const GAS bf16x8*)(xl + (size_t)(i + (u >> 2)) * 256 + (u & 3) * 16); a[u] = *(const GAS bf16x8*)(wl + (i + (u >> 2)) * 64 + (u & 3) * 16); }
#pragma unroll
    for (int u = 0; u < 8; ++u) acc = __builtin_amdgcn_mfma_f32_32x32x16_bf16(a[u], bb[u], acc, 0, 0, 0);
  }
  unsigned pw[8];
#pragma unroll
  for (int r = 0; r < 16; r += 2) {
    float v0 = acc[r] + bias1[32 * wid + crow(r, hi)], v1 = acc[r + 1] + bias1[32 * wid + crow(r + 1, hi)];
    v0 = v0 * __builtin_amdgcn_rcpf(1.f + __expf(-v0)); v1 = v1 * __builtin_amdgcn_rcpf(1.f + __expf(-v1));
    pw[r >> 1] = att::cvtpk(v0, v1);
  }
  const att::u32x4 q0 = {pw[0], pw[1], pw[2], pw[3]}, q1 = {pw[4], pw[5], pw[6], pw[7]};
  const bf16x8 pb0 = __builtin_bit_cast(bf16x8, q0), pb1 = __builtin_bit_cast(bf16x8, q1);
  f32x16 y[2]; y[0] = z; y[1] = z;
#pragma unroll
  for (int db = 0; db < 2; ++db)
#pragma unroll
    for (int s = 0; s < 2; ++s) {
      const bf16_t* wp = W2T + (size_t)(32 * db + r32) * 256 + 32 * wid + 16 * s + 4 * hi;
      const s16x4 lo = *(const GAS s16x4*)wp, hh2 = *(const GAS s16x4*)(wp + 8);
      const bf16x8 af = {lo[0], lo[1], lo[2], lo[3], hh2[0], hh2[1], hh2[2], hh2[3]};
      y[db] = __builtin_amdgcn_mfma_f32_32x32x16_bf16(af, s == 0 ? pb0 : pb1, y[db], 0, 0, 0);
    }
  LAS float* red = (LAS float*)(lds + L_RED);
#pragma unroll
  for (int r = 0; r < 16; ++r) { red[wid * 2048 + r * 64 + lane] = y[0][r]; red[wid * 2048 + 1024 + r * 64 + lane] = y[1][r]; }
  __syncthreads();
#pragma unroll
  for (int i = 0; i < 4; ++i) {
    const int e = tid + 512 * i; float sum = 0.f;
#pragma unroll
    for (int w = 0; w < 8; ++w) sum += red[w * 2048 + e];
    const int db = e >> 10, r = (e >> 6) & 15, ln = e & 63, d = 32 * db + crow(r, ln >> 5), mm = rt * 32 + (ln & 31);
    if (mm < 2032) { const int h2 = mm & 1, bc2 = mm >> 1, b2 = bc2 / 127, c2 = bc2 - b2 * 127; KCout[(((size_t)b2 * 128 + c2) * 2 + h2) * 64 + d] = f2bf(sum); }
  }
  __syncthreads();
}
__device__ __forceinline__ void cmp_bias_part(LAS unsigned char* lds, int jb, const float* __restrict__ pos, const float* __restrict__ w1, float* __restrict__ PB) {
  const int tid = tid_fresh(), n = tid & 255, kh = tid >> 8, chunk = jb & 31, k0 = chunk * 64 + kh * 32;
  float s = 0.f;
#pragma unroll
  for (int i = 0; i < 32; ++i) s += pos[k0 + i] * w1[(size_t)(k0 + i) * 256 + n];
  LAS float* part = (LAS float*)lds;
  if (kh) part[n] = s;
  __syncthreads();
  if (!kh) PB[(size_t)chunk * 256 + n] = s + part[n];
  __syncthreads();
}
__device__ __forceinline__ void cmp_bias_final(const float* __restrict__ PB, float* __restrict__ bias1) {
  const int tid = tid_fresh(); float s = 0.f;
#pragma unroll
  for (int c = 0; c < 32; ++c) s += PB[((size_t)(tid >> 8) * 32 + c) * 256 + (tid & 255)];
  bias1[tid] = s;
}
__device__ __forceinline__ void gn_rows(int row0, const bf16_t* __restrict__ XN, const bf16_t* __restrict__ WgnT, float* __restrict__ GN) {
  const int tid = tid_fresh(), lane = tid & 63, wid = __builtin_amdgcn_readfirstlane(tid >> 6), r32 = lane & 31, hi = lane >> 5;
  if (wid < 2) {
    const int row = row0 + 32 * wid + r32;
    f32x16 acc[1]; acc[0] = (f32x16){0.f, 0.f, 0.f, 0.f, 0.f, 0.f, 0.f, 0.f, 0.f, 0.f, 0.f, 0.f, 0.f, 0.f, 0.f, 0.f};
    wave_gemm<1, 8>(acc, WgnT + (size_t)r32 * 1024 + 8 * hi, 1024, XN + (size_t)row * 1024 + 8 * hi, 64);
#pragma unroll
    for (int r = 0; r < 16; ++r) { const int col = crow(r, hi); if (col < 24) GN[(size_t)row * 32 + col] = 1.f / (1.f + __expf(-acc[0][r])); }
  }
}
}


namespace rt {
using att::f32x16; using att::bf16x8; using att::crow;
constexpr int L_RED = 0, L_LG = 65536;
__device__ __forceinline__ void router_rows(LAS unsigned char* lds, int row0, const float* __restrict__ x1, const float* __restrict__ gf, const float* __restrict__ bg, const float* __restrict__ be,
                                            const bf16_t* __restrict__ WrtHi, const bf16_t* __restrict__ WrtLo, bf16_t* __restrict__ H2, bf16_t* __restrict__ H2LO, int* __restrict__ cnt, int* __restrict__ sm, int* __restrict__ list) {
  const int tid = tid_fresh(), lane = tid & 63, wid = __builtin_amdgcn_readfirstlane(tid >> 6), r32 = lane & 31, hi = lane >> 5;
  {
    f32x4v v[8][4];
#pragma unroll
    for (int rr = 0; rr < 8; ++rr) { const GAS f32x4v* xr = (const GAS f32x4v*)(x1 + (size_t)(row0 + wid * 8 + rr) * D);
#pragma unroll
      for (int j = 0; j < 4; ++j) v[rr][j] = xr[lane + 64 * j]; }
    f32x4v gg[4];
#pragma unroll
    for (int j = 0; j < 4; ++j) gg[j] = ((const GAS f32x4v*)gf)[lane + 64 * j];
    float s[8];
#pragma unroll
    for (int rr = 0; rr < 8; ++rr) { float t = 0.f;
#pragma unroll
      for (int j = 0; j < 4; ++j) t += v[rr][j].x * v[rr][j].x + v[rr][j].y * v[rr][j].y + v[rr][j].z * v[rr][j].z + v[rr][j].w * v[rr][j].w;
      s[rr] = wave_sum(t); }
#pragma unroll
    for (int rr = 0; rr < 8; ++rr) {
      const int r = row0 + wid * 8 + rr; const float rstd = rsqrtf(s[rr] * (1.f / D) + 1e-6f);
#pragma unroll
      for (int j = 0; j < 4; ++j) {
        const f32x4v h = v[rr][j] * rstd * gg[j];
        u16x4v hh, lo;
        hh.x = f2bf(h.x); hh.y = f2bf(h.y); hh.z = f2bf(h.z); hh.w = f2bf(h.w);
        lo.x = f2bf(h.x - bf2f(hh.x)); lo.y = f2bf(h.y - bf2f(hh.y)); lo.z = f2bf(h.z - bf2f(hh.z)); lo.w = f2bf(h.w - bf2f(hh.w));
        ((GAS u16x4v*)(H2 + (size_t)r * D))[lane + 64 * j] = hh;
        ((GAS u16x4v*)(H2LO + (size_t)r * D))[lane + 64 * j] = lo;
      }
    }
  }
  __syncthreads();
  {
    const int rb = wid & 1, kq = wid >> 1, row = row0 + 32 * rb + r32;
    const f32x16 z = {0.f, 0.f, 0.f, 0.f, 0.f, 0.f, 0.f, 0.f, 0.f, 0.f, 0.f, 0.f, 0.f, 0.f, 0.f, 0.f};
    f32x16 acc[2]; acc[0] = z; acc[1] = z;
    const bf16_t* xh = H2 + (size_t)row * D + kq * 256 + 8 * hi; const bf16_t* xl = H2LO + (size_t)row * D + kq * 256 + 8 * hi;
    const bf16_t* wh = WrtHi + (size_t)r32 * D + kq * 256 + 8 * hi; const bf16_t* wl = WrtLo + (size_t)r32 * D + kq * 256 + 8 * hi;
#pragma unroll 1
    for (int ks = 0; ks < 16; ks += 4) {
      bf16x8 bh[4], bl[4], ah[4][2], al[4][2];
#pragma unroll
      for (int u = 0; u < 4; ++u) { bh[u] = *(const GAS bf16x8*)(xh + (ks + u) * 16); bl[u] = *(const GAS bf16x8*)(xl + (ks + u) * 16);
#pragma unroll
        for (int cb = 0; cb < 2; ++cb) { ah[u][cb] = *(const GAS bf16x8*)(wh + (size_t)cb * 32 * D + (ks + u) * 16); al[u][cb] = *(const GAS bf16x8*)(wl + (size_t)cb * 32 * D + (ks + u) * 16); } }
#pragma unroll
      for (int u = 0; u < 4; ++u)
#pragma unroll
        for (int cb = 0; cb < 2; ++cb) {
          acc[cb] = __builtin_amdgcn_mfma_f32_32x32x16_bf16(al[u][cb], bh[u], acc[cb], 0, 0, 0);
          acc[cb] = __builtin_amdgcn_mfma_f32_32x32x16_bf16(ah[u][cb], bl[u], acc[cb], 0, 0, 0);
          acc[cb] = __builtin_amdgcn_mfma_f32_32x32x16_bf16(ah[u][cb], bh[u], acc[cb], 0, 0, 0);
        }
    }
    LAS float* red = (LAS float*)(lds + L_RED) + ((kq * 2 + rb) * 2) * 1024 + lane;
#pragma unroll
    for (int r = 0; r < 16; ++r) { red[r * 64] = acc[0][r]; red[1024 + r * 64] = acc[1][r]; }
  }
  __syncthreads();
  {
    LAS const float* red = (LAS const float*)(lds + L_RED);
    LAS float* lg = (LAS float*)(lds + L_LG);
#pragma unroll
    for (int i = 0; i < 8; ++i) {
      const int e = tid + 512 * i;
      const float sum = (red[e] + red[4096 + e]) + (red[8192 + e] + red[12288 + e]);
      const int ln = e & 63, r = (e >> 6) & 15, cb = (e >> 10) & 1, rb = e >> 11;
      lg[(32 * rb + (ln & 31)) * 64 + 32 * cb + crow(r, ln >> 5)] = sum;
    }
  }
  __syncthreads();
  if (tid < 64) {
    const int r = row0 + tid; LAS const float* lgr = (LAS const float*)(lds + L_LG) + tid * 64;
    int grp = 0; float gmax = -1e30f; float gl[4];
#pragma unroll
    for (int j = 0; j < 4; ++j) { gl[j] = lgr[j] + bg[j]; if (gl[j] > gmax) { gmax = gl[j]; grp = j; } }
    float zs = 0.f;
#pragma unroll
    for (int j = 0; j < 4; ++j) zs += __expf(gl[j] - gmax);
    const float pgrp = 1.f / zs;
    int i1 = 0; float v1 = -1e30f;
    for (int i = 0; i < 8; ++i) { const float e = lgr[4 + grp * 8 + i] + be[grp * 8 + i]; if (e > v1) { v1 = e; i1 = i; } }
    int i2 = 0; float v2 = -1e30f;
    for (int i = 0; i < 8; ++i) { const float e = lgr[4 + grp * 8 + i] + be[grp * 8 + i]; if (i != i1 && e > v2) { v2 = e; i2 = i; } }
    const float e2 = __expf(v2 - v1), w1 = 1.f / (1.f + e2), w2 = e2 * w1;
    const int e_a = grp * 8 + i1, e_b = grp * 8 + i2;
    const int ra = atomicAdd(&cnt[e_a], 1), rb = atomicAdd(&cnt[e_b], 1);
    sm[SM_EID + 2 * r] = e_a; sm[SM_EID + 2 * r + 1] = e_b;
    ((float*)sm)[SM_WT + 2 * r] = pgrp * w1; ((float*)sm)[SM_WT + 2 * r + 1] = pgrp * w2;
    sm[SM_RANK + 2 * r] = ra; sm[SM_RANK + 2 * r + 1] = rb;
    list[(size_t)e_a * NTOK + ra] = r; list[(size_t)e_b * NTOK + rb] = r;
  }
  __syncthreads();
}
}

__device__ __forceinline__ void ph_prep_xn(const float* __restrict__ x, const float* __restrict__ g, bf16_t* __restrict__ xn) {
  const int tid_ = tid_fresh(), lane = tid_ & 63, wave = (blockIdx.x * 512 + tid_) >> 6, nw = (gridDim.x * 512) >> 6;
  f32x4v gg[4];
#pragma unroll
  for (int j = 0; j < 4; ++j) gg[j] = ((const GAS f32x4v*)g)[lane + 64 * j];
#pragma unroll 1
  for (int r = wave * 4; r < NTOK; r += nw * 4) {
    f32x4v v[4][4]; float s[4];
#pragma unroll
    for (int q = 0; q < 4; ++q) { const GAS f32x4v* xr = (const GAS f32x4v*)(x + (size_t)(r + q) * D);
#pragma unroll
      for (int j = 0; j < 4; ++j) v[q][j] = xr[lane + 64 * j]; }
#pragma unroll
    for (int q = 0; q < 4; ++q) { float t = 0.f;
#pragma unroll
      for (int j = 0; j < 4; ++j) t += v[q][j].x * v[q][j].x + v[q][j].y * v[q][j].y + v[q][j].z * v[q][j].z + v[q][j].w * v[q][j].w;
      s[q] = wave_sum(t); }
#pragma unroll
    for (int q = 0; q < 4; ++q) { const float rstd = rsqrtf(s[q] * (1.f / D) + 1e-6f);
#pragma unroll
      for (int j = 0; j < 4; ++j) {
        u16x4v o; o.x = f2bf(v[q][j].x * rstd * gg[j].x); o.y = f2bf(v[q][j].y * rstd * gg[j].y); o.z = f2bf(v[q][j].z * rstd * gg[j].z); o.w = f2bf(v[q][j].w * rstd * gg[j].w);
        ((GAS u16x4v*)(xn + (size_t)(r + q) * D))[lane + 64 * j] = o; } }
  }
}

template <class AL, class BL, class EP>
__device__ __forceinline__ void naive_gemm_phase(unsigned char* lds, const AL al, const BL bl, const EP ep, int K, int ntm, int ntn) {
  const int tid_ = tid_fresh(), half = tid_ >> 8, tid = tid_ & 255, tx = tid & 15, ty = tid >> 4;
  float (*As)[68] = (float (*)[68])(lds + half * 8704);
  float (*Bs)[68] = As + 16;
  const int ntiles = ntm * ntn;
  for (int it0 = blockIdx.x * 2; it0 < ntiles; it0 += 2 * gridDim.x) {
    const int it = it0 + half, tm = it / ntn, tn = it - tm * ntn, m0 = tm * 64, n0 = tn * 64;
    const bool act = it < ntiles && al.active(m0);
    float acc[4][4];
#pragma unroll
    for (int i = 0; i < 4; ++i)
#pragma unroll
      for (int j = 0; j < 4; ++j) acc[i][j] = 0.f;
    for (int k0 = 0; k0 < K; k0 += 16) {
#pragma unroll
      for (int i = 0; i < 4; ++i) { const int e = tid + i * 256, r = e >> 4, kk = e & 15; As[kk][r] = act ? al(m0 + r, k0 + kk) : 0.f; }
#pragma unroll
      for (int i = 0; i < 4; ++i) { const int e = tid + i * 256, kk = e >> 6, c = e & 63; Bs[kk][c] = act ? bl(m0, k0 + kk, n0 + c) : 0.f; }
      __syncthreads();
#pragma unroll
      for (int kk = 0; kk < 16; ++kk) {
        const float4 a = *(const float4*)&As[kk][ty * 4];
        const float4 b = *(const float4*)&Bs[kk][tx * 4];
        const float av[4] = {a.x, a.y, a.z, a.w}, bv[4] = {b.x, b.y, b.z, b.w};
#pragma unroll
        for (int i = 0; i < 4; ++i)
#pragma unroll
          for (int j = 0; j < 4; ++j) acc[i][j] += av[i] * bv[j];
      }
      __syncthreads();
    }
    if (act) {
#pragma unroll
      for (int i = 0; i < 4; ++i)
#pragma unroll
        for (int j = 0; j < 4; ++j) ep(m0 + ty * 4 + i, n0 + tx * 4 + j, acc[i][j]);
    }
  }
}

struct AL_bf16 { const bf16_t* A; int lda, M; __device__ bool active(int) const { return true; } __device__ float operator()(int m, int k) const { return m < M ? bf2f(A[(size_t)m * lda + k]) : 0.f; } };
struct AL_f32 { const float* A; int lda, M; __device__ bool active(int) const { return true; } __device__ float operator()(int m, int k) const { return m < M ? A[(size_t)m * lda + k] : 0.f; } };
struct BL_f32 { const float* B; int ldb, N; __device__ float operator()(int, int k, int n) const { return n < N ? B[(size_t)k * ldb + n] : 0.f; } };
struct EP_proj {
  bf16_t *QA, *QB, *KVC, *KVS, *KVW, *KVB, *GM; float* GN;
  __device__ void operator()(int m, int c, float v) const {
    if (c >= INW) return;
    if (c < 512) QA[(size_t)m * 512 + c] = f2bf(v);
    else if (c < 768) KVC[(size_t)m * 256 + (c - 512)] = f2bf(v);
    else if (c < 1024) KVS[(size_t)m * 256 + (c - 768)] = f2bf(v);
    else if (c < 1280) KVW[(size_t)m * 256 + (c - 1024)] = f2bf(v);
    else if (c < 1304) GN[(size_t)m * 32 + (c - 1280)] = sigmoidf_(v);
    else if (c < 1816) QB[(size_t)m * 512 + (c - 1304)] = f2bf(v);
    else if (c < 2072) KVB[(size_t)m * 256 + (c - 1816)] = f2bf(v);
    else GM[(size_t)m * 2048 + (c - 2072)] = f2bf(sigmoidf_(v));
  }
};
struct AL_cmp { const bf16_t* KVC; const float* pos; int sel; __device__ bool active(int) const { return true; }
  __device__ float operator()(int m, int k) const { if (m >= 2032) return 0.f; const int h = m & 1, bc = m >> 1, b = bc / 127, c = bc % 127, i = k >> 6, d = k & 63;
    return bf2f(KVC[((size_t)b * S + 16 * c + i) * 256 + sel * 128 + h * 64 + d]) + pos[k]; } };
struct EP_silu { float* T; int M, N; __device__ void operator()(int m, int n, float v) const { if (m < M && n < N) T[(size_t)m * N + n] = v / (1.f + __expf(-v)); } };
struct EP_kc { bf16_t* KC; __device__ void operator()(int m, int n, float v) const { if (m >= 2032 || n >= 64) return; const int h = m & 1, bc = m >> 1, b = bc / 127, c = bc % 127; KC[(((size_t)b * 128 + c) * 2 + h) * 64 + n] = f2bf(v); } };
struct EP_mg1 { float* tmp; const bf16_t* GM; __device__ void operator()(int m, int n, float v) const { tmp[(size_t)m * 1024 + n] = bf2f(GM[(size_t)m * 2048 + n]) * v; } };
struct EP_mg2 { const float* tmp; const bf16_t* GM; bf16_t* MG; __device__ void operator()(int m, int n, float v) const { MG[(size_t)m * 1024 + n] = f2bf(tmp[(size_t)m * 1024 + n] + bf2f(GM[(size_t)m * 2048 + 1024 + n]) * v); } };
struct EP_x1 { const float* x; float* out; __device__ void operator()(int m, int n, float v) const { out[(size_t)m * 1024 + n] = x[(size_t)m * 1024 + n] + v; } };
struct AL_moe { const bf16_t* H2; const int* list; const int* cnt; const int* l_off; const int* l_te; __device__ bool active(int m0) const { return l_te[m0 >> 8] >= 0; }
  __device__ float operator()(int m, int k) const { const int e = l_te[m >> 8], r = m - l_off[e]; if (r >= cnt[e]) return 0.f; const int t = list[(size_t)e * NTOK + r]; return bf2f(H2[(size_t)t * 1024 + k]); } };
struct BL_moe { const float* W; const int* l_te; int K, N; __device__ float operator()(int m0, int k, int n) const { const int e = l_te[m0 >> 8]; return W[((size_t)e * K + k) * N + n]; } };
struct EP_g { float* G; __device__ void operator()(int m, int n, float v) const { G[(size_t)m * 256 + n] = v; } };
struct EP_hb { const float* G; bf16_t* HB; __device__ void operator()(int m, int n, float v) const { const float g = G[(size_t)m * 256 + n]; HB[(size_t)m * 256 + n] = f2bf(g / (1.f + __expf(-g)) * v); } };
struct AL_hb { const bf16_t* HB; const int* l_te; __device__ bool active(int m0) const { return l_te[m0 >> 8] >= 0; } __device__ float operator()(int m, int k) const { return bf2f(HB[(size_t)m * 256 + k]); } };
struct EP_ys { bf16_t* YS; __device__ void operator()(int m, int n, float v) const { YS[(size_t)m * 1024 + n] = f2bf(v); } };

__device__ __forceinline__ void moe_tables(const int* cnt, int* l_off, int* l_te) {
  __syncthreads();
  if (threadIdx.x == 0) {
    int off = 0;
    for (int e = 0; e < 32; ++e) { l_off[e] = off; const int c = __hip_atomic_load(cnt + e, __ATOMIC_RELAXED, __HIP_MEMORY_SCOPE_AGENT); const int nt = (c + 255) >> 8; for (int i = 0; i < nt; ++i) l_te[(off >> 8) + i] = e; off += nt << 8; }
    l_off[32] = off;
    for (int i = off >> 8; i < NSLOT / 256; ++i) l_te[i] = -1;
  }
  __syncthreads();
}

__device__ __forceinline__ void naive_nsa_phase(unsigned char* lds, const bf16_t* __restrict__ QA, const bf16_t* __restrict__ KC, const bf16_t* __restrict__ VC, const bf16_t* __restrict__ KVS,
                                                const bf16_t* __restrict__ KVW, const float* __restrict__ GN, bf16_t* __restrict__ OA) {
  const int tid_ = tid_fresh(), half = tid_ >> 8, tid = tid_ & 255, g = tid >> 6, lane = tid & 63;
  unsigned char* base = lds + half * 12288;
  float (*q)[64] = (float (*)[64])base;
  float (*pc)[128] = (float (*)[128])(base + 1024);
  float (*sc)[512] = (float (*)[512])(base + 3072);
  float* sscore = (float*)(base + 11264);
  int* sel_idx = (int*)(base + 11264 + 128);
  int* sel_valid = (int*)(base + 11264 + 160);
  for (int item = blockIdx.x * 2 + half; item < NB * 2 * S; item += 2 * gridDim.x) {
    const int t = item & 2047, hkv = (item >> 11) & 1, b = item >> 12, head = hkv * 4 + g;
    const float slope = exp2f(-0.5f * (float)(9 + head));
    const size_t row = (size_t)b * S + t;
    q[g][lane] = bf2f(QA[row * 512 + head * 64 + lane]) * 0.125f;
    __syncthreads();
    {
      float sv[2]; bool vv[2]; float m = -1e30f;
#pragma unroll
      for (int i = 0; i < 2; ++i) {
        const int c = lane + 64 * i, dist = t - (16 * c + 31); vv[i] = (c < 127) && dist >= 0; float s = 0.f;
        if (vv[i]) { const bf16_t* kr = KC + (((size_t)b * 128 + c) * 2 + hkv) * 64; for (int d = 0; d < 64; ++d) s += q[g][d] * bf2f(kr[d]); s -= slope * (float)dist; m = fmaxf(m, s); }
        sv[i] = s;
      }
      m = wave_max(m);
      float z = 0.f;
#pragma unroll
      for (int i = 0; i < 2; ++i) { sv[i] = vv[i] ? __expf(sv[i] - m) : 0.f; z += sv[i]; }
      z = wave_sum(z);
      const float inv = z > 0.f ? 1.f / z : 1.f;
#pragma unroll
      for (int i = 0; i < 2; ++i) pc[g][lane + 64 * i] = sv[i] * inv;
    }
    __syncthreads();
    float ocmp = 0.f;
    {
      int ncv = (t >= 31) ? (t - 31) / 16 + 1 : 0; if (ncv > 127) ncv = 127;
      for (int c = 0; c < ncv; ++c) ocmp += pc[g][c] * bf2f(VC[(((size_t)b * 128 + c) * 2 + hkv) * 64 + lane]);
    }
    if (tid < 32) {
      const int j = tid;
      float ps[5];
#pragma unroll
      for (int u = 0; u < 5; ++u) { const int c = 4 * j - 1 + u; ps[u] = (c >= 0 && c < 127) ? (pc[0][c] + pc[1][c] + pc[2][c] + pc[3][c]) : 0.f; }
      const float imp = 0.5f * ps[0] + ps[1] + ps[2] + ps[3] + 0.5f * ps[4];
      const int cur = t >> 6; const bool forced = (j == 0) || (j == cur) || (j == cur - 1), valid = j <= cur;
      sscore[j] = forced ? 1e9f : (valid ? imp : -1e30f);
    }
    __syncthreads();
    if (tid < 32) {
      const int j = tid; const float sj = sscore[j]; int rank = 0;
      for (int i = 0; i < 32; ++i) { const float si = sscore[i]; rank += ((si > sj) || (si == sj && i < j)) ? 1 : 0; }
      if (rank < 8) { sel_idx[rank] = j; sel_valid[rank] = sj > -5e29f ? 1 : 0; }
    }
    __syncthreads();
    float oslc = 0.f;
    {
      float s8[8]; float m = -1e30f;
#pragma unroll
      for (int i = 0; i < 8; ++i) {
        const int kpos = sel_idx[i] * 64 + lane; const bool ok = sel_valid[i] && kpos <= t; float s = -1e30f;
        if (ok) { const bf16_t* kr = KVS + ((size_t)b * S + kpos) * 256 + hkv * 64; s = 0.f; for (int d = 0; d < 64; ++d) s += q[g][d] * bf2f(kr[d]); s -= slope * (float)(t - kpos); m = fmaxf(m, s); }
        s8[i] = s;
      }
      m = wave_max(m);
      float z = 0.f;
#pragma unroll
      for (int i = 0; i < 8; ++i) { const float p = s8[i] > -5e29f ? __expf(s8[i] - m) : 0.f; sc[g][i * 64 + lane] = p; z += p; }
      z = wave_sum(z);
      __syncthreads();
      for (int i = 0; i < 8; ++i) {
        if (!sel_valid[i]) continue;
        const int k0 = sel_idx[i] * 64;
        for (int l = 0; l < 64; ++l) { const int kpos = k0 + l; if (kpos > t) break; oslc += sc[g][i * 64 + l] * bf2f(KVS[((size_t)b * S + kpos) * 256 + 128 + hkv * 64 + lane]); }
      }
      oslc *= (z > 0.f ? 1.f / z : 1.f);
      __syncthreads();
    }
    float owin = 0.f;
    {
      float s4[4]; float m = -1e30f;
#pragma unroll
      for (int i = 0; i < 4; ++i) {
        const int dist = lane + 64 * i, kpos = t - dist; float s = -1e30f;
        if (kpos >= 0) { const bf16_t* kr = KVW + ((size_t)b * S + kpos) * 256 + hkv * 64; s = 0.f; for (int d = 0; d < 64; ++d) s += q[g][d] * bf2f(kr[d]); s -= slope * (float)dist; m = fmaxf(m, s); }
        s4[i] = s;
      }
      m = wave_max(m);
      float z = 0.f;
#pragma unroll
      for (int i = 0; i < 4; ++i) { const float p = s4[i] > -5e29f ? __expf(s4[i] - m) : 0.f; sc[g][i * 64 + lane] = p; z += p; }
      z = wave_sum(z);
      __syncthreads();
      for (int dist = 0; dist < 256; ++dist) { const int kpos = t - dist; if (kpos < 0) break; owin += sc[g][dist] * bf2f(KVW[((size_t)b * S + kpos) * 256 + 128 + hkv * 64 + lane]); }
      owin /= z;
    }
    const float* gn = GN + row * 32 + hkv * 12 + g * 3;
    OA[row * 1024 + 512 + head * 64 + lane] = f2bf(gn[0] * ocmp + gn[1] * oslc + gn[2] * owin);
    __syncthreads();
  }
}

__device__ __forceinline__ void naive_swa_phase(unsigned char* lds, const bf16_t* __restrict__ QB, const bf16_t* __restrict__ KVB, const float* __restrict__ sinks, bf16_t* __restrict__ OB) {
  const int tid_ = tid_fresh(), half = tid_ >> 8, tid = tid_ & 255, g = tid >> 6, lane = tid & 63;
  unsigned char* base = lds + half * 4096;
  float (*q)[64] = (float (*)[64])base;
  float (*sc)[128] = (float (*)[128])(base + 1024);
  for (int item = blockIdx.x * 2 + half; item < NB * 2 * S; item += 2 * gridDim.x) {
    const int t = item & 2047, hkv = (item >> 11) & 1, b = item >> 12, head = hkv * 4 + g;
    const float slope = exp2f(-0.5f * (float)(1 + head));
    const float sink = sinks[head];
    const size_t row = (size_t)b * S + t;
    q[g][lane] = bf2f(QB[row * 512 + head * 64 + lane]) * 0.125f;
    __syncthreads();
    float s2[2]; float m = sink;
#pragma unroll
    for (int i = 0; i < 2; ++i) {
      const int dist = lane + 64 * i, kpos = t - dist; float s = -1e30f;
      if (kpos >= 0) { const bf16_t* kr = KVB + ((size_t)b * S + kpos) * 256 + hkv * 64; s = 0.f; for (int d = 0; d < 64; ++d) s += q[g][d] * bf2f(kr[d]); s -= slope * (float)dist; m = fmaxf(m, s); }
      s2[i] = s;
    }
    m = wave_max(m);
    float z = 0.f;
#pragma unroll
    for (int i = 0; i < 2; ++i) { const float p = s2[i] > -5e29f ? __expf(s2[i] - m) : 0.f; sc[g][i * 64 + lane] = p; z += p; }
    z = wave_sum(z) + __expf(sink - m);
    __syncthreads();
    float o = 0.f;
    for (int dist = 0; dist < 128; ++dist) { const int kpos = t - dist; if (kpos < 0) break; o += sc[g][dist] * bf2f(KVB[((size_t)b * S + kpos) * 256 + 128 + hkv * 64 + lane]); }
    OB[row * 1024 + head * 64 + lane] = f2bf(o / z);
    __syncthreads();
  }
}

__device__ __forceinline__ void ph_router(unsigned char* lds, const float* __restrict__ x1, const float* __restrict__ gf, const float* __restrict__ wg, const float* __restrict__ bg, const float* __restrict__ we,
                                          const float* __restrict__ be, bf16_t* __restrict__ H2, bf16_t* __restrict__ H2LO, int* __restrict__ cnt, int* __restrict__ sm, int* __restrict__ list) {
  const int tid_ = tid_fresh(), lane = tid_ & 63, wl = tid_ >> 6, wave = (blockIdx.x * 512 + tid_) >> 6, nw = (gridDim.x * 512) >> 6;
  float* hs = (float*)lds + wl * 1024;
  float* lgs = (float*)(lds + 32768) + wl * 64;
  for (int r = wave; r < NTOK; r += nw) {
    const float4* xr = (const float4*)(x1 + (size_t)r * D);
    float4 v[4]; float s = 0.f;
#pragma unroll
    for (int j = 0; j < 4; ++j) { v[j] = xr[lane + 64 * j]; s += v[j].x * v[j].x + v[j].y * v[j].y + v[j].z * v[j].z + v[j].w * v[j].w; }
    s = wave_sum(s);
    const float rstd = rsqrtf(s * (1.f / D) + 1e-6f);
#pragma unroll
    for (int j = 0; j < 4; ++j) {
      const float4 gg = ((const float4*)gf)[lane + 64 * j];
      float4 h; h.x = v[j].x * rstd * gg.x; h.y = v[j].y * rstd * gg.y; h.z = v[j].z * rstd * gg.z; h.w = v[j].w * rstd * gg.w;
      ushort4 hi, lo;
      hi.x = f2bf(h.x); hi.y = f2bf(h.y); hi.z = f2bf(h.z); hi.w = f2bf(h.w);
      lo.x = f2bf(h.x - bf2f(hi.x)); lo.y = f2bf(h.y - bf2f(hi.y)); lo.z = f2bf(h.z - bf2f(hi.z)); lo.w = f2bf(h.w - bf2f(hi.w));
      ((ushort4*)(H2 + (size_t)r * D))[lane + 64 * j] = hi;
      ((ushort4*)(H2LO + (size_t)r * D))[lane + 64 * j] = lo;
      ((float4*)hs)[lane + 64 * j] = h;
    }
    __builtin_amdgcn_wave_barrier();
    asm volatile("s_waitcnt lgkmcnt(0)" ::: "memory");
    float acc = 0.f;
    if (lane < 36) {
      const float* wp = lane < 4 ? (wg + lane) : (we + (lane - 4));
      const int ld = lane < 4 ? 4 : 32;
      for (int k = 0; k < 1024; ++k) acc += hs[k] * wp[(size_t)k * ld];
      acc += lane < 4 ? bg[lane] : be[lane - 4];
    }
    lgs[lane] = acc;
    asm volatile("s_waitcnt lgkmcnt(0)" ::: "memory");
    __builtin_amdgcn_wave_barrier();
    if (lane == 0) {
      int grp = 0; float gmax = -1e30f;
      for (int j = 0; j < 4; ++j) { const float gl = lgs[j]; if (gl > gmax) { gmax = gl; grp = j; } }
      float zs = 0.f;
      for (int j = 0; j < 4; ++j) zs += __expf(lgs[j] - gmax);
      const float pgrp = 1.f / zs;
      int i1 = 0; float v1 = -1e30f;
      for (int i = 0; i < 8; ++i) { const float e = lgs[4 + grp * 8 + i]; if (e > v1) { v1 = e; i1 = i; } }
      int i2 = 0; float v2 = -1e30f;
      for (int i = 0; i < 8; ++i) { const float e = lgs[4 + grp * 8 + i]; if (i != i1 && e > v2) { v2 = e; i2 = i; } }
      const float e2 = __expf(v2 - v1), w1 = 1.f / (1.f + e2), w2 = e2 * w1;
      const int e_a = grp * 8 + i1, e_b = grp * 8 + i2;
      const int ra = atomicAdd(&cnt[e_a], 1), rb = atomicAdd(&cnt[e_b], 1);
      sm[SM_EID + 2 * r] = e_a; sm[SM_EID + 2 * r + 1] = e_b;
      ((float*)sm)[SM_WT + 2 * r] = pgrp * w1; ((float*)sm)[SM_WT + 2 * r + 1] = pgrp * w2;
      sm[SM_RANK + 2 * r] = ra; sm[SM_RANK + 2 * r + 1] = rb;
      list[(size_t)e_a * NTOK + ra] = r; list[(size_t)e_b * NTOK + rb] = r;
    }
    asm volatile("s_waitcnt lgkmcnt(0)" ::: "memory");
    __builtin_amdgcn_wave_barrier();
  }
}
__device__ __forceinline__ void ph_final(float* __restrict__ out, const bf16_t* __restrict__ YS, const int* __restrict__ sm, const int* l_off, const float* __restrict__ gfin) {
  const int tid_ = tid_fresh(), lane = tid_ & 63, wave = (blockIdx.x * 512 + tid_) >> 6, nw = (gridDim.x * 512) >> 6;
  f32x4v gg[4];
#pragma unroll
  for (int j = 0; j < 4; ++j) gg[j] = ((const GAS f32x4v*)gfin)[lane + 64 * j];
#pragma unroll 1
  for (int r = wave * 4; r < NTOK; r += nw * 4) {
    int s0[4], s1[4]; float w0[4], w1[4];
#pragma unroll
    for (int q = 0; q < 4; ++q) {
      const int e0 = sm[SM_EID + 2 * (r + q)], e1 = sm[SM_EID + 2 * (r + q) + 1];
      s0[q] = l_off[e0] + sm[SM_RANK + 2 * (r + q)]; s1[q] = l_off[e1] + sm[SM_RANK + 2 * (r + q) + 1];
      w0[q] = ((const float*)sm)[SM_WT + 2 * (r + q)]; w1[q] = ((const float*)sm)[SM_WT + 2 * (r + q) + 1];
    }
    f32x4v v[4][4]; u16x4v ya[4][4], yb[4][4];
#pragma unroll
    for (int q = 0; q < 4; ++q)
#pragma unroll
      for (int j = 0; j < 4; ++j) {
        v[q][j] = ((const GAS f32x4v*)(out + (size_t)(r + q) * D))[lane + 64 * j];
        ya[q][j] = ((const GAS u16x4v*)(YS + (size_t)s0[q] * D))[lane + 64 * j];
        yb[q][j] = ((const GAS u16x4v*)(YS + (size_t)s1[q] * D))[lane + 64 * j];
      }
    float s[4];
#pragma unroll
    for (int q = 0; q < 4; ++q) { float t = 0.f;
#pragma unroll
      for (int j = 0; j < 4; ++j) {
        v[q][j].x += w0[q] * bf2f(ya[q][j].x) + w1[q] * bf2f(yb[q][j].x); v[q][j].y += w0[q] * bf2f(ya[q][j].y) + w1[q] * bf2f(yb[q][j].y);
        v[q][j].z += w0[q] * bf2f(ya[q][j].z) + w1[q] * bf2f(yb[q][j].z); v[q][j].w += w0[q] * bf2f(ya[q][j].w) + w1[q] * bf2f(yb[q][j].w);
        t += v[q][j].x * v[q][j].x + v[q][j].y * v[q][j].y + v[q][j].z * v[q][j].z + v[q][j].w * v[q][j].w;
      }
      s[q] = wave_sum(t); }
#pragma unroll
    for (int q = 0; q < 4; ++q) { const float rstd = rsqrtf(s[q] * (1.f / D) + 1e-6f);
#pragma unroll
      for (int j = 0; j < 4; ++j) ((GAS f32x4v*)(out + (size_t)(r + q) * D))[lane + 64 * j] = v[q][j] * rstd * gg[j]; }
  }
}


struct WPtrs { const float *w_in, *w1k, *w2k, *w1v, *w2v, *w_a, *w_b, *w_o, *w_group, *w_expert, *w_gate, *w_up, *w_down;
               bf16_t *WinT, *WgnT, *W1kT, *W1vT, *W2kT, *W2vT, *WabT, *WoT, *WguT, *WdT, *WrtHi, *WrtLo; };
__device__ __forceinline__ TrItem tr_desc(const WPtrs& w, int it) {
  constexpr int I_IN = 2048, I_GN = 16, I_W1 = 256, I_W2 = 8, I_AB = 256, I_O = 512, I_GU = 4096;
  int r = it; TrItem d; d.nvalid = 32;
  if (r < I_IN) { const int rb = r >> 4, kb = r & 15, n0 = rb * 32; d.src = w.w_in + (size_t)(kb * 64) * INW + n0 + (n0 >= 1280 ? 24 : 0); d.ldw = INW; d.dst = w.WinT + (size_t)n0 * 1024 + kb * 64; d.ldt = 1024; return d; } r -= I_IN;
  if (r < I_GN) { d.src = w.w_in + (size_t)(r * 64) * INW + 1280; d.ldw = INW; d.nvalid = 24; d.dst = w.WgnT + r * 64; d.ldt = 1024; return d; } r -= I_GN;
  if (r < 2 * I_W1) { const int v = r >= I_W1; r -= v * I_W1; const int rb = r >> 5, kb = r & 31; d.src = (v ? w.w1v : w.w1k) + (size_t)(kb * 64) * 256 + rb * 32; d.ldw = 256; d.dst = (v ? w.W1vT : w.W1kT) + (size_t)(rb * 32) * 2048 + kb * 64; d.ldt = 2048; return d; } r -= 2 * I_W1;
  if (r < 2 * I_W2) { const int v = r >= I_W2; r -= v * I_W2; const int rb = r >> 2, kb = r & 3; d.src = (v ? w.w2v : w.w2k) + (size_t)(kb * 64) * 64 + rb * 32; d.ldw = 64; d.dst = (v ? w.W2vT : w.W2kT) + (size_t)(rb * 32) * 256 + kb * 64; d.ldt = 256; return d; } r -= 2 * I_W2;
  if (r < 2 * I_AB) { const int a = r >= I_AB; r -= a * I_AB; const int rb = r >> 3, kb = r & 7; d.src = (a ? w.w_a : w.w_b) + (size_t)(kb * 64) * 1024 + rb * 32; d.ldw = 1024; d.dst = w.WabT + (size_t)(rb * 32) * 1024 + a * 512 + kb * 64; d.ldt = 1024; return d; } r -= 2 * I_AB;
  if (r < I_O) { const int rb = r >> 4, kb = r & 15; d.src = w.w_o + (size_t)(kb * 64) * 1024 + rb * 32; d.ldw = 1024; d.dst = w.WoT + (size_t)(rb * 32) * 1024 + kb * 64; d.ldt = 1024; return d; } r -= I_O;
  if (r < 2 * I_GU) { const int u = r >= I_GU; r -= u * I_GU; const int e = r >> 7, q = r & 127, cb = q >> 4, kb = q & 15, c0 = cb * 32;
    d.src = (u ? w.w_up : w.w_gate) + ((size_t)e * 1024 + kb * 64) * 256 + c0; d.ldw = 256; d.dst = w.WguT + ((size_t)e * 512 + (c0 >> 7) * 256 + u * 128 + (c0 & 127)) * 1024 + kb * 64; d.ldt = 1024; return d; } r -= 2 * I_GU;
  { const int e = r >> 7, q = r & 127, cb = q >> 2, kb = q & 3; d.src = w.w_down + ((size_t)e * 256 + kb * 64) * 1024 + cb * 32; d.ldw = 1024; d.dst = w.WdT + ((size_t)e * 1024 + cb * 32) * 256 + kb * 64; d.ldt = 256; return d; }
}
__device__ __forceinline__ void ph_weights(LAS unsigned char* lds, const WPtrs& w) {
  const int tid_ = tid_fresh(), lane = tid_ & 63, wl = __builtin_amdgcn_readfirstlane(tid_ >> 6);
  const int gw = blockIdx.x * 8 + wl, NGW = gridDim.x * 8;
  LAS float* scr = (LAS float*)(lds + wl * 16384);
  constexpr int NITEMS = 2048 + 16 + 512 + 16 + 512 + 512 + 8192 + 4096;
  for (int i = blockIdx.x * 512 + tid_; i < 64 * 1024; i += gridDim.x * 512) {
    const int j = i >> 10, k = i & 1023; const float v = j < 4 ? w.w_group[k * 4 + j] : (j < 36 ? w.w_expert[k * 32 + (j - 4)] : 0.f);
    const bf16_t hi = f2bf(v); w.WrtHi[i] = hi; w.WrtLo[i] = f2bf(v - bf2f(hi));
  }
  int it = gw;
  if (it < NITEMS) {
    TrItem cur = tr_desc(w, it); TrRegs rc; tr_load(rc, cur, lane);
#pragma unroll 1
    for (;;) {
      const int nx = it + NGW; const bool more = nx < NITEMS;
      TrItem nd = cur; TrRegs rn = rc;
      if (more) { nd = tr_desc(w, nx); tr_load(rn, nd, lane); }
      tr_store(rc, cur, scr, lane);
      if (!more) break;
      cur = nd; rc = rn; it = nx;
    }
  }
}

#ifndef PROBE_REP
#define PROBE_REP -1
#endif
#ifndef PROBE_SPIN
#define PROBE_SPIN -1
#endif
#define REPS(k) for (int rep_ = 0; rep_ < ((PROBE_REP) == (k) ? 2 : 1); ++rep_)
struct Args { const float* in[22]; float* out; unsigned char* ws; };
constexpr int PTAB_OFF = 131072 + 4096;
#define PIN(i) ((const float*)ldptr(ptab, (i)))
#define POUT ((float*)ldptr(ptab, 22))
#define PWS ((unsigned char*)ldptr(ptab, 23))
#define WSB(off) ((bf16_t*)(ws + (off)))
__global__ void __launch_bounds__(512, 2) mega_fwd(Args a) {
  extern __shared__ __attribute__((aligned(16))) unsigned char lds[];
  LAS unsigned char* ldsl = (LAS unsigned char*)lds;
  LAS u64_t* ptab = (LAS u64_t*)(ldsl + PTAB_OFF);
  volatile LAS unsigned* MISC = (volatile LAS unsigned*)(ldsl + MISC_OFF);
  if (threadIdx.x == 0) {
#pragma unroll
    for (int i = 0; i < 22; ++i) ptab[i] = (u64_t)a.in[i];
    ptab[22] = (u64_t)a.out; ptab[23] = (u64_t)a.ws;
  }
  if (threadIdx.x < 32) MISC[threadIdx.x] = 0u;
  __syncthreads();
  XcdBarrier bar = xcd_barrier_post((unsigned*)PWS, MISC + 8);
  int* l_off = (int*)(lds + 131072 + 1024);
  int* l_te = (int*)(lds + 131072 + 1024 + 256);
#define GRID_BAR() do { bar.bar = (unsigned*)PWS; xcd_barrier(bar); } while (0)
  unsigned long long t_acc = 0ull, t_beg = 0ull;
#define PH_BEGIN(k) do { if (PROBE_SPIN == (k)) t_beg = __builtin_amdgcn_s_memrealtime(); } while (0)
#define PH_END(k) do { if (PROBE_SPIN == (k)) t_acc += __builtin_amdgcn_s_memrealtime() - t_beg; } while (0)

  PH_BEGIN(0);
  REPS(0) {
    unsigned char* ws = PWS;
    WPtrs w{PIN(2), PIN(4), PIN(5), PIN(7), PIN(8), PIN(10), PIN(11), PIN(12), PIN(14), PIN(16), PIN(18), PIN(19), PIN(20),
            WSB(WS_WINT), WSB(WS_WGNT), WSB(WS_W1KT), WSB(WS_W1VT), WSB(WS_W2KT), WSB(WS_W2VT), WSB(WS_WABT), WSB(WS_WOT), WSB(WS_WGUT), WSB(WS_WDT), WSB(WS_WRT_HI), WSB(WS_WRT_LO)};
    for (int jb = blockIdx.x; jb < 64; jb += gridDim.x) wg::cmp_bias_part(ldsl, jb, jb < 32 ? PIN(3) : PIN(6), jb < 32 ? PIN(4) : PIN(7), (float*)(ws + WS_PB) + (size_t)(jb >> 5) * 32 * 256);
    ph_weights(ldsl, w);
    ph_prep_xn(PIN(0), PIN(1), WSB(WS_XN));
  }
  GRID_BAR();
  PH_END(0);
  PH_BEGIN(1);
  REPS(1) {
    unsigned char* ws = PWS;
    pg8::SchedDense Sd; Sd.init(ws + WS_XN, 2048, ws + WS_WINT, NTOK, 4096, 1024, gridDim.x, blockIdx.x);
    pg8::EpiProj E{WSB(WS_QA), WSB(WS_QB), WSB(WS_KVC), WSB(WS_KVS), WSB(WS_KVW), WSB(WS_KVB), WSB(WS_GM)};
    pg8::gemm_phase<pg8::EpiProj, pg8::SchedDense, true>(ldsl, 1024, 128, Sd, E);
  }
  REPS(1) {
    unsigned char* ws = PWS;
    for (int c = blockIdx.x; c < NTOK / 64; c += gridDim.x) wg::gn_rows(64 * c, WSB(WS_XN), WSB(WS_WGNT), (float*)(ws + WS_GN));
    if (blockIdx.x == gridDim.x - 1) wg::cmp_bias_final((const float*)(ws + WS_PB), (float*)(ws + WS_BIAS1));
  }
  GRID_BAR();
  PH_END(1);
  PH_BEGIN(2);
  REPS(2) {
    unsigned char* ws = PWS;
    if (gridDim.x == 256) {
      const int c = blockIdx.x;
      if (c < 128) {
        const int sel = c >> 6, rt = c & 63;
        wg::cmp_unit(ldsl, sel, rt, WSB(WS_KVC), WSB(sel ? WS_W1VT : WS_W1KT), (const float*)(ws + WS_BIAS1) + sel * 256, WSB(sel ? WS_W2VT : WS_W2KT), WSB(sel ? WS_VC : WS_KC));
        att::swa_unit(ldsl, c >> 6, (c >> 5) & 1, c & 31, WSB(WS_QB), WSB(WS_KVB), PIN(9), WSB(WS_OAB));
      } else {
#pragma unroll 1
        for (int i = 0; i < 3; ++i) { const int u = 128 + (c - 128) * 3 + i; att::swa_unit(ldsl, u >> 6, (u >> 5) & 1, u & 31, WSB(WS_QB), WSB(WS_KVB), PIN(9), WSB(WS_OAB)); }
      }
    } else {
#pragma unroll 1
      for (int c = blockIdx.x; c < 128; c += gridDim.x) { const int sel = c >> 6, rt = c & 63;
        wg::cmp_unit(ldsl, sel, rt, WSB(WS_KVC), WSB(sel ? WS_W1VT : WS_W1KT), (const float*)(ws + WS_BIAS1) + sel * 256, WSB(sel ? WS_W2VT : WS_W2KT), WSB(sel ? WS_VC : WS_KC)); }
      att::swa_phase(ldsl, WSB(WS_QB), WSB(WS_KVB), PIN(9), WSB(WS_OAB));
    }
  }
  GRID_BAR();
  PH_END(2);
  PH_BEGIN(3);
  REPS(3) {
    unsigned char* ws = PWS;
    att::nsa_phase(ldsl, WSB(WS_QA), WSB(WS_KC), WSB(WS_VC), WSB(WS_KVS), WSB(WS_KVW), (const float*)(ws + WS_GN), WSB(WS_OAB));
  }
  GRID_BAR();
  PH_END(3);
  PH_BEGIN(4);
  REPS(4) {
    unsigned char* ws = PWS;
    pg8::SchedDense Sd; Sd.init(ws + WS_OAB, 2048, ws + WS_WABT, NTOK, 1024, 1024, gridDim.x, blockIdx.x);
    pg8::EpiMerge E{WSB(WS_GM), WSB(WS_MG)};
    pg8::gemm_phase<pg8::EpiMerge, pg8::SchedDense, true>(ldsl, 1024, 128, Sd, E);
  }
  GRID_BAR();
  PH_END(4);
  PH_BEGIN(5);
  REPS(5) {
    unsigned char* ws = PWS;
    pg8::SchedDense Sd; Sd.init(ws + WS_MG, 2048, ws + WS_WOT, NTOK, 1024, 1024, gridDim.x, blockIdx.x);
    pg8::EpiX1 E{PIN(0), POUT};
    pg8::gemm_phase<pg8::EpiX1, pg8::SchedDense, true>(ldsl, 1024, 128, Sd, E);
  }
  GRID_BAR();
  PH_END(5);
  PH_BEGIN(6);
  {
    unsigned char* ws = PWS;
#pragma unroll 1
    for (int c = blockIdx.x; c < NTOK / 64; c += gridDim.x)
      rt::router_rows(ldsl, 64 * c, POUT, PIN(13), PIN(15), PIN(17), WSB(WS_WRT_HI), WSB(WS_WRT_LO), WSB(WS_H2), WSB(WS_H2LO), (int*)(ws + WS_CTL) + CW_CNT, (int*)(ws + WS_SMALL), (int*)(ws + WS_LIST));
  }
  GRID_BAR();
  PH_END(6);
  PH_BEGIN(7);
  REPS(7) {
    unsigned char* ws = PWS;
    const int* cnt = (const int*)(ws + WS_CTL) + CW_CNT;
    moe_tables(cnt, l_off, l_te);
    pg8::SchedMoeUp Sm{(const char*)(ws + WS_H2), (const char*)(ws + WS_WGUT), (const int*)(ws + WS_LIST), cnt, l_off, l_te, (int)gridDim.x, (int)blockIdx.x};
    pg8::EpiHB E{WSB(WS_HB)};
    pg8::gemm_phase<pg8::EpiHB, pg8::SchedMoeUp, true>(ldsl, 1024, 128, Sm, E);
  }
  GRID_BAR();
  PH_END(7);
  PH_BEGIN(8);
  REPS(8) {
    unsigned char* ws = PWS;
    pg8::SchedMoeDown Sm{(const char*)(ws + WS_HB), (const char*)(ws + WS_WDT), l_off, l_te, (int)gridDim.x, (int)blockIdx.x};
    pg8::EpiYS E{WSB(WS_YS)};
    pg8::gemm_phase<pg8::EpiYS, pg8::SchedMoeDown, true>(ldsl, 256, 128, Sm, E);
  }
  GRID_BAR();
  PH_END(8);
  PH_BEGIN(9);
  {
    unsigned char* ws = PWS;
    ph_final(POUT, WSB(WS_YS), (const int*)(ws + WS_SMALL), l_off, PIN(21));
  }
  PH_END(9);
  if (PROBE_SPIN >= 0 && blockIdx.x == 0) { const unsigned long long t0 = __builtin_amdgcn_s_memrealtime(); while (__builtin_amdgcn_s_memrealtime() - t0 < t_acc) __builtin_amdgcn_s_sleep(8); }
}

extern "C" void kernel_launch(void* const* d_in, const int* in_sizes, int n_in, void* d_out, int out_size, void* d_ws, size_t ws_size, hipStream_t stream) {
  static int grid = 0;
  if (grid == 0) {
    int dev = 0, cus = 0, per_cu = 0;
    if (hipGetDevice(&dev) != hipSuccess || hipDeviceGetAttribute(&cus, hipDeviceAttributeMultiprocessorCount, dev) != hipSuccess) { fprintf(stderr, "kernel_launch: device query failed\n"); grid = -1; return; }
    if (hipFuncSetAttribute((const void*)mega_fwd, hipFuncAttributeMaxDynamicSharedMemorySize, LDS_BYTES) != hipSuccess) { fprintf(stderr, "kernel_launch: hipFuncSetAttribute failed\n"); grid = -1; return; }
    if (hipOccupancyMaxActiveBlocksPerMultiprocessor(&per_cu, (const void*)mega_fwd, 512, LDS_BYTES) != hipSuccess || per_cu < 1) { fprintf(stderr, "kernel_launch: occupancy query says %d blocks/CU\n", per_cu); (void)hipGetLastError(); grid = -1; return; }
    grid = cus;
  }
  if (grid < 0) return;
  (void)hipMemsetAsync((char*)d_ws + WS_CTL, 0, CTL_ZERO_BYTES, stream);
  Args a{};
  for (int i = 0; i < 22; ++i) a.in[i] = (const float*)d_in[i];
  a.out = (float*)d_out; a.ws = (unsigned char*)d_ws;
  hipLaunchKernelGGL(mega_fwd, dim3(grid), dim3(512), LDS_BYTES, stream, a);
}
```

```cpp
#include <hip/hip_runtime.h>
#include <stdint.h>
#include <cstdio>

typedef unsigned short bf16_t;
#ifndef PROBE_REP
#define PROBE_REP -1
#endif
#ifndef PROBE_SPIN
#define PROBE_SPIN -1
#endif
#ifndef PROBE_BLOCK
#define PROBE_BLOCK 0
#endif
#define REPS(k) for (int rep_ = 0; rep_ < ((PROBE_REP) == (k) ? 2 : 1); ++rep_)
#define LAS __attribute__((address_space(3)))
#define GAS __attribute__((address_space(1)))
__device__ __forceinline__ float bf2f(bf16_t v) { return __uint_as_float(((unsigned)v) << 16); }
__device__ __forceinline__ bf16_t f2bf(float f) { unsigned u = __float_as_uint(f); return (bf16_t)((u + 0x7fffu + ((u >> 16) & 1u)) >> 16); }
__device__ __forceinline__ float wave_sum(float v) {
#pragma unroll
  for (int o = 1; o < 64; o <<= 1) v += __shfl_xor(v, o);
  return v;
}
__device__ __forceinline__ float wave_max(float v) {
#pragma unroll
  for (int o = 1; o < 64; o <<= 1) v = fmaxf(v, __shfl_xor(v, o));
  return v;
}
__device__ __forceinline__ float sigmoidf_(float v) { return 1.f / (1.f + __expf(-v)); }

__device__ __forceinline__ int tid_fresh() { int t = threadIdx.x; asm volatile("" : "+v"(t)); return t; }
typedef unsigned long long u64_t;
typedef float f32x4v __attribute__((ext_vector_type(4)));
typedef unsigned short u16x4v __attribute__((ext_vector_type(4)));
__device__ __forceinline__ const void* ldptr(const LAS u64_t* tab, int i) {
  const u64_t v = tab[i]; const unsigned lo = __builtin_amdgcn_readfirstlane((unsigned)v), hi = __builtin_amdgcn_readfirstlane((unsigned)(v >> 32));
  return (const void*)(((u64_t)hi << 32) | lo);
}

constexpr int NB = 8, S = 2048, D = 1024, NTOK = NB * S;
constexpr int INW = 4120;
constexpr int NSLOT = 40960;
constexpr size_t MiB = 1u << 20;
constexpr size_t WS_CTL = 0;
constexpr int CW_CNT = 4096, CNT_STRIDE = 16;
constexpr size_t CTL_ZERO_BYTES = 65536;
constexpr size_t WS_SMALL = 1 * MiB;
constexpr size_t WS_LIST = 233 * MiB;
constexpr size_t WS_W1KT = 2 * MiB, WS_W1VT = 3 * MiB;
constexpr size_t WS_W2KT = 4 * MiB, WS_W2VT = 4 * MiB + 32768;
constexpr size_t WS_WGNT = 4 * MiB + 65536;
constexpr size_t WS_WRT_HI = 4 * MiB + 131072, WS_WRT_LO = 4 * MiB + 262144;
constexpr size_t WS_BIAS1 = 4 * MiB + 393216;
constexpr size_t WS_PB = 4 * MiB + 524288;
constexpr size_t WS_WABT = 5 * MiB;
constexpr size_t WS_WOT = 7 * MiB;
constexpr size_t WS_WGUT = 10 * MiB;
constexpr size_t WS_WDT = 42 * MiB;
constexpr size_t WS_WINT = 58 * MiB;
constexpr size_t WS_OAB = 66 * MiB;
constexpr size_t WS_XN = 66 * MiB;
constexpr size_t WS_OA = 66 * MiB, WS_OB = 82 * MiB;
constexpr size_t WS_YS = 66 * MiB;
constexpr size_t WS_GM = 98 * MiB;
constexpr size_t WS_H2 = 98 * MiB, WS_H2LO = 130 * MiB;
constexpr size_t WS_QA = 162 * MiB, WS_QB = 178 * MiB, WS_KVC = 194 * MiB, WS_KVS = 202 * MiB, WS_KVW = 210 * MiB, WS_KVB = 218 * MiB;
constexpr size_t WS_MG = 162 * MiB;
constexpr size_t WS_HB = 162 * MiB;
constexpr size_t WS_GTMP = 182 * MiB;
constexpr size_t WS_GN = 226 * MiB;
constexpr size_t WS_KC = 228 * MiB, WS_VC = WS_KC + 256 * 1024, WS_T1K = 229 * MiB, WS_T1V = 231 * MiB;
constexpr int SM_EID = 0, SM_WT = SM_EID + 2 * NTOK, SM_RANK = SM_WT + 2 * NTOK;
static_assert((SM_RANK + 2 * NTOK) * 4 <= (int)MiB, "small");

constexpr int LDS_BYTES = 147456;
constexpr int MISC_OFF = 131072 + 320;

#define XB_TMO      128
#define XB_XCNT(j)  (256  + 64 * (j))
#define XB_XSUB(j)  (1280 + 64 * (j))
#define XB_XGEN(j)  (2304 + 64 * (j))
#define XB_TOP      3328
#define XB_TOPGEN   3392
#define XCD_BAR_WORDS 3456
#define XB_SPIN_CAP (1u << 20)
__device__ __forceinline__ unsigned xb_ld(unsigned* p)              { return __hip_atomic_load(p, __ATOMIC_RELAXED, __HIP_MEMORY_SCOPE_AGENT); }
__device__ __forceinline__ unsigned xb_add(unsigned* p, unsigned v) { return __hip_atomic_fetch_add(p, v, __ATOMIC_RELAXED, __HIP_MEMORY_SCOPE_AGENT); }
__device__ __forceinline__ unsigned xb_xcc_id() { return (unsigned)__builtin_amdgcn_s_getreg((3 << 11) | 20) & 0xFu; }
#define XB_SPIN(cond, bar) do { unsigned _sp = 0; while (cond) { __builtin_amdgcn_s_sleep(1); \
    if ((++_sp & 255u) == 0u) { if (xb_ld(&(bar)[XB_TMO])) break; if (_sp > XB_SPIN_CAP) { atomicAdd(&(bar)[XB_TMO], 1u); break; } } } } while (0)
struct XcdBarrier { unsigned* bar; unsigned x; volatile LAS unsigned* st; };
__device__ __forceinline__ XcdBarrier xcd_barrier_post(unsigned* bar, volatile LAS unsigned* st) {
    XcdBarrier b; b.bar = bar; b.x = xb_xcc_id(); b.st = st;
    if (threadIdx.x == 0) (void)xb_add(&bar[XB_XCNT(b.x)], 1u);
    return b;
}
__device__ __forceinline__ void xcd_barrier_complete(unsigned* bar, unsigned x, unsigned& nloc, unsigned& nx) {
    const unsigned G = gridDim.x * gridDim.y * gridDim.z;
    unsigned sum, cnt, mine, sp = 0u;
    for (;;) {
        sum = 0u; cnt = 0u; mine = 0u;
#pragma unroll
        for (unsigned j = 0; j < 16; ++j) { const unsigned c = xb_ld(&bar[XB_XCNT(j)]); sum += c; cnt += (c > 0u) ? 1u : 0u; mine = (j == x) ? c : mine; }
        if (sum == G) break;
        __builtin_amdgcn_s_sleep(1);
        if ((++sp & 255u) == 0u) { if (xb_ld(&bar[XB_TMO])) break; if (sp > XB_SPIN_CAP) { atomicAdd(&bar[XB_TMO], 1u); break; } }
    }
    nloc = mine > 0u ? mine : 1u; nx = cnt > 0u ? cnt : 1u;
}
__device__ __forceinline__ void xcd_barrier(const XcdBarrier& b) {
    asm volatile("s_waitcnt vmcnt(0)" ::: "memory");
    __syncthreads();
    if (threadIdx.x == 0) {
        unsigned* bar = b.bar;
        __builtin_amdgcn_s_waitcnt(0);
        unsigned nloc = b.st[0], nx = b.st[1];
        if (nloc == 0u) { xcd_barrier_complete(bar, b.x, nloc, nx); b.st[0] = nloc; b.st[1] = nx; }
        const unsigned old = xb_add(&bar[XB_XSUB(b.x)], 1u);
        const unsigned gen = old / nloc;
        if (old + 1u == (gen + 1u) * nloc) {
            __builtin_amdgcn_fence(__ATOMIC_RELEASE, "agent");
            asm volatile("s_waitcnt vmcnt(0)" ::: "memory");
            const unsigned og = xb_add(&bar[XB_TOP], 1u);
            const unsigned tg = og / nx;
            if (og + 1u == (tg + 1u) * nx) xb_add(&bar[XB_TOPGEN], 1u);
            else XB_SPIN(xb_ld(&bar[XB_TOPGEN]) == tg, bar);
            __builtin_amdgcn_fence(__ATOMIC_ACQUIRE, "agent");
            xb_add(&bar[XB_XGEN(b.x)], 1u);
            asm volatile("s_waitcnt vmcnt(0)" ::: "memory");
        } else {
            XB_SPIN(xb_ld(&bar[XB_XGEN(b.x)]) == gen, bar);
            __builtin_amdgcn_fence(__ATOMIC_ACQUIRE, "agent");
            asm volatile("s_waitcnt vmcnt(0)" ::: "memory");
        }
    }
    __syncthreads();
}


namespace pg8 {
typedef short bf16x8 __attribute__((ext_vector_type(8)));
typedef float f32x4 __attribute__((ext_vector_type(4)));
typedef unsigned u32x4 __attribute__((ext_vector_type(4)));
typedef unsigned u32x2 __attribute__((ext_vector_type(2)));
constexpr int BM = 256, BK = 64, HALF = 128, HTB = HALF * BK * 2, STAGE_BYTES = 8 * HTB, NXCD = 8, WGM = 8;
__host__ __device__ __forceinline__ int lds_byte(int r, int c) { const int st = (r >> 4) * 2 + (c >> 5), rr = r & 15, cc = c & 31, ob = rr * 64 + cc * 2; return st * 1024 + (ob ^ (((ob >> 9) & 1) << 5)); }
__host__ __device__ __forceinline__ void stage_rc(int b, int& R, int& C) { const int st = b / 1024, sb = b % 1024, swz = sb ^ (((sb >> 9) & 1) << 5); R = (st >> 1) * 16 + swz / 64; C = (st & 1) * 32 + (swz % 64) / 2; }
__host__ __device__ __forceinline__ int perm32(int rho) { const int n = rho >> 4, i = rho & 15; return 8 * (i >> 2) + 4 * n + (i & 3); }
struct Unit { int pm, pn; const char* A; const char* B; };
__device__ __forceinline__ unsigned cvt_pk_bf16(float lo, float hi) { unsigned r; asm volatile("v_cvt_pk_bf16_f32 %0, %1, %2" : "=v"(r) : "v"(lo), "v"(hi)); return r; }

template <class Epi, class Sched, bool ALIGN_EPI>
__device__ __forceinline__ void gemm_phase(LAS unsigned char* lds, const int K, const int kstepA, const Sched& S, const Epi& E) {
    const int tid = tid_fresh(), wid = __builtin_amdgcn_readfirstlane(tid >> 6), lane = tid & 63, wr = wid >> 2, wc = wid & 3, fr = lane & 15, fq = lane >> 4;
    const int nt = K / BK;
    int Rr[2], Cc[2]; unsigned voffB[2];
#pragma unroll
    for (int i = 0; i < 2; ++i) { stage_rc(tid * 16 + i * 8192, Rr[i], Cc[i]); const int Rb = Epi::PERM ? ((Rr[i] & ~31) + perm32(Rr[i] & 31)) : Rr[i]; voffB[i] = (unsigned)(Rb * K + Cc[i]) * 2u; }
    const size_t kstepB = (size_t)(BK * 2);
    const size_t hstepB = (size_t)HALF * K * 2;
    const unsigned ldsw = (unsigned)wid * 1024u;
    const int aoff = lds_byte(wr * 64 + fr, fq * 8), boff = lds_byte(wc * 32 + fr, fq * 8);
#define PG8_SA(b, h) (((b) * 2 + (h)) * HTB)
#define PG8_SB(b, h) ((4 + (b) * 2 + (h)) * HTB)
#define PG8_STAGEB(bufoff, gbase) do { _Pragma("unroll") for (int _i = 0; _i < 2; ++_i) \
        __builtin_amdgcn_global_load_lds((const unsigned*)((const char*)(gbase) + voffB[_i]), (LAS unsigned*)(lds + (bufoff) + ldsw + _i * 8192), 16, 0, 0); } while (0)
#define PG8_STAGEA(bufoff, gbase, v0, v1) do { \
        __builtin_amdgcn_global_load_lds((const unsigned*)((const char*)(gbase) + (v0)), (LAS unsigned*)(lds + (bufoff) + ldsw), 16, 0, 0); \
        __builtin_amdgcn_global_load_lds((const unsigned*)((const char*)(gbase) + (v1)), (LAS unsigned*)(lds + (bufoff) + ldsw + 8192), 16, 0, 0); } while (0)
#define PG8_LDA(dst, b, h) do { _Pragma("unroll") for (int m = 0; m < 4; ++m) _Pragma("unroll") for (int k = 0; k < 2; ++k) dst[m][k] = *(const LAS bf16x8*)(lds + PG8_SA(b, h) + aoff + m * 2048 + k * 1024); } while (0)
#define PG8_LDB(dst, b, h) do { _Pragma("unroll") for (int n = 0; n < 2; ++n) _Pragma("unroll") for (int k = 0; k < 2; ++k) dst[n][k] = *(const LAS bf16x8*)(lds + PG8_SB(b, h) + boff + n * 2048 + k * 1024); } while (0)
#define PG8_MMA(ai, bj, At, Bt) do { __builtin_amdgcn_s_setprio(1); _Pragma("unroll") for (int m = 0; m < 4; ++m) _Pragma("unroll") for (int n = 0; n < 2; ++n) _Pragma("unroll") for (int k = 0; k < 2; ++k) \
        acc[ai][bj][m][n] = __builtin_amdgcn_mfma_f32_16x16x32_bf16(Bt[n][k], At[m][k], acc[ai][bj][m][n], 0, 0, 0); __builtin_amdgcn_s_setprio(0); } while (0)
#define PG8_WAIT_V(n) asm volatile("s_waitcnt vmcnt(" #n ")" ::: "memory")
#define PG8_WAIT_L(n) asm volatile("s_waitcnt lgkmcnt(" #n ")" ::: "memory")
#define PG8_BAR __builtin_amdgcn_s_barrier()
#define PG8_SCHED __builtin_amdgcn_sched_barrier(0)
    Unit cur, nxt; int ui = 0;
    if (!S.next(0, cur)) return;
    f32x4 acc[2][2][4][2];
#pragma unroll
    for (int a = 0; a < 2; ++a)
#pragma unroll
        for (int b = 0; b < 2; ++b)
#pragma unroll
            for (int m = 0; m < 4; ++m)
#pragma unroll
                for (int n = 0; n < 2; ++n) acc[a][b][m][n] = (f32x4){0.f, 0.f, 0.f, 0.f};
    bf16x8 At[4][2], B0[2][2], B1[2][2];
    unsigned vc00, vc01, vc10, vc11;
    vc00 = S.arow(cur, Rr[0]) + (unsigned)Cc[0] * 2u; vc01 = S.arow(cur, Rr[1]) + (unsigned)Cc[1] * 2u;
    vc10 = S.arow(cur, HALF + Rr[0]) + (unsigned)Cc[0] * 2u; vc11 = S.arow(cur, HALF + Rr[1]) + (unsigned)Cc[1] * 2u;
    const char* cA = cur.A; const char* cB = cur.B;
    PG8_STAGEB(PG8_SB(0, 0), cB); PG8_STAGEB(PG8_SB(0, 1), cB + hstepB); PG8_STAGEA(PG8_SA(0, 0), cA, vc00, vc01); PG8_STAGEA(PG8_SA(0, 1), cA, vc10, vc11);
    if (wr == 1) PG8_BAR;
    PG8_WAIT_V(2); PG8_BAR;
    PG8_STAGEB(PG8_SB(1, 0), cB + kstepB); PG8_STAGEA(PG8_SA(1, 0), cA + kstepA, vc00, vc01); PG8_STAGEB(PG8_SB(1, 1), cB + hstepB + kstepB);
    PG8_WAIT_V(6); PG8_BAR;
    for (;;) {
        const bool has_next = S.next(ui + 1, nxt);
        const char* nA = has_next ? nxt.A : cA; const char* nB = has_next ? nxt.B : cB;
        unsigned vn00 = vc00, vn01 = vc01, vn10 = vc10, vn11 = vc11;
        if (Sched::GATHER && has_next) {
            vn00 = S.arow(nxt, Rr[0]) + (unsigned)Cc[0] * 2u; vn01 = S.arow(nxt, Rr[1]) + (unsigned)Cc[1] * 2u;
            vn10 = S.arow(nxt, HALF + Rr[0]) + (unsigned)Cc[0] * 2u; vn11 = S.arow(nxt, HALF + Rr[1]) + (unsigned)Cc[1] * 2u;
        }
#pragma unroll 1
        for (int t = 0; t < nt; t += 2) {
            const bool last = (t == nt - 2);
            if (Epi::HOOK) { if (t == nt / 2) E.mid(acc, cur, wr, wc, fr, fq); }
            const char* a1 = cA + (size_t)(t + 1) * kstepA;
            const char* a2 = last ? nA : cA + (size_t)(t + 2) * kstepA; const char* b2 = last ? nB : cB + (size_t)(t + 2) * kstepB;
            const char* a3 = a2 + kstepA; const char* b3 = b2 + kstepB;
            const unsigned w00 = last ? vn00 : vc00, w01 = last ? vn01 : vc01, w10 = last ? vn10 : vc10, w11 = last ? vn11 : vc11;
            PG8_LDB(B0, 0, 0); PG8_LDB(B1, 0, 1); PG8_SCHED; PG8_LDA(At, 0, 0); PG8_STAGEA(PG8_SA(1, 1), a1, vc10, vc11);
            PG8_WAIT_V(8); PG8_WAIT_L(0); PG8_BAR; PG8_MMA(0, 0, At, B0); PG8_MMA(0, 1, At, B1); PG8_BAR; PG8_SCHED;
            PG8_LDA(At, 0, 1); PG8_STAGEB(PG8_SB(0, 0), b2); PG8_STAGEB(PG8_SB(0, 1), b2 + hstepB); PG8_STAGEA(PG8_SA(0, 0), a2, w00, w01);
            PG8_WAIT_V(8); PG8_WAIT_L(0); PG8_BAR; PG8_MMA(1, 0, At, B0); PG8_MMA(1, 1, At, B1); PG8_BAR; PG8_SCHED;
            PG8_LDB(B0, 1, 0); PG8_LDB(B1, 1, 1); PG8_SCHED; PG8_LDA(At, 1, 0); PG8_STAGEA(PG8_SA(0, 1), a2, w10, w11);
            PG8_WAIT_V(8); PG8_WAIT_L(0); PG8_BAR; PG8_MMA(0, 0, At, B0); PG8_MMA(0, 1, At, B1); PG8_BAR; PG8_SCHED;
            PG8_LDA(At, 1, 1); PG8_STAGEB(PG8_SB(1, 0), b3); PG8_STAGEB(PG8_SB(1, 1), b3 + hstepB); PG8_STAGEA(PG8_SA(1, 0), a3, w00, w01);
            PG8_WAIT_V(8); PG8_WAIT_L(0); PG8_BAR; PG8_MMA(1, 0, At, B0); PG8_MMA(1, 1, At, B1); PG8_BAR; PG8_SCHED;
        }
        if constexpr (ALIGN_EPI) { if (wr == 0) PG8_BAR; }
        E(acc, cur, wr, wc, fr, fq);
        if (!has_next) break;
#pragma unroll
        for (int a = 0; a < 2; ++a)
#pragma unroll
            for (int b = 0; b < 2; ++b)
#pragma unroll
                for (int m = 0; m < 4; ++m)
#pragma unroll
                    for (int n = 0; n < 2; ++n) acc[a][b][m][n] = (f32x4){0.f, 0.f, 0.f, 0.f};
        cur = nxt; cA = nA; cB = nB; vc00 = vn00; vc01 = vn01; vc10 = vn10; vc11 = vn11; ++ui;
        if constexpr (ALIGN_EPI) { if (wr == 1) PG8_BAR; }
    }
    PG8_WAIT_V(0);
    if constexpr (!ALIGN_EPI) { if (wr == 0) PG8_BAR; }
    PG8_BAR;
#undef PG8_SA
#undef PG8_SB
#undef PG8_STAGEA
#undef PG8_STAGEB
#undef PG8_LDA
#undef PG8_LDB
#undef PG8_MMA
#undef PG8_WAIT_V
#undef PG8_WAIT_L
#undef PG8_BAR
#undef PG8_SCHED
}

struct SchedDense {
    static constexpr bool GATHER = false;
    const char* A; const char* B; int pitchA  ; int K; int nM, nN, nwg, G, c;
    __device__ void init(const void* A_, int pitchA_, const void* B_, int M, int N, int K_, int G_, int c_) { A = (const char*)A_; B = (const char*)B_; pitchA = pitchA_; K = K_; nM = M / BM; nN = N / BM; nwg = nM * nN; G = G_; c = c_; }
    __device__ bool next(int i, Unit& u) const {
        const long L = (long)i * G + c; if (L >= nwg) return false;
        int wgid = (int)L; { const int q = nwg / NXCD, r = nwg % NXCD, xcd = wgid % NXCD, off = wgid / NXCD; wgid = (xcd < r ? xcd * (q + 1) : r * (q + 1) + (xcd - r) * q) + off; }
        const int nig = WGM * nN, gid = wgid / nig, fm = gid * WGM, gsz = (nM - fm) < WGM ? (nM - fm) : WGM;
        u.pm = fm + ((wgid % nig) % gsz); u.pn = (wgid % nig) / gsz;
        u.A = A + (size_t)u.pm * BM * pitchA; u.B = B + (size_t)u.pn * BM * K * 2; return true;
    }
    __device__ unsigned arow(const Unit&, int r) const { return (unsigned)(r * pitchA); }
};
struct SchedMoeUp {
    static constexpr bool GATHER = true;
    const char* H2; const char* W; const int* list; const int* cnt; const int* l_off; const int* l_te; int G, c;
    __device__ bool next(int i, Unit& u) const {
        const int L = i * G + c, tix = L >> 1; if (tix >= (l_off[32] >> 8)) return false;
        u.pm = tix; u.pn = L & 1; const int e = l_te[tix];
        u.A = H2; u.B = W + (size_t)e * (512 * 1024 * 2) + (size_t)u.pn * (256 * 1024 * 2); return true;
    }
    __device__ unsigned arow(const Unit& u, int r) const { const int e = l_te[u.pm]; int ri = u.pm * 256 + r - l_off[e]; if (ri >= cnt[e]) ri = 0; return (unsigned)list[(size_t)e * NTOK + ri] * 2048u; }
};
struct SchedMoeDown {
    static constexpr bool GATHER = false;
    const char* HB; const char* W; const int* l_off; const int* l_te; int G, c;
    __device__ bool next(int i, Unit& u) const {
        const int L = i * G + c, tix = L >> 2; if (tix >= (l_off[32] >> 8)) return false;
        u.pm = tix; u.pn = L & 3; const int e = l_te[tix];
        u.A = HB + (size_t)tix * (256 * 512); u.B = W + (size_t)e * (1024 * 256 * 2) + (size_t)u.pn * (256 * 256 * 2); return true;
    }
    __device__ unsigned arow(const Unit&, int r) const { return (unsigned)(r * 512); }
};

__device__ __forceinline__ float sigm(float v) { return __builtin_amdgcn_rcpf(1.f + __expf(-v)); }
struct EpiProj {
    static constexpr bool PERM = true, HOOK = false;
    bf16_t *QA, *QB, *KVC, *KVS, *KVW, *KVB, *GM;
    __device__ __forceinline__ void mid(f32x4 (&)[2][2][4][2], const Unit&, int, int, int, int) const {}
    __device__ __forceinline__ void operator()(const f32x4 (&acc)[2][2][4][2], const Unit& u, int wr, int wc, int fr, int fq) const {
        const int pn = u.pn; bf16_t* base; int ldc, colt; bool sg = false;
        if (pn < 2) { base = QA; ldc = 512; colt = pn * 256; }
        else if (pn == 2) { base = KVC; ldc = 256; colt = 0; }
        else if (pn == 3) { base = KVS; ldc = 256; colt = 0; }
        else if (pn == 4) { base = KVW; ldc = 256; colt = 0; }
        else if (pn < 7) { base = QB; ldc = 512; colt = (pn - 5) * 256; }
        else if (pn == 7) { base = KVB; ldc = 256; colt = 0; }
        else { base = GM; ldc = 2048; colt = (pn - 8) * 256; sg = true; }
        const float qs = (pn < 2 || pn == 5 || pn == 6) ? 0.125f * 1.4426950408889634f : 1.f;
        const int row0 = u.pm * BM + wr * 64 + fr, col0 = colt + wc * 32 + 8 * fq;
#pragma unroll
        for (int ai = 0; ai < 2; ++ai)
#pragma unroll
            for (int m = 0; m < 4; ++m) { bf16_t* rowp = base + (size_t)(row0 + ai * HALF + m * 16) * ldc + col0;
#pragma unroll
                for (int bj = 0; bj < 2; ++bj) { f32x4 v0 = acc[ai][bj][m][0], v1 = acc[ai][bj][m][1];
                    if (sg) { v0 = (f32x4){sigm(v0[0]), sigm(v0[1]), sigm(v0[2]), sigm(v0[3])}; v1 = (f32x4){sigm(v1[0]), sigm(v1[1]), sigm(v1[2]), sigm(v1[3])}; }
                    v0 = v0 * qs; v1 = v1 * qs;
                    u32x4 w; w.x = cvt_pk_bf16(v0[0], v0[1]); w.y = cvt_pk_bf16(v0[2], v0[3]); w.z = cvt_pk_bf16(v1[0], v1[1]); w.w = cvt_pk_bf16(v1[2], v1[3]);
                    *(u32x4*)(rowp + bj * HALF) = w; } }
    }
};
struct EpiMerge {
    static constexpr bool PERM = true, HOOK = true;
    const bf16_t* GM; bf16_t* MG;
    __device__ __forceinline__ void mid(f32x4 (&acc)[2][2][4][2], const Unit& u, int wr, int wc, int fr, int fq) const {
        const int row0 = u.pm * BM + wr * 64 + fr, col0 = u.pn * BM + wc * 32 + 8 * fq;
        const GAS char* gm = (const GAS char*)GM + ((size_t)row0 * 2048 + col0) * 2;
#pragma unroll
        for (int ai = 0; ai < 2; ++ai)
#pragma unroll
            for (int m = 0; m < 4; ++m) { unsigned ro = (unsigned)(ai * HALF + m * 16) * 4096u; asm volatile("" : "+v"(ro));
#pragma unroll
                for (int bj = 0; bj < 2; ++bj) { const u32x4 ga = *(const GAS u32x4*)(gm + ro + bj * 256), gb = *(const GAS u32x4*)(gm + ro + 2048 + bj * 256);
                    const unsigned gaw[4] = {ga.x, ga.y, ga.z, ga.w}, gbw[4] = {gb.x, gb.y, gb.z, gb.w};
#pragma unroll
                    for (int q = 0; q < 4; ++q) { const float a0 = __uint_as_float(gaw[q] << 16), a1 = __uint_as_float(gaw[q] & 0xffff0000u), b0 = __uint_as_float(gbw[q] << 16), b1 = __uint_as_float(gbw[q] & 0xffff0000u);
                        acc[ai][bj][m][q >> 1][(q & 1) * 2] *= b0 * __builtin_amdgcn_rcpf(a0); acc[ai][bj][m][q >> 1][(q & 1) * 2 + 1] *= b1 * __builtin_amdgcn_rcpf(a1); } } }
    }
    __device__ __forceinline__ void operator()(const f32x4 (&acc)[2][2][4][2], const Unit& u, int wr, int wc, int fr, int fq) const {
        const int row0 = u.pm * BM + wr * 64 + fr, col0 = u.pn * BM + wc * 32 + 8 * fq;
        const GAS char* gm = (const GAS char*)GM + ((size_t)row0 * 2048 + col0) * 2;
        GAS char* mg = (GAS char*)MG + ((size_t)row0 * 1024 + col0) * 2;
#pragma unroll
        for (int ai = 0; ai < 2; ++ai)
#pragma unroll
            for (int m = 0; m < 4; ++m) { unsigned ro = (unsigned)(ai * HALF + m * 16) * 2048u; asm volatile("" : "+v"(ro));
#pragma unroll
                for (int bj = 0; bj < 2; ++bj) { const u32x4 ga = *(const GAS u32x4*)(gm + 2 * ro + bj * 256); const unsigned gaw[4] = {ga.x, ga.y, ga.z, ga.w}; float o[8];
#pragma unroll
                    for (int q = 0; q < 4; ++q) { o[2 * q] = acc[ai][bj][m][q >> 1][(q & 1) * 2] * __uint_as_float(gaw[q] << 16); o[2 * q + 1] = acc[ai][bj][m][q >> 1][(q & 1) * 2 + 1] * __uint_as_float(gaw[q] & 0xffff0000u); }
                    u32x4 w; w.x = cvt_pk_bf16(o[0], o[1]); w.y = cvt_pk_bf16(o[2], o[3]); w.z = cvt_pk_bf16(o[4], o[5]); w.w = cvt_pk_bf16(o[6], o[7]);
                    *(GAS u32x4*)(mg + ro + bj * 256) = w; } }
    }
};
struct EpiX1 {
    static constexpr bool PERM = false, HOOK = false;
    const float* x; float* out;
    __device__ __forceinline__ void mid(f32x4 (&)[2][2][4][2], const Unit&, int, int, int, int) const {}
    __device__ __forceinline__ void operator()(const f32x4 (&acc)[2][2][4][2], const Unit& u, int wr, int wc, int fr, int fq) const {
        const int row0 = u.pm * BM + wr * 64 + fr, col0 = u.pn * BM + wc * 32 + 4 * fq;
#pragma unroll
        for (int ai = 0; ai < 2; ++ai)
#pragma unroll
            for (int m = 0; m < 4; ++m) { const size_t off = (size_t)(row0 + ai * HALF + m * 16) * 1024 + col0;
#pragma unroll
                for (int bj = 0; bj < 2; ++bj)
#pragma unroll
                    for (int n = 0; n < 2; ++n) { const f32x4 bs = *(const f32x4*)(x + off + bj * HALF + n * 16); *(f32x4*)(out + off + bj * HALF + n * 16) = bs + acc[ai][bj][m][n]; } }
    }
};
struct EpiHB {
    static constexpr bool PERM = true, HOOK = false;
    bf16_t* HB;
    __device__ __forceinline__ void mid(f32x4 (&)[2][2][4][2], const Unit&, int, int, int, int) const {}
    __device__ __forceinline__ void operator()(const f32x4 (&acc)[2][2][4][2], const Unit& u, int wr, int wc, int fr, int fq) const {
        const int row0 = u.pm * BM + wr * 64 + fr, col0 = u.pn * HALF + wc * 32 + 8 * fq;
#pragma unroll
        for (int ai = 0; ai < 2; ++ai)
#pragma unroll
            for (int m = 0; m < 4; ++m) { float o[8];
#pragma unroll
                for (int n = 0; n < 2; ++n)
#pragma unroll
                    for (int j = 0; j < 4; ++j) { const float g = acc[ai][0][m][n][j]; o[n * 4 + j] = g * sigm(g) * acc[ai][1][m][n][j]; }
                u32x4 w; w.x = cvt_pk_bf16(o[0], o[1]); w.y = cvt_pk_bf16(o[2], o[3]); w.z = cvt_pk_bf16(o[4], o[5]); w.w = cvt_pk_bf16(o[6], o[7]);
                *(u32x4*)(HB + (size_t)(row0 + ai * HALF + m * 16) * 256 + col0) = w; }
    }
};
struct EpiYS {
    static constexpr bool PERM = true, HOOK = false;
    bf16_t* YS;
    __device__ __forceinline__ void mid(f32x4 (&)[2][2][4][2], const Unit&, int, int, int, int) const {}
    __device__ __forceinline__ void operator()(const f32x4 (&acc)[2][2][4][2], const Unit& u, int wr, int wc, int fr, int fq) const {
        const int row0 = u.pm * BM + wr * 64 + fr, col0 = u.pn * BM + wc * 32 + 8 * fq;
#pragma unroll
        for (int ai = 0; ai < 2; ++ai)
#pragma unroll
            for (int m = 0; m < 4; ++m) { bf16_t* rowp = YS + (size_t)(row0 + ai * HALF + m * 16) * 1024 + col0;
#pragma unroll
                for (int bj = 0; bj < 2; ++bj) { const f32x4 v0 = acc[ai][bj][m][0], v1 = acc[ai][bj][m][1];
                    u32x4 w; w.x = cvt_pk_bf16(v0[0], v0[1]); w.y = cvt_pk_bf16(v0[2], v0[3]); w.z = cvt_pk_bf16(v1[0], v1[1]); w.w = cvt_pk_bf16(v1[2], v1[3]);
                    *(u32x4*)(rowp + bj * HALF) = w; } }
    }
};
}

__device__ __forceinline__ unsigned pk2(float lo, float hi) { return (unsigned)f2bf(lo) | ((unsigned)f2bf(hi) << 16); }
struct TrItem { const float* src; bf16_t* dst; int ldw, ldt, nvalid, frag; };
struct TrRegs { f32x4v v[8]; };
__device__ __forceinline__ void tr_load(TrRegs& t, const TrItem& it, int lane) {
  const int n4 = 4 * (lane & 7), kr = lane >> 3;
#pragma unroll
  for (int i = 0; i < 8; ++i) { if (n4 < it.nvalid) t.v[i] = *(const GAS f32x4v*)(it.src + (size_t)(kr + 8 * i) * it.ldw + n4); else t.v[i] = (f32x4v){0.f, 0.f, 0.f, 0.f}; }
}
__device__ __forceinline__ void tr_store(const TrRegs& t, const TrItem& it, LAS float* scr, int lane) {
  const int n4 = 4 * (lane & 7), kr = lane >> 3;
#pragma unroll
  for (int i = 0; i < 8; ++i) { LAS float* p = scr + (kr + 8 * i) * 33 + n4; p[0] = t.v[i].x; p[1] = t.v[i].y; p[2] = t.v[i].z; p[3] = t.v[i].w; }
  asm volatile("s_waitcnt lgkmcnt(0)" ::: "memory");
  const int c = lane & 7;
#pragma unroll
  for (int j = 0; j < 4; ++j) { const int n = (lane >> 3) + 8 * j; const LAS float* s = scr + (8 * c) * 33 + n;
    pg8::u32x4 o; o.x = pk2(s[0 * 33], s[1 * 33]); o.y = pk2(s[2 * 33], s[3 * 33]); o.z = pk2(s[4 * 33], s[5 * 33]); o.w = pk2(s[6 * 33], s[7 * 33]);
    if (it.frag) *(GAS pg8::u32x4*)(it.dst + ((size_t)(c >> 1) * 64 + (c & 1) * 32 + n) * 8) = o;
    else *(GAS pg8::u32x4*)(it.dst + (size_t)n * it.ldt + 8 * c) = o; }
  asm volatile("s_waitcnt lgkmcnt(0)" ::: "memory");
}

namespace att {
typedef float f32x16 __attribute__((ext_vector_type(16)));
typedef short bf16x8 __attribute__((ext_vector_type(8)));
typedef short s16x4 __attribute__((ext_vector_type(4)));
typedef unsigned u32x4 __attribute__((ext_vector_type(4)));
constexpr float LOG2E = 1.4426950408889634f, C2 = 0.125f * LOG2E, NEG = -1e30f;
constexpr int L_KS = 0, L_VS = 16384, L_WSC = 32768, L_PS = 36864, L_SCR = 69632, L_MSK = 77824;
__device__ __forceinline__ int crow(int r, int hi) { return (r & 3) + 8 * (r >> 2) + 4 * hi; }
__device__ __forceinline__ unsigned cvtpk(float lo, float hi) { unsigned r; asm volatile("v_cvt_pk_bf16_f32 %0, %1, %2" : "=v"(r) : "v"(lo), "v"(hi)); return r; }
struct KVRegs { u32x4 k, v; };
__device__ __forceinline__ KVRegs kv_load(const bf16_t* kptr, const bf16_t* vptr, int pitch, int wid, int lane) {
  KVRegs r;
  r.k = *(const GAS u32x4*)(kptr + (size_t)lane * pitch + wid * 8);
  r.v = *(const GAS u32x4*)(vptr + (size_t)(16 * (wid & 3) + (lane >> 2)) * pitch + (wid >> 2) * 32 + (lane & 3) * 8);
  return r;
}
__device__ __forceinline__ void kv_store(LAS unsigned char* Ks, LAS unsigned char* Vs, const KVRegs& r, int wid, int lane) {
  *(LAS u32x4*)(Ks + wid * 1024 + lane * 16) = r.k;
  *(LAS u32x4*)(Vs + wid * 1024 + lane * 16) = r.v;
}
__device__ __forceinline__ void qkt(f32x16& p0, f32x16& p1, const LAS unsigned char* Ks, const bf16x8 (&qr)[4], int r32, int hi) {
  const LAS unsigned char* kb = Ks + hi * 1024 + r32 * 16;
  const f32x16 z = {0.f, 0.f, 0.f, 0.f, 0.f, 0.f, 0.f, 0.f, 0.f, 0.f, 0.f, 0.f, 0.f, 0.f, 0.f, 0.f};
  p0 = z; p1 = z;
#pragma unroll
  for (int d0 = 0; d0 < 4; ++d0) {
    const bf16x8 b0 = *(const LAS bf16x8*)(kb + d0 * 2048), b1 = *(const LAS bf16x8*)(kb + d0 * 2048 + 512);
    p0 = __builtin_amdgcn_mfma_f32_32x32x16_bf16(b0, qr[d0], p0, 0, 0, 0);
    p1 = __builtin_amdgcn_mfma_f32_32x32x16_bf16(b1, qr[d0], p1, 0, 0, 0);
  }
}
typedef short v4i16_t __attribute__((ext_vector_type(4)));
__device__ __forceinline__ s16x4 vtr(const LAS unsigned char* p) { return __builtin_bit_cast(s16x4, __builtin_amdgcn_ds_read_tr16_b64_v4i16((LAS v4i16_t*)p)); }
__device__ __forceinline__ void pv(f32x16 (&o)[2], const LAS unsigned char* Vs, const bf16x8 (&pa)[4], int lane) {
  const int hi = lane >> 5;
  const LAS unsigned char* vb = Vs + ((lane >> 4) & 1) * 32 + (lane & 3) * 8 + (4 * hi + ((lane & 15) >> 2)) * 64;
#pragma unroll
  for (int d0 = 0; d0 < 2; ++d0)
#pragma unroll
    for (int ks = 0; ks < 4; ++ks) {
      const s16x4 lo = vtr(vb + d0 * 4096 + ks * 1024), hh = vtr(vb + d0 * 4096 + ks * 1024 + 512);
      const bf16x8 vf = {lo[0], lo[1], lo[2], lo[3], hh[0], hh[1], hh[2], hh[3]};
      o[d0] = __builtin_amdgcn_mfma_f32_32x32x16_bf16(pa[ks], vf, o[d0], 0, 0, 0);
    }
}
__device__ __forceinline__ void pack_p(bf16x8 (&pa)[4], const f32x16& p0, const f32x16& p1) {
  u32x4 w0 = {cvtpk(p0[0], p0[1]), cvtpk(p0[2], p0[3]), cvtpk(p0[4], p0[5]), cvtpk(p0[6], p0[7])};
  u32x4 w1 = {cvtpk(p0[8], p0[9]), cvtpk(p0[10], p0[11]), cvtpk(p0[12], p0[13]), cvtpk(p0[14], p0[15])};
  u32x4 w2 = {cvtpk(p1[0], p1[1]), cvtpk(p1[2], p1[3]), cvtpk(p1[4], p1[5]), cvtpk(p1[6], p1[7])};
  u32x4 w3 = {cvtpk(p1[8], p1[9]), cvtpk(p1[10], p1[11]), cvtpk(p1[12], p1[13]), cvtpk(p1[14], p1[15])};
  pa[0] = __builtin_bit_cast(bf16x8, w0); pa[1] = __builtin_bit_cast(bf16x8, w1); pa[2] = __builtin_bit_cast(bf16x8, w2); pa[3] = __builtin_bit_cast(bf16x8, w3);
}
__device__ __forceinline__ bf16x8 make_kext(int keyidx, int hi) {
  const unsigned short b = f2bf((float)keyidx); u32x4 w = {hi == 0 ? ((unsigned)b | ((unsigned)b << 16)) : 0u, 0u, 0u, 0u};
  return __builtin_bit_cast(bf16x8, w);
}
__device__ __forceinline__ bf16x8 make_qext(float slope, int hi) {
  const unsigned short h = f2bf(slope), l = f2bf(slope - bf2f(h)); u32x4 w = {hi == 0 ? ((unsigned)h | ((unsigned)l << 16)) : 0u, 0u, 0u, 0u};
  return __builtin_bit_cast(bf16x8, w);
}
struct Ext { bf16x8 q, k0, k1; };
__device__ __forceinline__ void qkt_ext(f32x16& p0, f32x16& p1, const LAS unsigned char* Ks, const bf16x8 (&qr)[4], const Ext& ex, int r32, int hi) {
  qkt(p0, p1, Ks, qr, r32, hi);
  p0 = __builtin_amdgcn_mfma_f32_32x32x16_bf16(ex.k0, ex.q, p0, 0, 0, 0);
  p1 = __builtin_amdgcn_mfma_f32_32x32x16_bf16(ex.k1, ex.q, p1, 0, 0, 0);
}
template <int MASK>
__device__ __forceinline__ void mask_apply(f32x16& p0, f32x16& p1, int t, int kbase, int W, int hi) {
  if (MASK == 0) return;
#pragma unroll
  for (int r = 0; r < 16; ++r) {
    const int key0 = (r & 3) + 8 * (r >> 2) + 4 * hi;
    if (MASK == 3) { const int c0 = kbase + key0, c1 = c0 + 32; p0[r] = (16 * c0 + 31 <= t && c0 < 127) ? p0[r] : NEG; p1[r] = (16 * c1 + 31 <= t && c1 < 127) ? p1[r] : NEG; }
    else { const int d0 = t - (kbase + key0), d1 = d0 - 32;
      if (MASK == 1) { p0[r] = (d0 >= 0 && d0 < W) ? p0[r] : NEG; p1[r] = (d1 >= 0 && d1 < W) ? p1[r] : NEG; }
      if (MASK == 2) { p0[r] = d0 >= 0 ? p0[r] : NEG; p1[r] = d1 >= 0 ? p1[r] : NEG; } }
  }
}
__device__ __forceinline__ float row_max(const f32x16& p0, const f32x16& p1) {
  float a = fmaxf(p0[0], p1[0]), b = fmaxf(p0[1], p1[1]);
#pragma unroll
  for (int r = 2; r < 16; r += 2) { a = fmaxf(a, fmaxf(p0[r], p1[r])); b = fmaxf(b, fmaxf(p0[r + 1], p1[r + 1])); }
  return fmaxf(a, b);
}
__device__ __forceinline__ float expo(f32x16& p0, f32x16& p1, float ref) {
  float rs0 = 0.f, rs1 = 0.f;
#pragma unroll
  for (int r = 0; r < 16; ++r) { p0[r] = __builtin_amdgcn_exp2f(p0[r] - ref); p1[r] = __builtin_amdgcn_exp2f(p1[r] - ref); rs0 += p0[r]; rs1 += p1[r]; }
  return rs0 + rs1;
}
__device__ __forceinline__ void scale_rows(f32x16 (&o)[2], float f, LAS float* wsc, int r32, int hi) {
  if (hi == 0) wsc[r32] = f;
#pragma unroll
  for (int r = 0; r < 16; ++r) { const float a = wsc[crow(r, hi)]; o[0][r] *= a; o[1][r] *= a; }
}
constexpr float THR = 8.f;
template <int MASK>
__device__ __forceinline__ void tile_step(f32x16 (&o)[2], float& m, float& l, const bf16x8 (&qr)[4], const Ext& ex, const LAS unsigned char* Ks, const LAS unsigned char* Vs, LAS float* wsc,
                                          float cj, int t, int kbase, int W, bool rowsel, int lane) {
  const int r32 = lane & 31, hi = lane >> 5;
  f32x16 p0, p1;
  qkt_ext(p0, p1, Ks, qr, ex, r32, hi);
  mask_apply<MASK>(p0, p1, t, kbase, W, hi);
  float mt = row_max(p0, p1);
  mt = rowsel ? mt : NEG;
  mt = fmaxf(mt, __shfl_xor(mt, 32)) + cj;
  if (__any(mt > m + THR)) {
    const float mn = fmaxf(m, mt), alpha = __builtin_amdgcn_exp2f(m - mn);
    m = mn; l *= alpha;
    scale_rows(o, alpha, wsc, r32, hi);
  }
  float ref = m < -1e29f ? 0.f : m - cj;
  ref = rowsel ? ref : 1e30f;
  l += expo(p0, p1, ref);
  bf16x8 pa[4]; pack_p(pa, p0, p1);
  pv(o, Vs, pa, lane);
}
__device__ __forceinline__ void load_q(bf16x8 (&qr)[4], const bf16_t* qrow  , int hi) {
#pragma unroll
  for (int d0 = 0; d0 < 4; ++d0) qr[d0] = *(const GAS bf16x8*)(qrow + d0 * 16 + hi * 8);
}
__device__ __forceinline__ void zero_o(f32x16 (&o)[2]) {
  const f32x16 z = {0.f, 0.f, 0.f, 0.f, 0.f, 0.f, 0.f, 0.f, 0.f, 0.f, 0.f, 0.f, 0.f, 0.f, 0.f, 0.f}; o[0] = z; o[1] = z;
}

struct SeqIter { int j, end; __device__ __forceinline__ int pop() { return j < end ? j++ : -1; } };
struct BitIter { unsigned rem; __device__ __forceinline__ int pop() { if (!rem) return -1; const int j = __builtin_ctz(rem); rem &= rem - 1; return j; } };
template <class It, class Step>
__device__ __forceinline__ void stream_tiles(LAS unsigned char* lds, It it, const bf16_t* kp, const bf16_t* vp, int wid, int lane, Step step) {
  int j0 = it.pop(), j1 = it.pop();
  KVRegs a = kv_load(kp + (size_t)j0 * 64 * 256, vp + (size_t)j0 * 64 * 256, 256, wid, lane), b = a;
  if (j1 >= 0) b = kv_load(kp + (size_t)j1 * 64 * 256, vp + (size_t)j1 * 64 * 256, 256, wid, lane);
  kv_store(lds + L_KS, lds + L_VS, a, wid, lane);
  __syncthreads();
  int sl = 0;
#pragma unroll 1
  for (;;) {
    const int j2 = it.pop();
    if (j2 >= 0) a = kv_load(kp + (size_t)j2 * 64 * 256, vp + (size_t)j2 * 64 * 256, 256, wid, lane);
    step(j0, sl);
    if (j1 >= 0) kv_store(lds + L_KS + (sl ^ 8192), lds + L_VS + (sl ^ 8192), b, wid, lane);
    __syncthreads();
    if (j1 < 0) break;
    j0 = j1; j1 = j2; b = a; sl ^= 8192;
  }
}
__device__ __forceinline__ void swa_unit(LAS unsigned char* lds, int b, int hkv, int qt, const bf16_t* __restrict__ QB, const bf16_t* __restrict__ KVB, const float* __restrict__ sinks, bf16_t* __restrict__ OAB) {
  const int tid = tid_fresh(), lane = tid & 63, wid = __builtin_amdgcn_readfirstlane(tid >> 6), r32 = lane & 31, hi = lane >> 5;
  const int g = wid >> 1, head = hkv * 4 + g, t0 = qt * 64, t = t0 + 32 * (wid & 1) + r32;
  const size_t tokb = (size_t)b * S;
  LAS float* wsc = (LAS float*)(lds + L_WSC) + wid * 128;
  const float slope2 = exp2f(-0.5f * (float)(1 + head)) * LOG2E, sink2 = sinks[head] * LOG2E;
  Ext ex; ex.q = make_qext(slope2, hi); ex.k0 = make_kext(r32, hi); ex.k1 = make_kext(r32 + 32, hi);
  bf16x8 qr[4]; load_q(qr, QB + (tokb + t) * 512 + head * 64, hi);
  f32x16 o[2]; zero_o(o);
  float m = NEG, l = 0.f;
  const bf16_t* kp = KVB + tokb * 256 + hkv * 64; const bf16_t* vp = kp + 128;
  stream_tiles(lds, SeqIter{qt >= 2 ? qt - 2 : 0, qt + 1}, kp, vp, wid, lane, [&](int j, int sl) {
    const float cj = slope2 * (float)(j * 64);
    if (j == qt - 1) tile_step<0>(o, m, l, qr, ex, lds + L_KS + sl, lds + L_VS + sl, wsc, cj, t, j * 64, 128, true, lane);
    else tile_step<1>(o, m, l, qr, ex, lds + L_KS + sl, lds + L_VS + sl, wsc, cj, t, j * 64, 128, true, lane);
  });
  const float lt = l + __shfl_xor(l, 32), sk = sink2 + slope2 * (float)t;
  const float mf = fmaxf(m, sk), z = lt * __builtin_amdgcn_exp2f(m - mf) + __builtin_amdgcn_exp2f(sk - mf);
  scale_rows(o, __builtin_amdgcn_exp2f(m - mf) / z, wsc, r32, hi);
  bf16_t* op = OAB + (tokb + t0 + 32 * (wid & 1)) * 1024 + head * 64 + r32;
#pragma unroll
  for (int r = 0; r < 16; ++r) { const int q = crow(r, hi); op[(size_t)q * 1024] = f2bf(o[0][r]); op[(size_t)q * 1024 + 32] = f2bf(o[1][r]); }
}
__device__ __forceinline__ void swa_phase(LAS unsigned char* lds, const bf16_t* QB, const bf16_t* KVB, const float* sinks, bf16_t* OAB) {
#pragma unroll 1
  for (int u = blockIdx.x; u < NB * 2 * 32; u += gridDim.x) { swa_unit(lds, u >> 6, (u >> 5) & 1, u & 31, QB, KVB, sinks, OAB); }
}

constexpr int L_P4 = 36864, L_SC2 = 102400, L_MK2 = 110592;
__device__ __forceinline__ void store_o(LAS unsigned char* stage, const f32x16 (&o)[2], bf16_t* orow0  , int lane) {
  const int r32 = lane & 31, hi = lane >> 5;
  LAS bf16_t* st = (LAS bf16_t*)stage;
#pragma unroll
  for (int r = 0; r < 16; ++r) { const int q = crow(r, hi); st[q * 64 + r32] = f2bf(o[0][r]); st[q * 64 + 32 + r32] = f2bf(o[1][r]); }
  asm volatile("s_waitcnt lgkmcnt(0)" ::: "memory");
#pragma unroll
  for (int i = 0; i < 4; ++i) { const int row = i * 8 + (lane >> 3), ch = lane & 7; const u32x4 v = *(const LAS u32x4*)(st + row * 64 + ch * 8); *(GAS u32x4*)(orow0 + (size_t)row * 1024 + ch * 8) = v; }
}
__device__ __forceinline__ void nsa_unit(LAS unsigned char* lds, int b, int hkv, int qt, const bf16_t* __restrict__ QA, const bf16_t* __restrict__ KC, const bf16_t* __restrict__ VC,
                                         const bf16_t* __restrict__ KVS, const bf16_t* __restrict__ KVW, const float* __restrict__ GN, bf16_t* __restrict__ OAB, unsigned long long& t_acc) {
  const int tid = tid_fresh(), lane = tid & 63, wid = __builtin_amdgcn_readfirstlane(tid >> 6), r32 = lane & 31, hi = lane >> 5;
  unsigned long long t_b = PROBE_SPIN >= 0 ? __builtin_amdgcn_s_memrealtime() : 0ull;
#define SUBP(k) do { if (PROBE_SPIN >= 0) { if (PROBE_SPIN == (k) || PROBE_SPIN == 35) t_acc += __builtin_amdgcn_s_memrealtime() - t_b; t_b = __builtin_amdgcn_s_memrealtime(); } } while (0)
  const int g = wid >> 1, qh = wid & 1, head = hkv * 4 + g, t0 = qt * 64, ql = 32 * qh + r32, t = t0 + ql;
  const size_t tokb = (size_t)b * S;
  LAS float* wsc = (LAS float*)(lds + L_WSC) + wid * 128;
  LAS float* P4 = (LAS float*)(lds + L_P4);
  LAS float* SCR = (LAS float*)(lds + L_SC2);
  LAS unsigned* MSK = (LAS unsigned*)(lds + L_MK2);
  const float slope2 = exp2f(-0.5f * (float)(9 + head)) * LOG2E;
  { const float* gnp_ = GN + (tokb + t) * 32 + hkv * 12 + g * 3;
    if (hi == 0) { wsc[32 + r32] = gnp_[0]; wsc[64 + r32] = gnp_[1]; wsc[96 + r32] = gnp_[2]; } }
  bf16x8 qr[4]; load_q(qr, QA + (tokb + t) * 512 + head * 64, hi);
  Ext ex; ex.q = make_qext(slope2, hi); ex.k0 = make_kext(r32, hi); ex.k1 = make_kext(r32 + 32, hi);
  const int nct = (t0 + 63 >= 31 + 16 * 64) ? 2 : 1;
  const bf16_t* kcp = KC + ((size_t)b * 128 * 2 + hkv) * 64; const bf16_t* vcp = VC + ((size_t)b * 128 * 2 + hkv) * 64;
  f32x16 acc[2];
  float imp[4] = {0.f, 0.f, 0.f, 0.f};
  {
    { KVRegs kc0 = kv_load(kcp, vcp, 128, wid, lane); kv_store(lds + L_KS, lds + L_VS, kc0, wid, lane); }
    if (nct == 2) { KVRegs kc1 = kv_load(kcp + (size_t)64 * 128, vcp + (size_t)64 * 128, 128, wid, lane); kv_store(lds + L_KS + 8192, lds + L_VS + 8192, kc1, wid, lane); }
    if (tid < 65) MSK[tid] = 0u;
    __syncthreads();
    Ext exc = ex; exc.q = make_qext(16.f * slope2, hi);
    float m = NEG, l = 0.f;
    for (int ct = 0; ct < nct; ++ct) {
      f32x16 p0, p1;
      qkt_ext(p0, p1, lds + L_KS + ct * 8192, qr, exc, r32, hi);
      mask_apply<3>(p0, p1, t, ct * 64, 0, hi);
      const float cj = slope2 * (float)(1024 * ct + 31);
      float mt = row_max(p0, p1); mt = fmaxf(mt, __shfl_xor(mt, 32)) + cj;
      const float mn = fmaxf(m, mt), alpha = __builtin_amdgcn_exp2f(m - mn);
      m = mn; l = l * alpha + expo(p0, p1, mn < -1e29f ? 0.f : mn - cj);
    }
    l += __shfl_xor(l, 32);
    const float inv = l > 0.f ? 1.f / l : 1.f;
    f32x16 ocmp[2]; zero_o(ocmp);
    for (int ct = 0; ct < nct; ++ct) {
      f32x16 p0, p1;
      qkt_ext(p0, p1, lds + L_KS + ct * 8192, qr, exc, r32, hi);
      mask_apply<3>(p0, p1, t, ct * 64, 0, hi);
      (void)expo(p0, p1, m < -1e29f ? 0.f : m - slope2 * (float)(1024 * ct + 31));
#pragma unroll
      for (int r = 0; r < 16; ++r) { p0[r] *= inv; p1[r] *= inv; }
      { LAS float* pr = P4 + (g * 64 + ql) * 64 + 4 * hi;
#pragma unroll
        for (int r = 0; r < 16; ++r) { const int c0 = (r & 3) + 8 * (r >> 2); pr[c0] = p0[r]; pr[c0 + 32] = p1[r]; } }
      { bf16x8 pa[4]; pack_p(pa, p0, p1); pv(ocmp, lds + L_VS + ct * 8192, pa, lane); }
      __syncthreads();
#pragma unroll
      for (int i = 0; i < 4; ++i) {
        const int pi = tid + i * 512, q = pi >> 5, j = pi & 31;
        if (j <= qt) {
          float sacc = 0.f;
#pragma unroll
          for (int u = 0; u < 5; ++u) {
            const int c = 4 * j - 1 + u, cl = c - 64 * ct;
            if (c >= 0 && c < 127 && cl >= 0 && cl < 64) {
              const float w = (u == 0 || u == 4) ? 0.5f : 1.f;
              sacc += w * ((P4[(0 * 64 + q) * 64 + cl] + P4[(1 * 64 + q) * 64 + cl]) + (P4[(2 * 64 + q) * 64 + cl] + P4[(3 * 64 + q) * 64 + cl]));
            }
          }
          imp[i] += sacc;
        }
      }
      __syncthreads();
    }
    scale_rows(ocmp, wsc[32 + r32], wsc, r32, hi);
    acc[0] = ocmp[0]; acc[1] = ocmp[1];
  }
  SUBP(31);
  {
    const int cur = qt;
#pragma unroll
    for (int i = 0; i < 4; ++i) {
      const int pi = tid + i * 512, j = pi & 31;
      const bool forced = (j == 0) || (j == cur) || (j == cur - 1);
      SCR[pi] = forced ? 1e9f : (j <= cur ? imp[i] : NEG);
    }
    __syncthreads();
#pragma unroll
    for (int i = 0; i < 4; ++i) {
      const int pi = tid + i * 512, q = pi >> 5, j = pi & 31;
      const float sj = SCR[pi]; int rank = 0;
      for (int k = 0; k < 32; ++k) { const float sk = SCR[q * 32 + k]; rank += ((sk > sj) || (sk == sj && k < j)) ? 1 : 0; }
      if (rank < 8 && sj > -5e29f) { __hip_atomic_fetch_or(&MSK[q], 1u << j, __ATOMIC_RELAXED, __HIP_MEMORY_SCOPE_WORKGROUP); __hip_atomic_fetch_or(&MSK[64], 1u << j, __ATOMIC_RELAXED, __HIP_MEMORY_SCOPE_WORKGROUP); }
    }
    __syncthreads();
  }
  SUBP(32);
  const unsigned um = MSK[64], mymask = MSK[ql];
  { LAS float* pk = (LAS float*)(lds + L_P4) + wid * 2048 + lane;
#pragma unroll
    for (int r = 0; r < 16; ++r) { pk[r * 64] = acc[0][r]; pk[1024 + r * 64] = acc[1][r]; } }
  {
    f32x16 o[2]; zero_o(o);
    float m = NEG, l = 0.f;
    const bf16_t* kp = KVS + tokb * 256 + hkv * 64; const bf16_t* vp = kp + 128;
    stream_tiles(lds, BitIter{(unsigned)__builtin_amdgcn_readfirstlane(um)}, kp, vp, wid, lane, [&](int j, int sl) {
      const bool rs = ((mymask >> j) & 1u) != 0u; const float cj = slope2 * (float)(j * 64);
      if (j == qt) tile_step<2>(o, m, l, qr, ex, lds + L_KS + sl, lds + L_VS + sl, wsc, cj, t, j * 64, 0, rs, lane);
      else tile_step<0>(o, m, l, qr, ex, lds + L_KS + sl, lds + L_VS + sl, wsc, cj, t, j * 64, 0, rs, lane);
    });
    const float lt = l + __shfl_xor(l, 32), inv = lt > 0.f ? 1.f / lt : 1.f;
    scale_rows(o, inv * wsc[64 + r32], wsc, r32, hi);
    LAS float* pk = (LAS float*)(lds + L_P4) + wid * 2048 + lane;
#pragma unroll
    for (int r = 0; r < 16; ++r) { pk[r * 64] += o[0][r]; pk[1024 + r * 64] += o[1][r]; }
  }
  SUBP(33);
  {
    zero_o(acc);
    float m = NEG, l = 0.f;
    const bf16_t* kp = KVW + tokb * 256 + hkv * 64; const bf16_t* vp = kp + 128;
    stream_tiles(lds, SeqIter{qt >= 4 ? qt - 4 : 0, qt + 1}, kp, vp, wid, lane, [&](int j, int sl) {
      const float cj = slope2 * (float)(j * 64);
      if (j < qt && j > qt - 4) tile_step<0>(acc, m, l, qr, ex, lds + L_KS + sl, lds + L_VS + sl, wsc, cj, t, j * 64, 256, true, lane);
      else tile_step<1>(acc, m, l, qr, ex, lds + L_KS + sl, lds + L_VS + sl, wsc, cj, t, j * 64, 256, true, lane);
    });
    const float lt = l + __shfl_xor(l, 32);
    scale_rows(acc, wsc[96 + r32] / lt, wsc, r32, hi);
    LAS const float* pk = (LAS const float*)(lds + L_P4) + wid * 2048 + lane;
#pragma unroll
    for (int r = 0; r < 16; ++r) { acc[0][r] += pk[r * 64]; acc[1][r] += pk[1024 + r * 64]; }
  }
  SUBP(34);
  store_o(lds + wid * 4096, acc, OAB + (tokb + t0 + 32 * qh) * 1024 + 512 + head * 64, lane);
  __syncthreads();
  SUBP(36);
#undef SUBP
}
__device__ __forceinline__ void nsa_phase(LAS unsigned char* lds, const bf16_t* QA, const bf16_t* KC, const bf16_t* VC, const bf16_t* KVS, const bf16_t* KVW, const float* GN, bf16_t* OAB, unsigned long long& t_acc) {
#pragma unroll 1
  for (int pr0 = blockIdx.x; pr0 < 256; pr0 += gridDim.x) {
    const int pr = gridDim.x == 256 ? ((pr0 & 7) * 32 + (pr0 >> 3)) : pr0;
    const int bh = pr >> 4, s = pr & 15;
#pragma unroll 1
    for (int i = 0; i < 2; ++i) nsa_unit(lds, bh >> 1, bh & 1, i == 0 ? 31 - s : s, QA, KC, VC, KVS, KVW, GN, OAB, t_acc);
  }
}
}


namespace wg {
using att::f32x16; using att::bf16x8; using att::crow;
typedef short s16x4 __attribute__((ext_vector_type(4)));
template <int NI, int UNR>
__device__ __forceinline__ void wave_gemm(f32x16 (&acc)[NI], const bf16_t* wl, int ldw, const bf16_t* xl, int ksteps) {
  for (int ks = 0; ks < ksteps; ks += UNR) {
    bf16x8 a[UNR][NI], b[UNR];
#pragma unroll
    for (int u = 0; u < UNR; ++u) { b[u] = *(const GAS bf16x8*)(xl + (ks + u) * 16);
#pragma unroll
      for (int i = 0; i < NI; ++i) a[u][i] = *(const GAS bf16x8*)(wl + (size_t)i * 32 * ldw + (ks + u) * 16); }
#pragma unroll
    for (int u = 0; u < UNR; ++u)
#pragma unroll
      for (int i = 0; i < NI; ++i) acc[i] = __builtin_amdgcn_mfma_f32_32x32x16_bf16(a[u][i], b[u], acc[i], 0, 0, 0);
  }
}
constexpr int L_XW = 0, L_RED = 0;
__device__ __forceinline__ void cmp_unit(LAS unsigned char* lds, int sel, int rt, const bf16_t* __restrict__ KVC, const bf16_t* __restrict__ W1F, const float* __restrict__ bias1,
                                         const bf16_t* __restrict__ W2T, bf16_t* __restrict__ KCout) {
  const int tid = tid_fresh(), lane = tid & 63, wid = __builtin_amdgcn_readfirstlane(tid >> 6), r32 = lane & 31, hi = lane >> 5;
  const int b = rt >> 3, c0 = (rt & 7) * 16;
  {
    const bf16_t* src = KVC + ((size_t)b * S + 16 * c0) * 256 + sel * 128;
    const int ntok = (16 * c0 + 272 <= S) ? 272 : (S - 16 * c0);
#pragma unroll 1
    for (int e = tid; e < 272 * 16; e += 512) {
      const int T = e >> 4, q = e & 15;
      att::u32x4 v = {0u, 0u, 0u, 0u};
      if (T < ntok) v = *(const GAS att::u32x4*)(src + (size_t)T * 256 + q * 8);
      *(LAS att::u32x4*)(lds + L_XW + T * 256 + ((q ^ ((T >> 4) & 15)) << 4)) = v;
    }
  }
  __syncthreads();
  const int cl = r32 >> 1, hh = r32 & 1;
  const bf16_t* wl = W1F + ((size_t)wid * 128) * 512 + lane * 8;
  const f32x16 z = {0.f, 0.f, 0.f, 0.f, 0.f, 0.f, 0.f, 0.f, 0.f, 0.f, 0.f, 0.f, 0.f, 0.f, 0.f, 0.f};
  f32x16 acc = z;
  bf16x8 a0[8], a1[8];
#define CMP_LOADW(A, i) do { _Pragma("unroll") for (int u = 0; u < 8; ++u) A[u] = *(const GAS bf16x8*)(wl + (size_t)(4 * (i) + u) * 512); } while (0)
#define CMP_MMA(A, i) do { _Pragma("unroll") for (int u = 0; u < 8; ++u) { const int T = 16 * cl + (i) + (u >> 2), q = hh * 8 + 2 * (u & 3) + hi; \
      const bf16x8 bb = *(const LAS bf16x8*)(lds + L_XW + T * 256 + ((q ^ ((T >> 4) & 15)) << 4)); acc = __builtin_amdgcn_mfma_f32_32x32x16_bf16(A[u], bb, acc, 0, 0, 0); } } while (0)
  CMP_LOADW(a0, 0);
#pragma unroll 1
  for (int i = 0; i < 32; i += 4) {
    CMP_LOADW(a1, i + 2);
    CMP_MMA(a0, i);
    if (i + 4 < 32) CMP_LOADW(a0, i + 4);
    CMP_MMA(a1, i + 2);
  }
#undef CMP_LOADW
#undef CMP_MMA
  unsigned pw[8];
#pragma unroll
  for (int r = 0; r < 16; r += 2) {
    float v0 = acc[r] + bias1[32 * wid + crow(r, hi)], v1 = acc[r + 1] + bias1[32 * wid + crow(r + 1, hi)];
    v0 = v0 * __builtin_amdgcn_rcpf(1.f + __expf(-v0)); v1 = v1 * __builtin_amdgcn_rcpf(1.f + __expf(-v1));
    pw[r >> 1] = att::cvtpk(v0, v1);
  }
  const att::u32x4 q0 = {pw[0], pw[1], pw[2], pw[3]}, q1 = {pw[4], pw[5], pw[6], pw[7]};
  const bf16x8 pb0 = __builtin_bit_cast(bf16x8, q0), pb1 = __builtin_bit_cast(bf16x8, q1);
  f32x16 y[2]; y[0] = z; y[1] = z;
#pragma unroll
  for (int db = 0; db < 2; ++db)
#pragma unroll
    for (int s = 0; s < 2; ++s) {
      const bf16_t* wp = W2T + (size_t)(32 * db + r32) * 256 + 32 * wid + 16 * s + 4 * hi;
      const s16x4 lo = *(const GAS s16x4*)wp, hh2 = *(const GAS s16x4*)(wp + 8);
      const bf16x8 af = {lo[0], lo[1], lo[2], lo[3], hh2[0], hh2[1], hh2[2], hh2[3]};
      y[db] = __builtin_amdgcn_mfma_f32_32x32x16_bf16(af, s == 0 ? pb0 : pb1, y[db], 0, 0, 0);
    }
  __syncthreads();
  LAS float* red = (LAS float*)(lds + L_RED);
#pragma unroll
  for (int r = 0; r < 16; ++r) { red[wid * 2048 + r * 64 + lane] = y[0][r]; red[wid * 2048 + 1024 + r * 64 + lane] = y[1][r]; }
  __syncthreads();
#pragma unroll
  for (int i = 0; i < 4; ++i) {
    const int e = tid + 512 * i; float sum = 0.f;
#pragma unroll
    for (int w = 0; w < 8; ++w) sum += red[w * 2048 + e];
    const int db = e >> 10, r = (e >> 6) & 15, ln = e & 63, d = 32 * db + crow(r, ln >> 5), row = ln & 31, c = c0 + (row >> 1), h2 = row & 1;
    if (c < 127) KCout[(((size_t)b * 128 + c) * 2 + h2) * 64 + d] = f2bf(sum);
  }
  __syncthreads();
}
__device__ __forceinline__ void cmp_bias_part(LAS unsigned char* lds, int jb, const float* __restrict__ pos, const float* __restrict__ w1, float* __restrict__ PB) {
  const int tid = tid_fresh(), n = tid & 255, kh = tid >> 8, chunk = jb & 31, k0 = chunk * 64 + kh * 32;
  float s = 0.f;
#pragma unroll
  for (int i = 0; i < 32; ++i) s += pos[k0 + i] * w1[(size_t)(k0 + i) * 256 + n];
  LAS float* part = (LAS float*)lds;
  if (kh) part[n] = s;
  __syncthreads();
  if (!kh) PB[(size_t)chunk * 256 + n] = s + part[n];
  __syncthreads();
}
__device__ __forceinline__ void cmp_bias_final(const float* __restrict__ PB, float* __restrict__ bias1) {
  const int tid = tid_fresh(); float s = 0.f;
#pragma unroll
  for (int c = 0; c < 32; ++c) s += PB[((size_t)(tid >> 8) * 32 + c) * 256 + (tid & 255)];
  bias1[tid] = s;
}
__device__ __forceinline__ void gn_rows(int row0, const bf16_t* __restrict__ XN, const bf16_t* __restrict__ WgnT, float* __restrict__ GN) {
  const int tid = tid_fresh(), lane = tid & 63, wid = __builtin_amdgcn_readfirstlane(tid >> 6), r32 = lane & 31, hi = lane >> 5;
  if (wid < 2) {
    const int row = row0 + 32 * wid + r32;
    f32x16 acc[1]; acc[0] = (f32x16){0.f, 0.f, 0.f, 0.f, 0.f, 0.f, 0.f, 0.f, 0.f, 0.f, 0.f, 0.f, 0.f, 0.f, 0.f, 0.f};
    wave_gemm<1, 8>(acc, WgnT + (size_t)r32 * 1024 + 8 * hi, 1024, XN + (size_t)row * 1024 + 8 * hi, 64);
#pragma unroll
    for (int r = 0; r < 16; ++r) { const int col = crow(r, hi); if (col < 24) GN[(size_t)row * 32 + col] = 1.f / (1.f + __expf(-acc[0][r])); }
  }
}
}


namespace rt {
using att::f32x16; using att::bf16x8; using att::crow;
constexpr int L_RED = 0, L_LG = 65536;
__device__ __forceinline__ void router_rows(LAS unsigned char* lds, int row0, const float* __restrict__ x1, const float* __restrict__ gf, const float* __restrict__ bg, const float* __restrict__ be,
                                            const bf16_t* __restrict__ WrtHi, const bf16_t* __restrict__ WrtLo, bf16_t* __restrict__ H2, bf16_t* __restrict__ H2LO, int* __restrict__ cnt, int* __restrict__ sm, int* __restrict__ list, unsigned long long& t_acc) {
  const int tid = tid_fresh(), lane = tid & 63, wid = __builtin_amdgcn_readfirstlane(tid >> 6), r32 = lane & 31, hi = lane >> 5;
  unsigned long long t_b = PROBE_SPIN >= 0 ? __builtin_amdgcn_s_memrealtime() : 0ull;
#define SUBP(k) do { if (PROBE_SPIN >= 0) { if (PROBE_SPIN == (k)) t_acc += __builtin_amdgcn_s_memrealtime() - t_b; t_b = __builtin_amdgcn_s_memrealtime(); } } while (0)
  {
    f32x4v v[8][4];
#pragma unroll
    for (int rr = 0; rr < 8; ++rr) { const GAS f32x4v* xr = (const GAS f32x4v*)(x1 + (size_t)(row0 + wid * 8 + rr) * D);
#pragma unroll
      for (int j = 0; j < 4; ++j) v[rr][j] = xr[lane + 64 * j]; }
    f32x4v gg[4];
#pragma unroll
    for (int j = 0; j < 4; ++j) gg[j] = ((const GAS f32x4v*)gf)[lane + 64 * j];
    float s[8];
#pragma unroll
    for (int rr = 0; rr < 8; ++rr) { float t = 0.f;
#pragma unroll
      for (int j = 0; j < 4; ++j) t += v[rr][j].x * v[rr][j].x + v[rr][j].y * v[rr][j].y + v[rr][j].z * v[rr][j].z + v[rr][j].w * v[rr][j].w;
      s[rr] = wave_sum(t); }
#pragma unroll
    for (int rr = 0; rr < 8; ++rr) {
      const int r = row0 + wid * 8 + rr; const float rstd = rsqrtf(s[rr] * (1.f / D) + 1e-6f);
#pragma unroll
      for (int j = 0; j < 4; ++j) {
        const f32x4v h = v[rr][j] * rstd * gg[j];
        u16x4v hh, lo;
        hh.x = f2bf(h.x); hh.y = f2bf(h.y); hh.z = f2bf(h.z); hh.w = f2bf(h.w);
        lo.x = f2bf(h.x - bf2f(hh.x)); lo.y = f2bf(h.y - bf2f(hh.y)); lo.z = f2bf(h.z - bf2f(hh.z)); lo.w = f2bf(h.w - bf2f(hh.w));
        ((GAS u16x4v*)(H2 + (size_t)r * D))[lane + 64 * j] = hh;
        ((GAS u16x4v*)(H2LO + (size_t)r * D))[lane + 64 * j] = lo;
      }
    }
  }
  __syncthreads();
  SUBP(61);
  {
    const f32x16 z = {0.f, 0.f, 0.f, 0.f, 0.f, 0.f, 0.f, 0.f, 0.f, 0.f, 0.f, 0.f, 0.f, 0.f, 0.f, 0.f};
    f32x16 acc[2][2]; acc[0][0] = z; acc[0][1] = z; acc[1][0] = z; acc[1][1] = z;
    const bf16_t* xh = H2 + (size_t)(row0 + r32) * D + wid * 128 + 8 * hi; const bf16_t* xl = H2LO + (size_t)(row0 + r32) * D + wid * 128 + 8 * hi;
    const bf16_t* wh = WrtHi + (size_t)r32 * D + wid * 128 + 8 * hi; const bf16_t* wl = WrtLo + (size_t)r32 * D + wid * 128 + 8 * hi;
#pragma unroll 1
    for (int ks = 0; ks < 8; ks += 4) {
      bf16x8 bh[4][2], bl[4][2], ah[4][2], al[4][2];
#pragma unroll
      for (int u = 0; u < 4; ++u)
#pragma unroll
        for (int q = 0; q < 2; ++q) {
          bh[u][q] = *(const GAS bf16x8*)(xh + (size_t)q * 32 * D + (ks + u) * 16); bl[u][q] = *(const GAS bf16x8*)(xl + (size_t)q * 32 * D + (ks + u) * 16);
          ah[u][q] = *(const GAS bf16x8*)(wh + (size_t)q * 32 * D + (ks + u) * 16); al[u][q] = *(const GAS bf16x8*)(wl + (size_t)q * 32 * D + (ks + u) * 16);
        }
#pragma unroll
      for (int u = 0; u < 4; ++u)
#pragma unroll
        for (int rb = 0; rb < 2; ++rb)
#pragma unroll
          for (int cb = 0; cb < 2; ++cb) {
            acc[rb][cb] = __builtin_amdgcn_mfma_f32_32x32x16_bf16(al[u][cb], bh[u][rb], acc[rb][cb], 0, 0, 0);
            acc[rb][cb] = __builtin_amdgcn_mfma_f32_32x32x16_bf16(ah[u][cb], bl[u][rb], acc[rb][cb], 0, 0, 0);
            acc[rb][cb] = __builtin_amdgcn_mfma_f32_32x32x16_bf16(ah[u][cb], bh[u][rb], acc[rb][cb], 0, 0, 0);
          }
    }
    LAS float* red = (LAS float*)(lds + L_RED) + (wid & 3) * 4096 + lane;
    if (wid >= 4) {
#pragma unroll
      for (int rb = 0; rb < 2; ++rb)
#pragma unroll
        for (int cb = 0; cb < 2; ++cb)
#pragma unroll
          for (int r = 0; r < 16; ++r) red[((rb * 2 + cb) * 16 + r) * 64] = acc[rb][cb][r];
    }
    __syncthreads();
    if (wid < 4) {
#pragma unroll
      for (int rb = 0; rb < 2; ++rb)
#pragma unroll
        for (int cb = 0; cb < 2; ++cb)
#pragma unroll
          for (int r = 0; r < 16; ++r) red[((rb * 2 + cb) * 16 + r) * 64] += acc[rb][cb][r];
    }
  }
  __syncthreads();
  {
    LAS const float* red = (LAS const float*)(lds + L_RED);
    LAS float* lg = (LAS float*)(lds + L_LG);
#pragma unroll
    for (int i = 0; i < 8; ++i) {
      const int e = tid + 512 * i;
      const float sum = (red[e] + red[4096 + e]) + (red[8192 + e] + red[12288 + e]);
      const int ln = e & 63, r = (e >> 6) & 15, cb = (e >> 10) & 1, rb = e >> 11;
      lg[(32 * rb + (ln & 31)) * 64 + 32 * cb + crow(r, ln >> 5)] = sum;
    }
    if (tid < 32) ((LAS int*)(lds + L_LG + 16384))[tid] = 0;
  }
  __syncthreads();
  SUBP(62);
  if (tid < 64) {
    LAS int* lcnt = (LAS int*)(lds + L_LG + 16384); LAS int* lbase = lcnt + 32;
    const int r = row0 + tid; LAS const float* lgr = (LAS const float*)(lds + L_LG) + tid * 64;
    int grp = 0; float gmax = -1e30f; float gl[4];
#pragma unroll
    for (int j = 0; j < 4; ++j) { gl[j] = lgr[j] + bg[j]; if (gl[j] > gmax) { gmax = gl[j]; grp = j; } }
    float zs = 0.f;
#pragma unroll
    for (int j = 0; j < 4; ++j) zs += __expf(gl[j] - gmax);
    const float pgrp = 1.f / zs;
    int i1 = 0; float v1 = -1e30f;
    for (int i = 0; i < 8; ++i) { const float e = lgr[4 + grp * 8 + i] + be[grp * 8 + i]; if (e > v1) { v1 = e; i1 = i; } }
    int i2 = 0; float v2 = -1e30f;
    for (int i = 0; i < 8; ++i) { const float e = lgr[4 + grp * 8 + i] + be[grp * 8 + i]; if (i != i1 && e > v2) { v2 = e; i2 = i; } }
    const float e2 = __expf(v2 - v1), w1 = 1.f / (1.f + e2), w2 = e2 * w1;
    const int e_a = grp * 8 + i1, e_b = grp * 8 + i2;
    const int la = __hip_atomic_fetch_add(&lcnt[e_a], 1, __ATOMIC_RELAXED, __HIP_MEMORY_SCOPE_WORKGROUP), lb = __hip_atomic_fetch_add(&lcnt[e_b], 1, __ATOMIC_RELAXED, __HIP_MEMORY_SCOPE_WORKGROUP);
    asm volatile("s_waitcnt lgkmcnt(0)" ::: "memory");
    if (tid < 32) { const int c = lcnt[tid]; lbase[tid] = c > 0 ? atomicAdd(&cnt[tid * CNT_STRIDE], c) : 0; }
    asm volatile("s_waitcnt vmcnt(0) lgkmcnt(0)" ::: "memory");
    const int ra = lbase[e_a] + la, rb = lbase[e_b] + lb;
    sm[SM_EID + 2 * r] = e_a; sm[SM_EID + 2 * r + 1] = e_b;
    ((float*)sm)[SM_WT + 2 * r] = pgrp * w1; ((float*)sm)[SM_WT + 2 * r + 1] = pgrp * w2;
    sm[SM_RANK + 2 * r] = ra; sm[SM_RANK + 2 * r + 1] = rb;
    list[(size_t)e_a * NTOK + ra] = r; list[(size_t)e_b * NTOK + rb] = r;
  }
  __syncthreads();
  SUBP(63);
#undef SUBP
}
}

__device__ __forceinline__ void ph_prep_xn(const float* __restrict__ x, const float* __restrict__ g, bf16_t* __restrict__ xn) {
  const int tid_ = tid_fresh(), lane = tid_ & 63, wave = (blockIdx.x * 512 + tid_) >> 6, nw = (gridDim.x * 512) >> 6;
  f32x4v gg[4];
#pragma unroll
  for (int j = 0; j < 4; ++j) gg[j] = ((const GAS f32x4v*)g)[lane + 64 * j];
#pragma unroll 1
  for (int r = wave * 4; r < NTOK; r += nw * 4) {
    f32x4v v[4][4]; float s[4];
#pragma unroll
    for (int q = 0; q < 4; ++q) { const GAS f32x4v* xr = (const GAS f32x4v*)(x + (size_t)(r + q) * D);
#pragma unroll
      for (int j = 0; j < 4; ++j) v[q][j] = xr[lane + 64 * j]; }
#pragma unroll
    for (int q = 0; q < 4; ++q) { float t = 0.f;
#pragma unroll
      for (int j = 0; j < 4; ++j) t += v[q][j].x * v[q][j].x + v[q][j].y * v[q][j].y + v[q][j].z * v[q][j].z + v[q][j].w * v[q][j].w;
      s[q] = wave_sum(t); }
#pragma unroll
    for (int q = 0; q < 4; ++q) { const float rstd = rsqrtf(s[q] * (1.f / D) + 1e-6f);
#pragma unroll
      for (int j = 0; j < 4; ++j) {
        u16x4v o; o.x = f2bf(v[q][j].x * rstd * gg[j].x); o.y = f2bf(v[q][j].y * rstd * gg[j].y); o.z = f2bf(v[q][j].z * rstd * gg[j].z); o.w = f2bf(v[q][j].w * rstd * gg[j].w);
        ((GAS u16x4v*)(xn + (size_t)(r + q) * D))[lane + 64 * j] = o; } }
  }
}

__device__ __forceinline__ void moe_tables(const int* cnt, int* l_off, int* l_te, int* l_cnt) {
  __syncthreads();
  if (threadIdx.x < 32) l_cnt[threadIdx.x] = __hip_atomic_load(cnt + threadIdx.x * CNT_STRIDE, __ATOMIC_RELAXED, __HIP_MEMORY_SCOPE_AGENT);
  __syncthreads();
  if (threadIdx.x == 0) {
    int off = 0;
    for (int e = 0; e < 32; ++e) { l_off[e] = off; const int nt = (l_cnt[e] + 255) >> 8; for (int i = 0; i < nt; ++i) l_te[(off >> 8) + i] = e; off += nt << 8; }
    l_off[32] = off;
    for (int i = off >> 8; i < NSLOT / 256; ++i) l_te[i] = -1;
  }
  __syncthreads();
}

__device__ __forceinline__ void ph_final(float* __restrict__ out, const bf16_t* __restrict__ YS, const int* __restrict__ sm, const int* l_off, const float* __restrict__ gfin) {
  const int tid_ = tid_fresh(), lane = tid_ & 63, wave = (blockIdx.x * 512 + tid_) >> 6, nw = (gridDim.x * 512) >> 6;
  f32x4v gg[4];
#pragma unroll
  for (int j = 0; j < 4; ++j) gg[j] = ((const GAS f32x4v*)gfin)[lane + 64 * j];
#pragma unroll 1
  for (int r = wave * 4; r < NTOK; r += nw * 4) {
    int s0[4], s1[4]; float w0[4], w1[4];
#pragma unroll
    for (int q = 0; q < 4; ++q) {
      const int e0 = sm[SM_EID + 2 * (r + q)], e1 = sm[SM_EID + 2 * (r + q) + 1];
      s0[q] = l_off[e0] + sm[SM_RANK + 2 * (r + q)]; s1[q] = l_off[e1] + sm[SM_RANK + 2 * (r + q) + 1];
      w0[q] = ((const float*)sm)[SM_WT + 2 * (r + q)]; w1[q] = ((const float*)sm)[SM_WT + 2 * (r + q) + 1];
    }
    f32x4v v[4][4]; u16x4v ya[4][4], yb[4][4];
#pragma unroll
    for (int q = 0; q < 4; ++q)
#pragma unroll
      for (int j = 0; j < 4; ++j) {
        v[q][j] = ((const GAS f32x4v*)(out + (size_t)(r + q) * D))[lane + 64 * j];
        ya[q][j] = ((const GAS u16x4v*)(YS + (size_t)s0[q] * D))[lane + 64 * j];
        yb[q][j] = ((const GAS u16x4v*)(YS + (size_t)s1[q] * D))[lane + 64 * j];
      }
    float s[4];
#pragma unroll
    for (int q = 0; q < 4; ++q) { float t = 0.f;
#pragma unroll
      for (int j = 0; j < 4; ++j) {
        v[q][j].x += w0[q] * bf2f(ya[q][j].x) + w1[q] * bf2f(yb[q][j].x); v[q][j].y += w0[q] * bf2f(ya[q][j].y) + w1[q] * bf2f(yb[q][j].y);
        v[q][j].z += w0[q] * bf2f(ya[q][j].z) + w1[q] * bf2f(yb[q][j].z); v[q][j].w += w0[q] * bf2f(ya[q][j].w) + w1[q] * bf2f(yb[q][j].w);
        t += v[q][j].x * v[q][j].x + v[q][j].y * v[q][j].y + v[q][j].z * v[q][j].z + v[q][j].w * v[q][j].w;
      }
      s[q] = wave_sum(t); }
#pragma unroll
    for (int q = 0; q < 4; ++q) { const float rstd = rsqrtf(s[q] * (1.f / D) + 1e-6f);
#pragma unroll
      for (int j = 0; j < 4; ++j) ((GAS f32x4v*)(out + (size_t)(r + q) * D))[lane + 64 * j] = v[q][j] * rstd * gg[j]; }
  }
}


struct WPtrs { const float *w_in, *w1k, *w2k, *w1v, *w2v, *w_a, *w_b, *w_o, *w_group, *w_expert, *w_gate, *w_up, *w_down;
               bf16_t *WinT, *WgnT, *W1kT, *W1vT, *W2kT, *W2vT, *WabT, *WoT, *WguT, *WdT, *WrtHi, *WrtLo; };
__device__ __forceinline__ TrItem tr_desc(const WPtrs& w, int it) {
  constexpr int I_IN = 2048, I_GN = 16, I_W1 = 256, I_W2 = 8, I_AB = 256, I_O = 512, I_GU = 4096;
  int r = it; TrItem d; d.nvalid = 32; d.frag = 0;
  if (r < I_IN) { const int rb = r >> 4, kb = r & 15, n0 = rb * 32; d.src = w.w_in + (size_t)(kb * 64) * INW + n0 + (n0 >= 1280 ? 24 : 0); d.ldw = INW; d.dst = w.WinT + (size_t)n0 * 1024 + kb * 64; d.ldt = 1024; return d; } r -= I_IN;
  if (r < I_GN) { d.src = w.w_in + (size_t)(r * 64) * INW + 1280; d.ldw = INW; d.nvalid = 24; d.dst = w.WgnT + r * 64; d.ldt = 1024; return d; } r -= I_GN;
  if (r < 2 * I_W1) { const int v = r >= I_W1; r -= v * I_W1; const int rb = r >> 5, kb = r & 31; d.src = (v ? w.w1v : w.w1k) + (size_t)(kb * 64) * 256 + rb * 32; d.ldw = 256; d.dst = (v ? w.W1vT : w.W1kT) + ((size_t)rb * 128 + kb * 4) * 512; d.ldt = 2048; d.frag = 1; return d; } r -= 2 * I_W1;
  if (r < 2 * I_W2) { const int v = r >= I_W2; r -= v * I_W2; const int rb = r >> 2, kb = r & 3; d.src = (v ? w.w2v : w.w2k) + (size_t)(kb * 64) * 64 + rb * 32; d.ldw = 64; d.dst = (v ? w.W2vT : w.W2kT) + (size_t)(rb * 32) * 256 + kb * 64; d.ldt = 256; return d; } r -= 2 * I_W2;
  if (r < 2 * I_AB) { const int a = r >= I_AB; r -= a * I_AB; const int rb = r >> 3, kb = r & 7; d.src = (a ? w.w_a : w.w_b) + (size_t)(kb * 64) * 1024 + rb * 32; d.ldw = 1024; d.dst = w.WabT + (size_t)(rb * 32) * 1024 + a * 512 + kb * 64; d.ldt = 1024; return d; } r -= 2 * I_AB;
  if (r < I_O) { const int rb = r >> 4, kb = r & 15; d.src = w.w_o + (size_t)(kb * 64) * 1024 + rb * 32; d.ldw = 1024; d.dst = w.WoT + (size_t)(rb * 32) * 1024 + kb * 64; d.ldt = 1024; return d; } r -= I_O;
  if (r < 2 * I_GU) { const int u = r >= I_GU; r -= u * I_GU; const int e = r >> 7, q = r & 127, cb = q >> 4, kb = q & 15, c0 = cb * 32;
    d.src = (u ? w.w_up : w.w_gate) + ((size_t)e * 1024 + kb * 64) * 256 + c0; d.ldw = 256; d.dst = w.WguT + ((size_t)e * 512 + (c0 >> 7) * 256 + u * 128 + (c0 & 127)) * 1024 + kb * 64; d.ldt = 1024; return d; } r -= 2 * I_GU;
  { const int e = r >> 7, q = r & 127, cb = q >> 2, kb = q & 3; d.src = w.w_down + ((size_t)e * 256 + kb * 64) * 1024 + cb * 32; d.ldw = 1024; d.dst = w.WdT + ((size_t)e * 1024 + cb * 32) * 256 + kb * 64; d.ldt = 256; return d; }
}
__device__ __forceinline__ void ph_weights(LAS unsigned char* lds, const WPtrs& w) {
  const int tid_ = tid_fresh(), lane = tid_ & 63, wl = __builtin_amdgcn_readfirstlane(tid_ >> 6);
  const int gw = blockIdx.x * 8 + wl, NGW = gridDim.x * 8;
  LAS float* scr = (LAS float*)(lds + wl * 16384);
  constexpr int NITEMS = 2048 + 16 + 512 + 16 + 512 + 512 + 8192 + 4096;
  for (int i = blockIdx.x * 512 + tid_; i < 64 * 1024; i += gridDim.x * 512) {
    const int j = i >> 10, k = i & 1023; const float v = j < 4 ? w.w_group[k * 4 + j] : (j < 36 ? w.w_expert[k * 32 + (j - 4)] : 0.f);
    const bf16_t hi = f2bf(v); w.WrtHi[i] = hi; w.WrtLo[i] = f2bf(v - bf2f(hi));
  }
  int it = gw;
  if (it < NITEMS) {
    TrItem cur = tr_desc(w, it); TrRegs rc; tr_load(rc, cur, lane);
#pragma unroll 1
    for (;;) {
      const int nx = it + NGW; const bool more = nx < NITEMS;
      TrItem nd = cur; TrRegs rn = rc;
      if (more) { nd = tr_desc(w, nx); tr_load(rn, nd, lane); }
      tr_store(rc, cur, scr, lane);
      if (!more) break;
      cur = nd; rc = rn; it = nx;
    }
  }
}

struct Args { const float* in[22]; float* out; unsigned char* ws; };
constexpr int PTAB_OFF = 131072 + 4096;
#define PIN(i) ((const float*)ldptr(ptab, (i)))
#define POUT ((float*)ldptr(ptab, 22))
#define PWS ((unsigned char*)ldptr(ptab, 23))
#define WSB(off) ((bf16_t*)(ws + (off)))
__global__ void __launch_bounds__(512, 2) mega_fwd(Args a) {
  extern __shared__ __attribute__((aligned(16))) unsigned char lds[];
  LAS unsigned char* ldsl = (LAS unsigned char*)lds;
  LAS u64_t* ptab = (LAS u64_t*)(ldsl + PTAB_OFF);
  volatile LAS unsigned* MISC = (volatile LAS unsigned*)(ldsl + MISC_OFF);
  if (threadIdx.x == 0) {
#pragma unroll
    for (int i = 0; i < 22; ++i) ptab[i] = (u64_t)a.in[i];
    ptab[22] = (u64_t)a.out; ptab[23] = (u64_t)a.ws;
  }
  if (threadIdx.x < 32) MISC[threadIdx.x] = 0u;
  __syncthreads();
  XcdBarrier bar = xcd_barrier_post((unsigned*)PWS, MISC + 8);
  int* l_off = (int*)(lds + 131072 + 1024);
  int* l_te = (int*)(lds + 131072 + 1024 + 256);
  int* l_cnt = (int*)(lds + 131072 + 2048);
#define GRID_BAR() do { bar.bar = (unsigned*)PWS; xcd_barrier(bar); } while (0)
  unsigned long long t_acc = 0ull, t_beg = 0ull;
#define PH_BEGIN(k) do { if (PROBE_SPIN == (k)) t_beg = __builtin_amdgcn_s_memrealtime(); } while (0)
#define PH_END(k) do { if (PROBE_SPIN == (k)) t_acc += __builtin_amdgcn_s_memrealtime() - t_beg; } while (0)

  PH_BEGIN(0);
  REPS(0) {
    unsigned char* ws = PWS;
    WPtrs w{PIN(2), PIN(4), PIN(5), PIN(7), PIN(8), PIN(10), PIN(11), PIN(12), PIN(14), PIN(16), PIN(18), PIN(19), PIN(20),
            WSB(WS_WINT), WSB(WS_WGNT), WSB(WS_W1KT), WSB(WS_W1VT), WSB(WS_W2KT), WSB(WS_W2VT), WSB(WS_WABT), WSB(WS_WOT), WSB(WS_WGUT), WSB(WS_WDT), WSB(WS_WRT_HI), WSB(WS_WRT_LO)};
    for (int jb = blockIdx.x; jb < 64; jb += gridDim.x) wg::cmp_bias_part(ldsl, jb, jb < 32 ? PIN(3) : PIN(6), jb < 32 ? PIN(4) : PIN(7), (float*)(ws + WS_PB) + (size_t)(jb >> 5) * 32 * 256);
    ph_weights(ldsl, w);
    ph_prep_xn(PIN(0), PIN(1), WSB(WS_XN));
  }
  GRID_BAR();
  PH_END(0);
  PH_BEGIN(1);
  REPS(1) {
    unsigned char* ws = PWS;
    pg8::SchedDense Sd; Sd.init(ws + WS_XN, 2048, ws + WS_WINT, NTOK, 4096, 1024, gridDim.x, blockIdx.x);
    pg8::EpiProj E{WSB(WS_QA), WSB(WS_QB), WSB(WS_KVC), WSB(WS_KVS), WSB(WS_KVW), WSB(WS_KVB), WSB(WS_GM)};
    pg8::gemm_phase<pg8::EpiProj, pg8::SchedDense, true>(ldsl, 1024, 128, Sd, E);
  }
  REPS(1) {
    unsigned char* ws = PWS;
    for (int c = blockIdx.x; c < NTOK / 64; c += gridDim.x) wg::gn_rows(64 * c, WSB(WS_XN), WSB(WS_WGNT), (float*)(ws + WS_GN));
    if (blockIdx.x == gridDim.x - 1) wg::cmp_bias_final((const float*)(ws + WS_PB), (float*)(ws + WS_BIAS1));
  }
  GRID_BAR();
  PH_END(1);
  PH_BEGIN(2);
  REPS(2) {
    unsigned char* ws = PWS;
    if (gridDim.x == 256) {
      const int c = (blockIdx.x & 7) * 32 + (blockIdx.x >> 3);
      if (c < 128) {
        const int sel = c >> 6, rt = c & 63;
        unsigned long long t_q = PROBE_SPIN >= 0 ? __builtin_amdgcn_s_memrealtime() : 0ull;
        wg::cmp_unit(ldsl, sel, rt, WSB(WS_KVC), WSB(sel ? WS_W1VT : WS_W1KT), (const float*)(ws + WS_BIAS1) + sel * 256, WSB(sel ? WS_W2VT : WS_W2KT), WSB(sel ? WS_VC : WS_KC));
        if (PROBE_SPIN == 21) t_acc += __builtin_amdgcn_s_memrealtime() - t_q;
        if (PROBE_SPIN >= 0) t_q = __builtin_amdgcn_s_memrealtime();
        att::swa_unit(ldsl, c >> 6, (c >> 5) & 1, c & 31, WSB(WS_QB), WSB(WS_KVB), PIN(9), WSB(WS_OAB));
        if (PROBE_SPIN == 22) t_acc += __builtin_amdgcn_s_memrealtime() - t_q;
      } else {
#pragma unroll 1
        for (int i = 0; i < 3; ++i) { const int u = 128 + (c - 128) * 3 + i; const unsigned long long t_q = PROBE_SPIN >= 0 ? __builtin_amdgcn_s_memrealtime() : 0ull; att::swa_unit(ldsl, u >> 6, (u >> 5) & 1, u & 31, WSB(WS_QB), WSB(WS_KVB), PIN(9), WSB(WS_OAB)); if (PROBE_SPIN == 23) t_acc += __builtin_amdgcn_s_memrealtime() - t_q; }
      }
    } else {
#pragma unroll 1
      for (int c = blockIdx.x; c < 128; c += gridDim.x) { const int sel = c >> 6, rt = c & 63;
        wg::cmp_unit(ldsl, sel, rt, WSB(WS_KVC), WSB(sel ? WS_W1VT : WS_W1KT), (const float*)(ws + WS_BIAS1) + sel * 256, WSB(sel ? WS_W2VT : WS_W2KT), WSB(sel ? WS_VC : WS_KC)); }
      att::swa_phase(ldsl, WSB(WS_QB), WSB(WS_KVB), PIN(9), WSB(WS_OAB));
    }
  }
  GRID_BAR();
  PH_END(2);
  PH_BEGIN(3);
  REPS(3) {
    unsigned char* ws = PWS;
    att::nsa_phase(ldsl, WSB(WS_QA), WSB(WS_KC), WSB(WS_VC), WSB(WS_KVS), WSB(WS_KVW), (const float*)(ws + WS_GN), WSB(WS_OAB), t_acc);
  }
  GRID_BAR();
  PH_END(3);
  PH_BEGIN(4);
  REPS(4) {
    unsigned char* ws = PWS;
    pg8::SchedDense Sd; Sd.init(ws + WS_OAB, 2048, ws + WS_WABT, NTOK, 1024, 1024, gridDim.x, blockIdx.x);
    pg8::EpiMerge E{WSB(WS_GM), WSB(WS_MG)};
    pg8::gemm_phase<pg8::EpiMerge, pg8::SchedDense, true>(ldsl, 1024, 128, Sd, E);
  }
  GRID_BAR();
  PH_END(4);
  PH_BEGIN(5);
  REPS(5) {
    unsigned char* ws = PWS;
    pg8::SchedDense Sd; Sd.init(ws + WS_MG, 2048, ws + WS_WOT, NTOK, 1024, 1024, gridDim.x, blockIdx.x);
    pg8::EpiX1 E{PIN(0), POUT};
    pg8::gemm_phase<pg8::EpiX1, pg8::SchedDense, true>(ldsl, 1024, 128, Sd, E);
  }
  GRID_BAR();
  PH_END(5);
  PH_BEGIN(6);
  {
    unsigned char* ws = PWS;
#pragma unroll 1
    for (int c = blockIdx.x; c < NTOK / 64; c += gridDim.x)
      rt::router_rows(ldsl, 64 * c, POUT, PIN(13), PIN(15), PIN(17), WSB(WS_WRT_HI), WSB(WS_WRT_LO), WSB(WS_H2), WSB(WS_H2LO), (int*)(ws + WS_CTL) + CW_CNT, (int*)(ws + WS_SMALL), (int*)(ws + WS_LIST), t_acc);
  }
  GRID_BAR();
  PH_END(6);
  PH_BEGIN(7);
  REPS(7) {
    unsigned char* ws = PWS;
    const int* cnt = (const int*)(ws + WS_CTL) + CW_CNT;
    moe_tables(cnt, l_off, l_te, l_cnt);
    pg8::SchedMoeUp Sm{(const char*)(ws + WS_H2), (const char*)(ws + WS_WGUT), (const int*)(ws + WS_LIST), l_cnt, l_off, l_te, (int)gridDim.x, (int)blockIdx.x};
    pg8::EpiHB E{WSB(WS_HB)};
    pg8::gemm_phase<pg8::EpiHB, pg8::SchedMoeUp, true>(ldsl, 1024, 128, Sm, E);
  }
  GRID_BAR();
  PH_END(7);
  PH_BEGIN(8);
  REPS(8) {
    unsigned char* ws = PWS;
    pg8::SchedMoeDown Sm{(const char*)(ws + WS_HB), (const char*)(ws + WS_WDT), l_off, l_te, (int)gridDim.x, (int)blockIdx.x};
    pg8::EpiYS E{WSB(WS_YS)};
    pg8::gemm_phase<pg8::EpiYS, pg8::SchedMoeDown, true>(ldsl, 256, 128, Sm, E);
  }
  GRID_BAR();
  PH_END(8);
  PH_BEGIN(9);
  {
    unsigned char* ws = PWS;
    ph_final(POUT, WSB(WS_YS), (const int*)(ws + WS_SMALL), l_off, PIN(21));
  }
  if (PROBE_SPIN == 9) GRID_BAR();
  PH_END(9);
  if (PROBE_SPIN >= 0 && blockIdx.x == PROBE_BLOCK) { const unsigned long long t0 = __builtin_amdgcn_s_memrealtime(); while (__builtin_amdgcn_s_memrealtime() - t0 < t_acc) __builtin_amdgcn_s_sleep(8); }
}

extern "C" void kernel_launch(void* const* d_in, const int* in_sizes, int n_in, void* d_out, int out_size, void* d_ws, size_t ws_size, hipStream_t stream) {
  static int grid = 0;
  if (grid == 0) {
    int dev = 0, cus = 0, per_cu = 0;
    if (hipGetDevice(&dev) != hipSuccess || hipDeviceGetAttribute(&cus, hipDeviceAttributeMultiprocessorCount, dev) != hipSuccess) { fprintf(stderr, "kernel_launch: device query failed\n"); grid = -1; return; }
    if (hipFuncSetAttribute((const void*)mega_fwd, hipFuncAttributeMaxDynamicSharedMemorySize, LDS_BYTES) != hipSuccess) { fprintf(stderr, "kernel_launch: hipFuncSetAttribute failed\n"); grid = -1; return; }
    if (hipOccupancyMaxActiveBlocksPerMultiprocessor(&per_cu, (const void*)mega_fwd, 512, LDS_BYTES) != hipSuccess || per_cu < 1) { fprintf(stderr, "kernel_launch: occupancy query says %d blocks/CU\n", per_cu); (void)hipGetLastError(); grid = -1; return; }
    grid = cus;
  }
  if (grid < 0) return;
  (void)hipMemsetAsync((char*)d_ws + WS_CTL, 0, CTL_ZERO_BYTES, stream);
  Args a{};
  for (int i = 0; i < 22; ++i) a.in[i] = (const float*)d_in[i];
  a.out = (float*)d_out; a.ws = (unsigned char*)d_ws;
  hipLaunchKernelGGL(mega_fwd, dim3(grid), dim3(512), LDS_BYTES, stream, a);
}
```
